# Optimizing an MI355X kernel written in HIP

```python
import jax
import jax.numpy as jnp
from jax import lax
import numpy as np

D_MODEL = 2048
BATCH = 8
SEQ = 2048
DEPTH = 1

D_RNN = D_MODEL
LRU_BLOCKS = 16
LRU_BLOCK_DIM = D_RNN // LRU_BLOCKS
CONV_WIDTH = 4
LRU_C = 8.0
N_HEADS = 16
HEAD_DIM = 128
N_KV_GROUPS = 4
HEADS_PER_GROUP = N_HEADS // N_KV_GROUPS
Q_WIDTH = N_HEADS * HEAD_DIM
KV_WIDTH = N_KV_GROUPS * HEAD_DIM
CMP_STRIDE = 16
CMP_BLOCK = 2 * CMP_STRIDE
SLC_BLOCK = 64
N_SELECT = 16
WINDOW = 512
WIN_Q_BLOCK = 128
SLC_Q_BLOCK = 32
ROPE_THETA = 500000.0
ROPE_DIM = HEAD_DIM // 4
D_FF = 5632
NORM_EPS = 1e-6
N_ADA = 9
SPLIT_SIZES = (D_RNN, D_RNN, Q_WIDTH, 6 * KV_WIDTH, 3 * N_HEADS, 2 * D_MODEL)
IN_WIDTH = 2 * D_RNN + Q_WIDTH + 6 * KV_WIDTH + 3 * N_HEADS + 2 * D_MODEL
NEG = -1e30

kernel_name = "hybrid_rglru_nsa_macaron_block"


def rms_norm(x, g):
    x32 = x.astype(jnp.float32)
    y = x32 * lax.rsqrt(jnp.mean(x32 * x32, axis=-1, keepdims=True) + NORM_EPS)
    return (y * g.astype(jnp.float32)).astype(x.dtype)


def modulate(h, shift, scale):
    return h * (1 + scale[:, None, :]) + shift[:, None, :]


def swiglu(u, w_gate, w_up, w_down):
    return (jax.nn.silu(u @ w_gate) * (u @ w_up)) @ w_down


def masked_softmax(s, mask):
    p = jax.nn.softmax(jnp.where(mask, s, NEG), axis=-1)
    return jnp.where(mask, p, 0.0)


def partial_rope(t, cos, sin):
    half = ROPE_DIM // 2
    c = cos[None, :, None, :].astype(t.dtype)
    s = sin[None, :, None, :].astype(t.dtype)
    t1 = t[..., :half]
    t2 = t[..., half:ROPE_DIM]
    return jnp.concatenate([t1 * c - t2 * s, t2 * c + t1 * s, t[..., ROPE_DIM:]], axis=-1)


def rglru_branch(xa, ya, conv_w, conv_b, wr, br, wi, bi, lam):
    B, S, _ = xa.shape
    xc = lax.conv_general_dilated(
        xa, conv_w[:, None, :], window_strides=(1,), padding=[(CONV_WIDTH - 1, 0)],
        dimension_numbers=('NWC', 'WIO', 'NWC'), feature_group_count=D_RNN) + conv_b
    xb = xc.reshape(B, S, LRU_BLOCKS, LRU_BLOCK_DIM)
    r = jax.nn.sigmoid(jnp.einsum('bshi,hij->bshj', xb, wr).reshape(B, S, D_RNN) + br)
    i = jax.nn.sigmoid(jnp.einsum('bshi,hij->bshj', xb, wi).reshape(B, S, D_RNN) + bi)
    log_a = (-LRU_C * r.astype(jnp.float32)) * jax.nn.softplus(-lam.astype(jnp.float32))
    a = jnp.exp(log_a)
    b = jnp.sqrt(-jnp.expm1(2.0 * log_a)) * (i * xc).astype(jnp.float32)

    def combine(left, right):
        a1, b1 = left
        a2, b2 = right
        return a1 * a2, a2 * b1 + b2

    _, h = lax.associative_scan(combine, (a, b), axis=1)
    return h.astype(xa.dtype) * jax.nn.gelu(ya)


def compress(t, pe, w1, w2):
    B, G, S, dh = t.shape
    ch = t.reshape(B, G, S // CMP_STRIDE, CMP_STRIDE, dh)
    blocks = jnp.concatenate([ch[:, :, :-1], ch[:, :, 1:]], axis=3) + pe
    flat = blocks.reshape(B, G, blocks.shape[2], CMP_BLOCK * dh)
    return jax.nn.gelu(flat @ w1) @ w2


def nsa_branch(q, kv, gate_logits, cos, sin, pe_k, w1_k, w2_k, pe_v, w1_v, w2_v):
    B, S, _ = q.shape
    G, HPG, DH = N_KV_GROUPS, HEADS_PER_GROUP, HEAD_DIM
    scale = HEAD_DIM ** -0.5
    pos = jnp.arange(S)

    q = partial_rope(q.reshape(B, S, N_HEADS, DH), cos, sin)
    qg = q.reshape(B, S, G, HPG, DH).transpose(0, 2, 3, 1, 4)
    k_cmp, v_cmp, k_slc, v_slc, k_win, v_win = jnp.split(kv, 6, axis=-1)

    def kv_heads(t, rotate):
        t = t.reshape(B, S, G, DH)
        if rotate:
            t = partial_rope(t, cos, sin)
        return t.transpose(0, 2, 1, 3)

    k_cmp, k_slc, k_win = kv_heads(k_cmp, True), kv_heads(k_slc, True), kv_heads(k_win, True)
    v_cmp, v_slc, v_win = kv_heads(v_cmp, False), kv_heads(v_slc, False), kv_heads(v_win, False)

    kc = compress(k_cmp, pe_k, w1_k, w2_k)
    vc = compress(v_cmp, pe_v, w1_v, w2_v)
    n_cmp = kc.shape[2]
    cmp_start = jnp.arange(n_cmp) * CMP_STRIDE
    cmp_mask = (cmp_start + CMP_BLOCK - 1)[None, :] <= pos[:, None]
    s_cmp = jnp.einsum('bghsd,bgnd->bghsn', qg, kc, preferred_element_type=jnp.float32) * scale
    p_cmp = masked_softmax(s_cmp, cmp_mask)
    o_cmp = jnp.einsum('bghsn,bgnd->bghsd', p_cmp.astype(vc.dtype), vc)

    n_slc = S // SLC_BLOCK
    slc_start = jnp.arange(n_slc) * SLC_BLOCK
    overlap = ((cmp_start[:, None] < slc_start[None, :] + SLC_BLOCK)
               & (cmp_start[:, None] + CMP_BLOCK > slc_start[None, :])).astype(jnp.float32)
    imp = jnp.einsum('bghsn,nj->bgsj', p_cmp, overlap)
    cur = pos // SLC_BLOCK
    blk = jnp.arange(n_slc)
    forced = (blk[None, :] == 0) | (blk[None, :] == cur[:, None]) | (blk[None, :] == cur[:, None] - 1)
    causal_blk = slc_start[None, :] <= pos[:, None]
    imp = jnp.where(forced, jnp.inf, jnp.where(causal_blk, imp, -jnp.inf))
    n_sel = min(N_SELECT, n_slc)
    _, sel_idx = lax.top_k(imp, n_sel)

    kb = k_slc.reshape(B, G, n_slc, SLC_BLOCK, DH)
    vb = v_slc.reshape(B, G, n_slc, SLC_BLOCK, DH)
    nqc = S // SLC_Q_BLOCK
    q_chunks = qg.reshape(B, G, HPG, nqc, SLC_Q_BLOCK, DH).transpose(3, 0, 1, 2, 4, 5)
    idx_chunks = sel_idx.reshape(B, G, nqc, SLC_Q_BLOCK, n_sel).transpose(2, 0, 1, 3, 4)
    pos_chunks = pos.reshape(nqc, SLC_Q_BLOCK)
    gather = jax.vmap(jax.vmap(lambda blocks, ids: blocks[ids]))

    def slc_chunk(args):
        qc, ic, pc = args
        kg = gather(kb, ic)
        vg = gather(vb, ic)
        s = jnp.einsum('bghqd,bgqnld->bghqnl', qc, kg, preferred_element_type=jnp.float32) * scale
        kpos = ic[..., None] * SLC_BLOCK + jnp.arange(SLC_BLOCK)
        mask = (kpos <= pc[None, None, :, None, None]).reshape(B, G, 1, SLC_Q_BLOCK, n_sel * SLC_BLOCK)
        p = masked_softmax(s.reshape(B, G, HPG, SLC_Q_BLOCK, n_sel * SLC_BLOCK), mask)
        return jnp.einsum('bghqnl,bgqnld->bghqd', p.reshape(s.shape).astype(vg.dtype), vg)

    o_slc = lax.map(slc_chunk, (q_chunks, idx_chunks, pos_chunks))
    o_slc = o_slc.transpose(1, 2, 3, 0, 4, 5).reshape(B, G, HPG, S, DH)

    nqb = S // WIN_Q_BLOCK
    span = WINDOW + WIN_Q_BLOCK
    kp = jnp.pad(k_win, ((0, 0), (0, 0), (WINDOW, 0), (0, 0)))
    vp = jnp.pad(v_win, ((0, 0), (0, 0), (WINDOW, 0), (0, 0)))
    qb = qg.reshape(B, G, HPG, nqb, WIN_Q_BLOCK, DH).transpose(3, 0, 1, 2, 4, 5)

    def win_chunk(args):
        qc, b = args
        start = b * WIN_Q_BLOCK
        kw = lax.dynamic_slice_in_dim(kp, start, span, axis=2)
        vw = lax.dynamic_slice_in_dim(vp, start, span, axis=2)
        qpos = start + jnp.arange(WIN_Q_BLOCK)
        kpos = start - WINDOW + jnp.arange(span)
        mask = ((kpos[None, :] <= qpos[:, None]) & (kpos[None, :] > qpos[:, None] - WINDOW)
                & (kpos[None, :] >= 0))
        s = jnp.einsum('bghqd,bgkd->bghqk', qc, kw, preferred_element_type=jnp.float32) * scale
        p = masked_softmax(s, mask)
        return jnp.einsum('bghqk,bgkd->bghqd', p.astype(vw.dtype), vw)

    o_win = lax.map(win_chunk, (qb, jnp.arange(nqb)))
    o_win = o_win.transpose(1, 2, 3, 0, 4, 5).reshape(B, G, HPG, S, DH)

    g = jax.nn.sigmoid(gate_logits).reshape(B, S, G, HPG, 3).transpose(0, 2, 3, 1, 4)
    o = g[..., 0:1] * o_cmp + g[..., 1:2] * o_slc + g[..., 2:3] * o_win
    return o.transpose(0, 3, 1, 2, 4).reshape(B, S, Q_WIDTH)


def setup_inputs(seed: int = 0) -> dict:
    key = jax.random.key(seed)
    ks = jax.random.split(key, 33)
    f32 = jnp.float32

    def nrm(k, shape, scale):
        return jax.random.normal(k, shape, f32) * scale

    def gain(k):
        return 1.0 + 0.05 * jax.random.normal(k, (DEPTH, D_MODEL), f32)

    u = jax.random.uniform(ks[18], (DEPTH, D_RNN), f32, minval=0.9, maxval=0.999)
    p = u ** (1.0 / LRU_C)
    lam = jnp.log(p) - jnp.log1p(-p)
    return {
        "x": nrm(ks[0], (BATCH, SEQ, D_MODEL), 1.0),
        "c": nrm(ks[1], (BATCH, D_MODEL), 1.0),
        "w_ada": nrm(ks[2], (DEPTH, D_MODEL, N_ADA * D_MODEL), D_MODEL ** -0.5),
        "b_ada": nrm(ks[3], (DEPTH, N_ADA * D_MODEL), 0.02),
        "ffn1_pre_g": gain(ks[4]),
        "ffn1_post_g": gain(ks[5]),
        "ffn1_w_gate": nrm(ks[6], (DEPTH, D_MODEL, D_FF), D_MODEL ** -0.5),
        "ffn1_w_up": nrm(ks[7], (DEPTH, D_MODEL, D_FF), D_MODEL ** -0.5),
        "ffn1_w_down": nrm(ks[8], (DEPTH, D_FF, D_MODEL), D_FF ** -0.5),
        "mix_pre_g": gain(ks[9]),
        "mix_post_g": gain(ks[10]),
        "w_in": nrm(ks[11], (DEPTH, D_MODEL, IN_WIDTH), D_MODEL ** -0.5),
        "conv_w": nrm(ks[12], (DEPTH, CONV_WIDTH, D_RNN), CONV_WIDTH ** -0.5),
        "conv_b": nrm(ks[13], (DEPTH, D_RNN), 0.02),
        "lru_wr": nrm(ks[14], (DEPTH, LRU_BLOCKS, LRU_BLOCK_DIM, LRU_BLOCK_DIM), LRU_BLOCK_DIM ** -0.5),
        "lru_br": nrm(ks[15], (DEPTH, D_RNN), 0.02),
        "lru_wi": nrm(ks[16], (DEPTH, LRU_BLOCKS, LRU_BLOCK_DIM, LRU_BLOCK_DIM), LRU_BLOCK_DIM ** -0.5),
        "lru_bi": nrm(ks[17], (DEPTH, D_RNN), 0.02),
        "lru_lambda": lam,
        "cmp_pe_k": nrm(ks[19], (DEPTH, CMP_BLOCK, HEAD_DIM), 0.02),
        "cmp_w1_k": nrm(ks[20], (DEPTH, CMP_BLOCK * HEAD_DIM, HEAD_DIM), (CMP_BLOCK * HEAD_DIM) ** -0.5),
        "cmp_w2_k": nrm(ks[21], (DEPTH, HEAD_DIM, HEAD_DIM), HEAD_DIM ** -0.5),
        "cmp_pe_v": nrm(ks[22], (DEPTH, CMP_BLOCK, HEAD_DIM), 0.02),
        "cmp_w1_v": nrm(ks[23], (DEPTH, CMP_BLOCK * HEAD_DIM, HEAD_DIM), (CMP_BLOCK * HEAD_DIM) ** -0.5),
        "cmp_w2_v": nrm(ks[24], (DEPTH, HEAD_DIM, HEAD_DIM), HEAD_DIM ** -0.5),
        "w_a_out": nrm(ks[25], (DEPTH, D_RNN, D_MODEL), D_RNN ** -0.5),
        "w_b_out": nrm(ks[26], (DEPTH, Q_WIDTH, D_MODEL), Q_WIDTH ** -0.5),
        "w_out": nrm(ks[27], (DEPTH, D_MODEL, D_MODEL), D_MODEL ** -0.5),
        "ffn2_pre_g": gain(ks[28]),
        "ffn2_post_g": gain(ks[29]),
        "ffn2_w_gate": nrm(ks[30], (DEPTH, D_MODEL, D_FF), D_MODEL ** -0.5),
        "ffn2_w_up": nrm(ks[31], (DEPTH, D_MODEL, D_FF), D_MODEL ** -0.5),
        "ffn2_w_down": nrm(ks[32], (DEPTH, D_FF, D_MODEL), D_FF ** -0.5),
    }


def reference(x, c, w_ada, b_ada,
              ffn1_pre_g, ffn1_post_g, ffn1_w_gate, ffn1_w_up, ffn1_w_down,
              mix_pre_g, mix_post_g, w_in, conv_w, conv_b,
              lru_wr, lru_br, lru_wi, lru_bi, lru_lambda,
              cmp_pe_k, cmp_w1_k, cmp_w2_k, cmp_pe_v, cmp_w1_v, cmp_w2_v,
              w_a_out, w_b_out, w_out,
              ffn2_pre_g, ffn2_post_g, ffn2_w_gate, ffn2_w_up, ffn2_w_down):
    B, S, D = x.shape
    pos = jnp.arange(S).astype(jnp.float32)
    inv_freq = ROPE_THETA ** (-jnp.arange(0, ROPE_DIM, 2, dtype=jnp.float32) / ROPE_DIM)
    ang = pos[:, None] * inv_freq[None, :]
    cos, sin = jnp.cos(ang), jnp.sin(ang)
    offsets = np.cumsum(SPLIT_SIZES)[:-1].tolist()
    c_act = jax.nn.silu(c)

    for l in range(DEPTH):
        mod = (c_act @ w_ada[l] + b_ada[l]).reshape(B, N_ADA, D)
        sh1, sc1, g1 = mod[:, 0], mod[:, 1], mod[:, 2]
        sh2, sc2, g2 = mod[:, 3], mod[:, 4], mod[:, 5]
        sh3, sc3, g3 = mod[:, 6], mod[:, 7], mod[:, 8]

        u = modulate(rms_norm(x, ffn1_pre_g[l]), sh1, sc1)
        f = swiglu(u, ffn1_w_gate[l], ffn1_w_up[l], ffn1_w_down[l])
        x = x + 0.5 * g1[:, None, :] * rms_norm(f, ffn1_post_g[l])

        u = modulate(rms_norm(x, mix_pre_g[l]), sh2, sc2)
        xa, ya, q, kv, nsa_g, merge_g = jnp.split(u @ w_in[l], offsets, axis=-1)
        y_a = rglru_branch(xa, ya, conv_w[l], conv_b[l], lru_wr[l], lru_br[l],
                           lru_wi[l], lru_bi[l], lru_lambda[l]) @ w_a_out[l]
        y_b = nsa_branch(q, kv, nsa_g, cos, sin, cmp_pe_k[l], cmp_w1_k[l], cmp_w2_k[l],
                         cmp_pe_v[l], cmp_w1_v[l], cmp_w2_v[l]) @ w_b_out[l]
        gate_a, gate_b = jnp.split(jax.nn.sigmoid(merge_g), 2, axis=-1)
        mixed = (gate_a * y_a + gate_b * y_b) @ w_out[l]
        x = x + g2[:, None, :] * rms_norm(mixed, mix_post_g[l])

        u = modulate(rms_norm(x, ffn2_pre_g[l]), sh3, sc3)
        f = swiglu(u, ffn2_w_gate[l], ffn2_w_up[l], ffn2_w_down[l])
        x = x + 0.5 * g3[:, None, :] * rms_norm(f, ffn2_post_g[l])
    return x
```

```cpp
#include <hip/hip_runtime.h>
#include <hip/hip_cooperative_groups.h>
#include <cstdio>
#include <cstdint>
namespace cg = cooperative_groups;

#ifndef ONE_LAUNCH
#define ONE_LAUNCH 1
#endif

#define LAS __attribute__((address_space(3)))
#define DI __device__ __forceinline__
typedef unsigned short bf16_t;
typedef short bf16x8 __attribute__((ext_vector_type(8)));
typedef short s16x4 __attribute__((ext_vector_type(4)));
typedef float f32x2 __attribute__((ext_vector_type(2)));
typedef float f32x4 __attribute__((ext_vector_type(4)));
typedef float f32x16 __attribute__((ext_vector_type(16)));
typedef unsigned u32x2 __attribute__((ext_vector_type(2)));
typedef unsigned u32x4 __attribute__((ext_vector_type(4)));
typedef __bf16 bf16x2_t __attribute__((ext_vector_type(2)));

constexpr int DM = 2048, NB = 8, SEQ = 2048, T = NB * SEQ, DFF = 5632, NADA = 9;
constexpr int INW = 13360;
constexpr int NTHR = 512, NWV = 8;
constexpr float EPS = 1e-6f;
constexpr size_t MiB = 1u << 20;
constexpr size_t WS_MOD = 0;
constexpr size_t WS_ROPE = 640 * 1024;
constexpr size_t WS_PEB = 900 * 1024;
constexpr size_t WS_W2T = 1 * MiB;
constexpr size_t WS_WGU = 2 * MiB, WS_WD = 46 * MiB;
constexpr size_t WS_BB = 2 * MiB;
constexpr size_t WS_WIN = 68 * MiB, WS_WV = 117 * MiB, WS_WA = 121 * MiB, WS_WB = 129 * MiB, WS_WO = 137 * MiB;
constexpr size_t WS_PART = 68 * MiB;
constexpr size_t WS_W1T = 145 * MiB, WS_WRI = 147 * MiB, WS_KCC = 152 * MiB, WS_VCT = 153 * MiB, WS_NG = 154 * MiB;
constexpr size_t WS_U = 160 * MiB;
constexpr size_t WS_H = 224 * MiB, WS_F = 400 * MiB;
constexpr size_t WS_XA = 224 * MiB, WS_GY = 288 * MiB, WS_Q = 352 * MiB, WS_KC = 416 * MiB, WS_VC = 432 * MiB, WS_KS = 448 * MiB, WS_KW = 464 * MiB;
constexpr size_t WS_VST = 480 * MiB, WS_VWT = 496 * MiB, WS_MG = 512 * MiB, WS_FMIX = 512 * MiB;
constexpr size_t WS_END = 640 * MiB;
constexpr int LDS_BYTES = 147456;

struct Args { const float* in[33]; float* out; unsigned char* ws; int ph_lo, ph_hi; };
typedef const Args __attribute__((address_space(4)))* KArgs;

DI unsigned pk2(float lo, float hi) { f32x2 v = {lo, hi}; bf16x2_t b = __builtin_convertvector(v, bf16x2_t); return __builtin_bit_cast(unsigned, b); }
DI float bf2f(bf16_t v) { return __uint_as_float((unsigned)v << 16); }
DI float bflo(unsigned w) { return __uint_as_float(w << 16); }
DI float bfhi(unsigned w) { return __uint_as_float(w & 0xffff0000u); }
DI float sigm(float x) { return 1.f / (1.f + __expf(-x)); }
DI float gelu_t(float x) { const float u = 0.7978845608028654f * (x + 0.044715f * x * x * x); return x / (1.f + __expf(-2.f * u)); }
DI float wave_sum(float v) {
#pragma unroll
    for (int o = 1; o < 64; o <<= 1) v += __shfl_xor(v, o);
    return v;
}
#define LDS_WAIT() asm volatile("s_waitcnt lgkmcnt(0)" ::: "memory")
DI int otid() { int t = threadIdx.x; asm volatile("" : "+v"(t)); return t; }

namespace pg8 {
constexpr int BM = 256, BK = 64, HALF = 128, HTB = HALF * BK * 2, STAGE_BYTES = 8 * HTB, NXCD = 8, WGM = 8;
DI int lds_byte(int r, int c) { const int st = (r >> 4) * 2 + (c >> 5), rr = r & 15, cc = c & 31, ob = rr * 64 + cc * 2; return st * 1024 + (ob ^ (((ob >> 9) & 1) << 5)); }
DI void stage_rc(int b, int& R, int& C) { const int st = b / 1024, sb = b % 1024, swz = sb ^ (((sb >> 9) & 1) << 5); R = (st >> 1) * 16 + swz / 64; C = (st & 1) * 32 + (swz % 64) / 2; }
DI int perm32(int rho) { const int n = rho >> 4, i = rho & 15; return 8 * (i >> 2) + 4 * n + (i & 3); }

struct Unit { int pm, pn; long aoff, boff; };
struct Gemm { const bf16_t* A; const bf16_t* Bt; int lda, ldb, K; };
struct Sched {
    int nM, nN, nwg, G, c, mode; long astep, bstep, srcstride;
    DI void init(int nM_, int nN_, int G_, int c_, long astep_, long bstep_) { nM = nM_; nN = nN_; nwg = nM * nN; G = G_; c = c_; mode = 0; astep = astep_; bstep = bstep_; srcstride = 0; }
    DI bool next(int i, Unit& u) const {
        const long L = (long)i * G + c; if (L >= nwg) return false;
        int wgid = (int)L;
        if (mode == 1) {
            const int pm = wgid & 15, ks = (wgid >> 4) & 7, src = wgid >> 7;
            u.pm = pm; u.pn = src + 2 * ks; u.aoff = (long)src * srcstride + (long)pm * 256 * 2048 * 2 + (long)ks * 1024; u.boff = (long)ks * 1024; return true;
        }
        { const int q = nwg / NXCD, r = nwg % NXCD, xcd = wgid % NXCD, off = wgid / NXCD; wgid = (xcd < r ? xcd * (q + 1) : r * (q + 1) + (xcd - r) * q) + off; }
        const int nig = WGM * nN, gid = wgid / nig, fm = gid * WGM, gsz = (nM - fm) < WGM ? (nM - fm) : WGM;
        u.pm = fm + ((wgid % nig) % gsz); u.pn = (wgid % nig) / gsz; u.aoff = (long)u.pm * astep; u.boff = (long)u.pn * bstep; return true;
    }
};

template <class Epi>
DI void gemm_phase(LAS unsigned char* lds, const Gemm g, const Sched& S, const Epi& E) {
    const int tid = otid(), wid = __builtin_amdgcn_readfirstlane(tid >> 6), lane = tid & 63, wr = wid >> 2, wc = wid & 3, fr = lane & 15, fq = lane >> 4;
    const int K = g.K, nt = K / BK;
    unsigned voffA[2], voffB[2];
#pragma unroll
    for (int i = 0; i < 2; ++i) { int R, C; stage_rc(tid * 16 + i * 8192, R, C); const int Rb = Epi::PERM ? ((R & ~31) + perm32(R & 31)) : R;
        voffA[i] = (unsigned)(R * g.lda + C) * 2u; voffB[i] = (unsigned)(Rb * g.ldb + C) * 2u; }
    const size_t kstep = (size_t)(BK * 2);
    const size_t hsA = (size_t)HALF * g.lda * 2, hsB = (size_t)HALF * g.ldb * 2;
    const unsigned ldsw = (unsigned)wid * 1024u;
    const int aoff = lds_byte(wr * 64 + fr, fq * 8), boff = lds_byte(wc * 32 + fr, fq * 8);
#define PG8_SA(b, h) (((b) * 2 + (h)) * HTB)
#define PG8_SB(b, h) ((4 + (b) * 2 + (h)) * HTB)
#define PG8_STAGE(bufoff, gbase, voff) do { _Pragma("unroll") for (int _i = 0; _i < 2; ++_i) \
        __builtin_amdgcn_global_load_lds((const unsigned*)((const char*)(gbase) + (voff)[_i]), (LAS unsigned*)(lds + (bufoff) + ldsw + _i * 8192), 16, 0, 0); } while (0)
#define PG8_LDA(dst, b, h) do { _Pragma("unroll") for (int m = 0; m < 4; ++m) _Pragma("unroll") for (int k = 0; k < 2; ++k) dst[m][k] = *(const LAS bf16x8*)(lds + PG8_SA(b, h) + aoff + m * 2048 + k * 1024); } while (0)
#define PG8_LDB(dst, b, h) do { _Pragma("unroll") for (int n = 0; n < 2; ++n) _Pragma("unroll") for (int k = 0; k < 2; ++k) dst[n][k] = *(const LAS bf16x8*)(lds + PG8_SB(b, h) + boff + n * 2048 + k * 1024); } while (0)
#define PG8_MMA(ai, bj, At, Bt) do { __builtin_amdgcn_s_setprio(1); _Pragma("unroll") for (int m = 0; m < 4; ++m) _Pragma("unroll") for (int n = 0; n < 2; ++n) _Pragma("unroll") for (int k = 0; k < 2; ++k) \
        acc[ai][bj][m][n] = __builtin_amdgcn_mfma_f32_16x16x32_bf16(Bt[n][k], At[m][k], acc[ai][bj][m][n], 0, 0, 0); __builtin_amdgcn_s_setprio(0); } while (0)
#define PG8_WAIT_V(n) asm volatile("s_waitcnt vmcnt(" #n ")" ::: "memory")
#define PG8_WAIT_L(n) asm volatile("s_waitcnt lgkmcnt(" #n ")" ::: "memory")
#define PG8_BAR __builtin_amdgcn_s_barrier()
#define PG8_SCHED __builtin_amdgcn_sched_barrier(0)
    Unit cur, nxt; int ui = 0;
    if (!S.next(0, cur)) return;
    f32x4 acc[2][2][4][2];
#pragma unroll
    for (int a = 0; a < 2; ++a)
#pragma unroll
        for (int b = 0; b < 2; ++b)
#pragma unroll
            for (int m = 0; m < 4; ++m)
#pragma unroll
                for (int n = 0; n < 2; ++n) acc[a][b][m][n] = (f32x4){0.f, 0.f, 0.f, 0.f};
    bf16x8 At[4][2], B0[2][2], B1[2][2];
    const char* cA = (const char*)g.A + cur.aoff; const char* cB = (const char*)g.Bt + cur.boff;
    PG8_STAGE(PG8_SB(0, 0), cB, voffB); PG8_STAGE(PG8_SB(0, 1), cB + hsB, voffB); PG8_STAGE(PG8_SA(0, 0), cA, voffA); PG8_STAGE(PG8_SA(0, 1), cA + hsA, voffA);
    if (wr == 1) PG8_BAR;
    PG8_WAIT_V(2); PG8_BAR;
    PG8_STAGE(PG8_SB(1, 0), cB + kstep, voffB); PG8_STAGE(PG8_SA(1, 0), cA + kstep, voffA); PG8_STAGE(PG8_SB(1, 1), cB + hsB + kstep, voffB);
    PG8_WAIT_V(6); PG8_BAR;
    for (;;) {
        const bool has_next = S.next(ui + 1, nxt);
        const char* nA = has_next ? (const char*)g.A + nxt.aoff : cA; const char* nB = has_next ? (const char*)g.Bt + nxt.boff : cB;
        for (int t = 0; t < nt; t += 2) {
            const bool last = (t == nt - 2);
            const char* a1 = cA + (size_t)(t + 1) * kstep;
            const char* a2 = last ? nA : cA + (size_t)(t + 2) * kstep; const char* b2 = last ? nB : cB + (size_t)(t + 2) * kstep;
            const char* a3 = a2 + kstep; const char* b3 = b2 + kstep;
            PG8_LDB(B0, 0, 0); PG8_LDB(B1, 0, 1); PG8_SCHED; PG8_LDA(At, 0, 0); PG8_STAGE(PG8_SA(1, 1), a1 + hsA, voffA);
            PG8_WAIT_V(8); PG8_WAIT_L(0); PG8_BAR; PG8_MMA(0, 0, At, B0); PG8_MMA(0, 1, At, B1); PG8_BAR; PG8_SCHED;
            PG8_LDA(At, 0, 1); PG8_STAGE(PG8_SB(0, 0), b2, voffB); PG8_STAGE(PG8_SB(0, 1), b2 + hsB, voffB); PG8_STAGE(PG8_SA(0, 0), a2, voffA);
            PG8_WAIT_V(8); PG8_WAIT_L(0); PG8_BAR; PG8_MMA(1, 0, At, B0); PG8_MMA(1, 1, At, B1); PG8_BAR; PG8_SCHED;
            PG8_LDB(B0, 1, 0); PG8_LDB(B1, 1, 1); PG8_SCHED; PG8_LDA(At, 1, 0); PG8_STAGE(PG8_SA(0, 1), a2 + hsA, voffA);
            PG8_WAIT_V(8); PG8_WAIT_L(0); PG8_BAR; PG8_MMA(0, 0, At, B0); PG8_MMA(0, 1, At, B1); PG8_BAR; PG8_SCHED;
            PG8_LDA(At, 1, 1); PG8_STAGE(PG8_SB(1, 0), b3, voffB); PG8_STAGE(PG8_SB(1, 1), b3 + hsB, voffB); PG8_STAGE(PG8_SA(1, 0), a3, voffA);
            PG8_WAIT_V(8); PG8_WAIT_L(0); PG8_BAR; PG8_MMA(1, 0, At, B0); PG8_MMA(1, 1, At, B1); PG8_BAR; PG8_SCHED;
        }
        if (wr == 0) PG8_BAR;
        E(acc, cur, wr, wc, fr, fq);
        if (!has_next) break;
#pragma unroll
        for (int a = 0; a < 2; ++a)
#pragma unroll
            for (int b = 0; b < 2; ++b)
#pragma unroll
                for (int m = 0; m < 4; ++m)
#pragma unroll
                    for (int n = 0; n < 2; ++n) acc[a][b][m][n] = (f32x4){0.f, 0.f, 0.f, 0.f};
        cur = nxt; cA = nA; cB = nB; ++ui;
        if (wr == 1) PG8_BAR;
    }
    PG8_WAIT_V(0);
    PG8_BAR;
#undef PG8_SA
#undef PG8_SB
#undef PG8_STAGE
#undef PG8_LDA
#undef PG8_LDB
#undef PG8_MMA
#undef PG8_WAIT_V
#undef PG8_WAIT_L
#undef PG8_BAR
#undef PG8_SCHED
}
}
using pg8::Unit;
typedef f32x4 AccT[2][2][4][2];

struct EpiFFN {
    static constexpr bool PERM = true; bf16_t* H;
    DI void operator()(const AccT& acc, const Unit& u, int wr, int wc, int fr, int fq) const {
        const int col = u.pn * 128 + wc * 32 + fq * 8;
#pragma unroll
        for (int ai = 0; ai < 2; ++ai)
#pragma unroll
            for (int m = 0; m < 4; ++m) {
                const int row = u.pm * 256 + ai * 128 + wr * 64 + m * 16 + fr;
                float v[8];
#pragma unroll
                for (int n = 0; n < 2; ++n)
#pragma unroll
                    for (int e = 0; e < 4; ++e) { const float gt = acc[ai][0][m][n][e], up = acc[ai][1][m][n][e]; v[n * 4 + e] = gt * sigm(gt) * up; }
                u32x4 w; w.x = pk2(v[0], v[1]); w.y = pk2(v[2], v[3]); w.z = pk2(v[4], v[5]); w.w = pk2(v[6], v[7]);
                *(u32x4*)(H + (size_t)row * DFF + col) = w;
            }
    }
};
struct EpiF32 {
    static constexpr bool PERM = false; float* O;
    DI void operator()(const AccT& acc, const Unit& u, int wr, int wc, int fr, int fq) const {
#pragma unroll
        for (int ai = 0; ai < 2; ++ai)
#pragma unroll
            for (int m = 0; m < 4; ++m) {
                const int row = u.pm * 256 + ai * 128 + wr * 64 + m * 16 + fr;
#pragma unroll
                for (int bj = 0; bj < 2; ++bj)
#pragma unroll
                    for (int n = 0; n < 2; ++n) *(f32x4*)(O + (size_t)row * DM + u.pn * 256 + bj * 128 + wc * 32 + n * 16 + fq * 4) = acc[ai][bj][m][n];
            }
    }
};
struct EpiPart {
    static constexpr bool PERM = false; float* P;
    DI void operator()(const AccT& acc, const Unit& u, int wr, int wc, int fr, int fq) const {
        const int src = u.pn & 1, ks = u.pn >> 1;
        float* base = P + ((size_t)(ks * 2 + src) * 4096) * 128;
#pragma unroll
        for (int ai = 0; ai < 2; ++ai)
#pragma unroll
            for (int m = 0; m < 4; ++m) {
                const int row = u.pm * 256 + ai * 128 + wr * 64 + m * 16 + fr;
#pragma unroll
                for (int n = 0; n < 2; ++n) { const f32x4 v = src ? acc[ai][1][m][n] : acc[ai][0][m][n]; *(f32x4*)(base + (size_t)row * 128 + wc * 32 + n * 16 + fq * 4) = v; }
            }
    }
};
struct EpiVT {
    static constexpr bool PERM = true; bf16_t* VT0; bf16_t* VT1;
    DI void operator()(const AccT& acc, const Unit& u, int wr, int wc, int fr, int fq) const {
#pragma unroll
        for (int ai = 0; ai < 2; ++ai)
#pragma unroll
            for (int m = 0; m < 4; ++m) {
                const int r = u.pm * 256 + ai * 128 + wr * 64 + m * 16 + fr;
                const int piece = r >> 9, gg = (r >> 7) & 3, d = r & 127;
                bf16_t* base = piece ? VT1 : VT0;
#pragma unroll
                for (int bj = 0; bj < 2; ++bj) {
                    const int t = u.pn * 256 + bj * 128 + wc * 32 + fq * 8, b = t >> 11, s = t & 2047;
                    const f32x4 v0 = acc[ai][bj][m][0], v1 = acc[ai][bj][m][1];
                    u32x4 w; w.x = pk2(v0[0], v0[1]); w.y = pk2(v0[2], v0[3]); w.z = pk2(v1[0], v1[1]); w.w = pk2(v1[2], v1[3]);
                    *(u32x4*)(base + ((size_t)((b * 4 + gg) * 128 + d)) * 2048 + s) = w;
                }
            }
    }
};
struct EpiGate {
    static constexpr bool PERM = true; const bf16_t* MG; const bf16_t* YAG; bf16_t* O; int mode;
    DI void operator()(const AccT& acc, const Unit& u, int wr, int wc, int fr, int fq) const {
#pragma unroll
        for (int ai = 0; ai < 2; ++ai)
#pragma unroll
            for (int m = 0; m < 4; ++m) {
                const int row = u.pm * 256 + ai * 128 + wr * 64 + m * 16 + fr;
#pragma unroll
                for (int bj = 0; bj < 2; ++bj) {
                    const int col = u.pn * 256 + bj * 128 + wc * 32 + fq * 8;
                    const u32x4 gw = *(const u32x4*)(MG + (size_t)row * 4096 + (mode ? 2048 : 0) + col);
                    const f32x4 v0 = acc[ai][bj][m][0], v1 = acc[ai][bj][m][1];
                    float o[8] = {v0[0] * bflo(gw.x), v0[1] * bfhi(gw.x), v0[2] * bflo(gw.y), v0[3] * bfhi(gw.y), v1[0] * bflo(gw.z), v1[1] * bfhi(gw.z), v1[2] * bflo(gw.w), v1[3] * bfhi(gw.w)};
                    if (mode) { const u32x4 yw = *(const u32x4*)(YAG + (size_t)row * DM + col);
                        o[0] += bflo(yw.x); o[1] += bfhi(yw.x); o[2] += bflo(yw.y); o[3] += bfhi(yw.y); o[4] += bflo(yw.z); o[5] += bfhi(yw.z); o[6] += bflo(yw.w); o[7] += bfhi(yw.w); }
                    u32x4 w; w.x = pk2(o[0], o[1]); w.y = pk2(o[2], o[3]); w.z = pk2(o[4], o[5]); w.w = pk2(o[6], o[7]);
                    *(u32x4*)(O + (size_t)row * DM + col) = w;
                }
            }
    }
};
struct EpiIn {
    static constexpr bool PERM = true; unsigned char* ws; const float* rope;
    DI void operator()(const AccT& acc, const Unit& u, int wr, int wc, int fr, int fq) const {
#pragma unroll
        for (int bj = 0; bj < 2; ++bj) {
            const int c0 = u.pn * 256 + bj * 128 + wc * 32;
            const int col = c0 + fq * 8;
#pragma unroll
            for (int ai = 0; ai < 2; ++ai)
#pragma unroll
                for (int m = 0; m < 4; ++m) {
                    const int row = u.pm * 256 + ai * 128 + wr * 64 + m * 16 + fr;
                    const int b = row >> 11, s = row & 2047;
                    float v[8];
#pragma unroll
                    for (int n = 0; n < 2; ++n)
#pragma unroll
                        for (int e = 0; e < 4; ++e) v[n * 4 + e] = acc[ai][bj][m][n][e];
                    bf16_t* dst = nullptr;
                    if (c0 < 2048) { dst = (bf16_t*)(ws + WS_XA) + (size_t)row * DM + col; }
                    else if (c0 < 4096) {
#pragma unroll
                        for (int e = 0; e < 8; ++e) v[e] = gelu_t(v[e]);
                        dst = (bf16_t*)(ws + WS_GY) + (size_t)row * DM + (col - 2048); }
                    else if (c0 < 8192) {
                        const bool isq = c0 < 6144;
                        const int pc = (c0 - 6144) >> 9;
                        if ((c0 & 127) == 0 && (isq || pc != 1)) {
                            const float* rp = rope + (size_t)s * 32 + 8 * (fq & 1);
                            const f32x4 cA = *(const f32x4*)(rp), cB = *(const f32x4*)(rp + 4), sA = *(const f32x4*)(rp + 16), sB = *(const f32x4*)(rp + 20);
                            const float cs[8] = {cA[0], cA[1], cA[2], cA[3], cB[0], cB[1], cB[2], cB[3]}, sn[8] = {sA[0], sA[1], sA[2], sA[3], sB[0], sB[1], sB[2], sB[3]};
#pragma unroll
                            for (int e = 0; e < 8; ++e) { const float mine = v[e], other = __shfl_xor(mine, 32); v[e] = (fq < 2) ? mine * cs[e] - other * sn[e] : mine * cs[e] + other * sn[e]; }
                        }
                        if (isq) dst = (bf16_t*)(ws + WS_Q) + (size_t)row * DM + (col - 4096);
                        else { const int gg = ((c0 - 6144) >> 7) & 3, d = col & 127; dst = (bf16_t*)(ws + WS_KC + (size_t)pc * 16 * MiB) + ((size_t)((b * 4 + gg) * 2048 + s)) * 128 + d; }
                    }
                    else if (c0 < 12288) {
#pragma unroll
                        for (int e = 0; e < 8; ++e) v[e] = sigm(v[e]);
                        dst = (bf16_t*)(ws + WS_MG) + (size_t)row * 4096 + (col - 8192); }
                    else {
                        const int cc = col - 12288;
                        if (cc < 48) { float* ng = (float*)(ws + WS_NG) + (size_t)row * 48 + cc;
                            *(f32x4*)ng = (f32x4){sigm(v[0]), sigm(v[1]), sigm(v[2]), sigm(v[3])}; *(f32x4*)(ng + 4) = (f32x4){sigm(v[4]), sigm(v[5]), sigm(v[6]), sigm(v[7])}; }
                    }
                    if (dst) { u32x4 w; w.x = pk2(v[0], v[1]); w.y = pk2(v[2], v[3]); w.z = pk2(v[4], v[5]); w.w = pk2(v[6], v[7]); *(u32x4*)dst = w; }
                }
        }
    }
};

struct ConvJob { int K, Nd; };
DI const float* conv_src(int job, int d, KArgs a, int& ld) {
    switch (job) {
    case 0: case 9: { const int pn = d >> 8, half = (d >> 7) & 1, j = d & 127; ld = DFF; const int base = job == 0 ? 6 : 30; return a->in[base + half] + 128 * pn + j; }
    case 1: ld = DM; return a->in[8] + d;
    case 10: ld = DM; return a->in[32] + d;
    case 2: { ld = INW; int col;
        if (d < 7680) col = d; else if (d < 8192) col = d + 512; else if (d < 12288) col = d - 8192 + 9264; else if (d < 12336) col = d - 12288 + 9216; else return nullptr;
        return a->in[11] + col; }
    case 3: ld = INW; return a->in[11] + (d < 512 ? 7680 + d : 8704 + (d - 512));
    case 4: ld = DM; return a->in[25] + d;
    case 5: ld = DM; return a->in[26] + d;
    case 6: ld = DM; return a->in[27] + d;
    case 7: ld = 128; return (d < 128) ? a->in[20] + d : a->in[23] + (d - 128);
    case 8: { const int h = d >> 8, half = (d >> 7) & 1, j = d & 127; ld = 128; return (half ? a->in[16] : a->in[14]) + h * 16384 + j; }
    default: ld = 128; return (d < 128) ? a->in[21] + d : a->in[24] + (d - 128);
    }
}
DI bf16_t* conv_dst(int job, unsigned char* ws) {
    switch (job) {
    case 0: case 9: return (bf16_t*)(ws + WS_WGU);
    case 1: case 10: return (bf16_t*)(ws + WS_WD);
    case 2: return (bf16_t*)(ws + WS_WIN);
    case 3: return (bf16_t*)(ws + WS_WV);
    case 4: return (bf16_t*)(ws + WS_WA);
    case 5: return (bf16_t*)(ws + WS_WB);
    case 6: return (bf16_t*)(ws + WS_WO);
    case 7: return (bf16_t*)(ws + WS_W1T);
    case 8: return (bf16_t*)(ws + WS_WRI);
    default: return (bf16_t*)(ws + WS_W2T);
    }
}
DI void conv_dims(int job, int& K, int& Nd) {
    switch (job) {
    case 0: case 9: K = DM; Nd = 11264; break;
    case 1: case 10: K = DFF; Nd = DM; break;
    case 2: K = DM; Nd = 12544; break;
    case 3: K = DM; Nd = 1024; break;
    case 4: case 5: case 6: K = DM; Nd = DM; break;
    case 7: K = 4096; Nd = 256; break;
    case 8: K = 128; Nd = 4096; break;
    default: K = 128; Nd = 256; break;
    }
}
DI void conv_item(int job, int item, KArgs a, LAS float* scr, int lane) {
    int K, Nd; conv_dims(job, K, Nd);
    const int nblk = Nd / 32, kb = item / nblk, nb = item % nblk, k0 = 64 * kb, n0 = 32 * nb;
    int ld; const float* src = conv_src(job, n0 + (lane & 31), a, ld);
#pragma unroll 8
    for (int i = 0; i < 32; ++i) { const int kk = 2 * i + (lane >> 5); scr[kk * 33 + (lane & 31)] = src ? src[(size_t)(k0 + kk) * ld] : 0.f; }
    LDS_WAIT();
    bf16_t* WT = conv_dst(job, a->ws);
    const int c = lane & 7;
#pragma unroll
    for (int j = 0; j < 4; ++j) { const int n = (lane >> 3) + 8 * j; const LAS float* s = scr + (8 * c) * 33 + n;
        u32x4 o; o.x = pk2(s[0 * 33], s[1 * 33]); o.y = pk2(s[2 * 33], s[3 * 33]); o.z = pk2(s[4 * 33], s[5 * 33]); o.w = pk2(s[6 * 33], s[7 * 33]);
        *(u32x4*)(WT + (size_t)(n0 + n) * K + k0 + 8 * c) = o; }
    LDS_WAIT();
}
DI void conv_jobs(int jlo, int jhi, KArgs a, LAS unsigned char* lds, int gw, int ngw, int wave, int lane) {
    LAS float* scr = (LAS float*)(lds + wave * 8704);
    for (int job = jlo; job < jhi; ++job) {
        int K, Nd; conv_dims(job, K, Nd);
        const int nit = (K / 64) * (Nd / 32);
        for (int it = gw; it < nit; it += ngw) conv_item(job, it, a, scr, lane);
    }
}

DI void row_load(f32x4 (&v)[8], const float* p, int lane) {
#pragma unroll
    for (int j = 0; j < 8; ++j) v[j] = *(const f32x4*)(p + 256 * j + 4 * lane);
}
DI float row_rstd(const f32x4 (&v)[8]) {
    float s = 0.f;
#pragma unroll
    for (int j = 0; j < 8; ++j) s += (v[j][0] * v[j][0] + v[j][1] * v[j][1]) + (v[j][2] * v[j][2] + v[j][3] * v[j][3]);
    return rsqrtf(wave_sum(s) * (1.f / DM) + EPS);
}
DI void row_modulate_store(const f32x4 (&v)[8], float rstd, const float* g, const float* sh, const float* sc, bf16_t* o, int lane) {
#pragma unroll
    for (int j = 0; j < 8; ++j) { const int c = 256 * j + 4 * lane; const f32x4 gg = *(const f32x4*)(g + c), s1 = *(const f32x4*)(sh + c), s2 = *(const f32x4*)(sc + c);
        const f32x4 r = (v[j] * rstd * gg) * (s2 + 1.f) + s1; u32x2 w; w.x = pk2(r[0], r[1]); w.y = pk2(r[2], r[3]); *(u32x2*)(o + c) = w; }
}
DI void row_residual(f32x4 (&v)[8], const float* f, const float* xres, const float* gate, const float* pg, float wgt, float* xo, int lane) {
    f32x4 fv[8]; row_load(fv, f, lane); const float rs = row_rstd(fv);
#pragma unroll
    for (int j = 0; j < 8; ++j) { const int c = 256 * j + 4 * lane; const f32x4 xr = *(const f32x4*)(xres + c), gt = *(const f32x4*)(gate + c), pp = *(const f32x4*)(pg + c);
        v[j] = xr + (gt * wgt) * (fv[j] * rs * pp); *(f32x4*)(xo + c) = v[j]; }
}

#define MFMA32(a, b, c) __builtin_amdgcn_mfma_f32_32x32x16_bf16((a), (b), (c), 0, 0, 0)
DI int crow(int r, int hi) { return (r & 3) + 8 * (r >> 2) + 4 * hi; }
constexpr int KPITCH = 272, VPITCH = 136, KVBUF = 17408;
constexpr int AL_K = 0, AL_V = 2 * KVBUF, AL_IMP4 = 4 * KVBUF, AL_IMPS = AL_IMP4 + 32768, AL_SEL = AL_IMPS + 8192;
constexpr float NEGB = -1e30f;
struct KVRegs { u32x4 k0, k1, v0, v1; };
DI void kv_load(KVRegs& R, const bf16_t* Kt, const bf16_t* Vt, int vpitch, int tid) {
    const int c = tid, c2 = tid + 512;
    R.k0 = *(const u32x4*)(Kt + (c >> 4) * 128 + (c & 15) * 8); R.k1 = *(const u32x4*)(Kt + (c2 >> 4) * 128 + (c2 & 15) * 8);
    R.v0 = *(const u32x4*)(Vt + (size_t)(c >> 3) * vpitch + (c & 7) * 8); R.v1 = *(const u32x4*)(Vt + (size_t)(c2 >> 3) * vpitch + (c2 & 7) * 8);
}
DI void kv_store(const KVRegs& R, LAS unsigned char* KB, LAS unsigned char* VB, int tid) {
    const int c = tid, c2 = tid + 512;
    *(LAS u32x4*)(KB + (c >> 4) * KPITCH + (c & 15) * 16) = R.k0; *(LAS u32x4*)(KB + (c2 >> 4) * KPITCH + (c2 & 15) * 16) = R.k1;
    LAS unsigned char* p = VB + (c >> 3) * VPITCH + (c & 7) * 16; *(LAS u32x2*)p = (u32x2){R.v0.x, R.v0.y}; *(LAS u32x2*)(p + 8) = (u32x2){R.v0.z, R.v0.w};
    p = VB + (c2 >> 3) * VPITCH + (c2 & 7) * 16; *(LAS u32x2*)p = (u32x2){R.v1.x, R.v1.y}; *(LAS u32x2*)(p + 8) = (u32x2){R.v1.z, R.v1.w};
}
DI void qk_tile(f32x16& p0, f32x16& p1, const LAS unsigned char* KB, const bf16x8 (&qr)[8], int r, int hi) {
#pragma unroll
    for (int i = 0; i < 16; ++i) { p0[i] = 0.f; p1[i] = 0.f; }
#pragma unroll
    for (int d0 = 0; d0 < 8; ++d0) {
        const bf16x8 a0 = *(const LAS bf16x8*)(KB + r * KPITCH + d0 * 32 + hi * 16), a1 = *(const LAS bf16x8*)(KB + (32 + r) * KPITCH + d0 * 32 + hi * 16);
        p0 = MFMA32(a0, qr[d0], p0); p1 = MFMA32(a1, qr[d0], p1);
    }
}
DI bf16x8 pack8(const f32x16& p, int s2) {
    u32x4 w; w.x = pk2(p[8 * s2], p[8 * s2 + 1]); w.y = pk2(p[8 * s2 + 2], p[8 * s2 + 3]); w.z = pk2(p[8 * s2 + 4], p[8 * s2 + 5]); w.w = pk2(p[8 * s2 + 6], p[8 * s2 + 7]);
    return __builtin_bit_cast(bf16x8, w);
}
DI void pv_tile(f32x16 (&o)[4], const LAS unsigned char* VB, const f32x16& p0, const f32x16& p1, int r, int hi) {
#pragma unroll
    for (int kb = 0; kb < 2; ++kb)
#pragma unroll
        for (int s2 = 0; s2 < 2; ++s2) {
            const bf16x8 pf = pack8(kb ? p1 : p0, s2);
#pragma unroll
            for (int db = 0; db < 4; ++db) {
                const LAS unsigned char* base = VB + (32 * db + r) * VPITCH + (32 * kb + 16 * s2 + 4 * hi) * 2;
                const s16x4 lo = *(const LAS s16x4*)base, hh = *(const LAS s16x4*)(base + 16);
                const bf16x8 af = __builtin_shufflevector(lo, hh, 0, 1, 2, 3, 4, 5, 6, 7);
                o[db] = MFMA32(af, pf, o[db]);
            }
        }
}
constexpr float SCL = 0.08838834764831845f * 1.4426950408889634f;

DI void flash_step(f32x16 (&o)[4], float& mrun, float& lrun, const LAS unsigned char* KB, const LAS unsigned char* VB, const bf16x8 (&qr)[8],
                   int r, int hi, int qpos, int key0, bool rowok, bool need_c, bool need_w) {
    f32x16 p0, p1; qk_tile(p0, p1, KB, qr, r, hi);
    float mt = NEGB;
#pragma unroll
    for (int i = 0; i < 16; ++i) {
        const int k0 = key0 + crow(i, hi), k1 = k0 + 32;
        bool v0 = rowok, v1 = rowok;
        if (need_c) { v0 = v0 && (k0 <= qpos); v1 = v1 && (k1 <= qpos); }
        if (need_w) { v0 = v0 && (k0 > qpos - 512); v1 = v1 && (k1 > qpos - 512); }
        p0[i] = v0 ? p0[i] * SCL : NEGB; p1[i] = v1 ? p1[i] * SCL : NEGB;
        mt = fmaxf(mt, fmaxf(p0[i], p1[i]));
    }
    mt = fmaxf(mt, __shfl_xor(mt, 32));
    const float mnew = fmaxf(mrun, mt);
    const float alpha = __builtin_amdgcn_exp2f(mrun - mnew);
    float ls = 0.f;
#pragma unroll
    for (int i = 0; i < 16; ++i) {
        p0[i] = (p0[i] > -1e29f) ? __builtin_amdgcn_exp2f(p0[i] - mnew) : 0.f;
        p1[i] = (p1[i] > -1e29f) ? __builtin_amdgcn_exp2f(p1[i] - mnew) : 0.f;
        ls += p0[i] + p1[i];
    }
    lrun = lrun * alpha + ls;
    if (__any(mnew > mrun)) {
#pragma unroll
        for (int db = 0; db < 4; ++db)
#pragma unroll
            for (int i = 0; i < 16; ++i) o[db][i] *= alpha;
    }
    mrun = mnew;
    pv_tile(o, VB, p0, p1, r, hi);
}

DI void nsa_unit(int bg, int qblk, unsigned char* ws, LAS unsigned char* lds) {
    const int tid = otid(), lane = tid & 63, r = lane & 31, hi = lane >> 5, wave = __builtin_amdgcn_readfirstlane(tid >> 6);
    const int b = bg >> 2, g = bg & 3, head = g * 4 + (wave >> 1), q0 = qblk * 64, qw0 = q0 + 32 * (wave & 1), qpos = qw0 + r;
    const size_t trow = (size_t)b * SEQ + qpos;
    bf16_t* Qp = (bf16_t*)(ws + WS_Q) + trow * DM + head * 128;
    bf16x8 qr[8];
#pragma unroll
    for (int d0 = 0; d0 < 8; ++d0) qr[d0] = *(const bf16x8*)(Qp + d0 * 16 + hi * 8);
    const float* ngp = (const float*)(ws + WS_NG) + trow * 48 + head * 3;
    const float g0 = ngp[0], g1 = ngp[1], g2 = ngp[2];
    LAS unsigned char* KB0 = lds + AL_K; LAS unsigned char* VB0 = lds + AL_V;
    LAS float* IMP4 = (LAS float*)(lds + AL_IMP4); LAS float* IMPS = (LAS float*)(lds + AL_IMPS); LAS unsigned* SEL = (LAS unsigned*)(lds + AL_SEL);
    unsigned opk[4][8];
    KVRegs R;
    {
        const bf16_t* kc = (const bf16_t*)(ws + WS_KCC) + (size_t)bg * 128 * 128;
        const bf16_t* vct = (const bf16_t*)(ws + WS_VCT) + (size_t)bg * 128 * 128;
        kv_load(R, kc, vct, 128, tid); kv_store(R, KB0, VB0, tid);
        kv_load(R, kc + 64 * 128, vct + 64, 128, tid); kv_store(R, KB0 + KVBUF, VB0 + KVBUF, tid);
        if (tid < 65) SEL[tid] = 0u;
        __syncthreads();
        f32x16 pa0, pa1, pb0, pb1;
        qk_tile(pa0, pa1, KB0, qr, r, hi); qk_tile(pb0, pb1, KB0 + KVBUF, qr, r, hi);
        float mt = NEGB;
#pragma unroll
        for (int i = 0; i < 16; ++i) {
            const int n = crow(i, hi);
            pa0[i] = (16 * n + 31 <= qpos) ? pa0[i] * SCL : NEGB; pa1[i] = (16 * (n + 32) + 31 <= qpos) ? pa1[i] * SCL : NEGB;
            pb0[i] = (16 * (n + 64) + 31 <= qpos) ? pb0[i] * SCL : NEGB; pb1[i] = (16 * (n + 96) + 31 <= qpos) ? pb1[i] * SCL : NEGB;
            mt = fmaxf(fmaxf(mt, fmaxf(pa0[i], pa1[i])), fmaxf(pb0[i], pb1[i]));
        }
        mt = fmaxf(mt, __shfl_xor(mt, 32));
        float ls = 0.f;
#pragma unroll
        for (int i = 0; i < 16; ++i) {
            pa0[i] = (pa0[i] > -1e29f) ? __builtin_amdgcn_exp2f(pa0[i] - mt) : 0.f; pa1[i] = (pa1[i] > -1e29f) ? __builtin_amdgcn_exp2f(pa1[i] - mt) : 0.f;
            pb0[i] = (pb0[i] > -1e29f) ? __builtin_amdgcn_exp2f(pb0[i] - mt) : 0.f; pb1[i] = (pb1[i] > -1e29f) ? __builtin_amdgcn_exp2f(pb1[i] - mt) : 0.f;
            ls += (pa0[i] + pa1[i]) + (pb0[i] + pb1[i]);
        }
        ls += __shfl_xor(ls, 32);
        const float inv = ls > 0.f ? 1.f / ls : 0.f;
#pragma unroll
        for (int i = 0; i < 16; ++i) { pa0[i] *= inv; pa1[i] *= inv; pb0[i] *= inv; pb1[i] *= inv; }
        if (qblk >= 16) {
            LAS float* ip = IMP4 + ((wave >> 1) * 64 + 32 * (wave & 1) + r) * 32;
#define IMP_G(P, blk) _Pragma("unroll") for (int g4 = 0; g4 < 4; ++g4) ip[8 * (blk) + 2 * g4 + hi] = (P[4 * g4] + P[4 * g4 + 1]) + (P[4 * g4 + 2] + P[4 * g4 + 3]);
            IMP_G(pa0, 0) IMP_G(pa1, 1) IMP_G(pb0, 2) IMP_G(pb1, 3)
            LDS_WAIT();
#define IMP_L(P, blk) _Pragma("unroll") for (int g4 = 0; g4 < 4; ++g4) { const int j1 = 8 * (blk) + 2 * g4 + hi + 1; if (j1 < 32) ip[j1] += P[4 * g4 + 3]; }
            IMP_L(pa0, 0) IMP_L(pa1, 1) IMP_L(pb0, 2) IMP_L(pb1, 3)
#undef IMP_G
#undef IMP_L
        }
        f32x16 oc[4];
#pragma unroll
        for (int db = 0; db < 4; ++db)
#pragma unroll
            for (int i = 0; i < 16; ++i) oc[db][i] = 0.f;
        pv_tile(oc, VB0, pa0, pa1, r, hi); pv_tile(oc, VB0 + KVBUF, pb0, pb1, r, hi);
#pragma unroll
        for (int db = 0; db < 4; ++db)
#pragma unroll
            for (int i = 0; i < 8; ++i) opk[db][i] = pk2(oc[db][2 * i] * g0, oc[db][2 * i + 1] * g0);
    }
    __syncthreads();
    if (qblk >= 16) {
#pragma unroll
        for (int e = 0; e < 4; ++e) { const int idx = tid + 512 * e; IMPS[idx] = (IMP4[idx] + IMP4[2048 + idx]) + (IMP4[4096 + idx] + IMP4[6144 + idx]); }
        __syncthreads();
        const int q = tid >> 3;
        float val[32];
#pragma unroll
        for (int j4 = 0; j4 < 8; ++j4) { const f32x4 t4 = *(const LAS f32x4*)(IMPS + q * 32 + 4 * j4); val[4 * j4] = t4[0]; val[4 * j4 + 1] = t4[1]; val[4 * j4 + 2] = t4[2]; val[4 * j4 + 3] = t4[3]; }
        unsigned bits = 0u;
#pragma unroll
        for (int e = 0; e < 4; ++e) {
            const int j = (tid & 7) * 4 + e;
            float vj = 0.f;
#pragma unroll
            for (int i = 0; i < 32; ++i) vj = (i == j) ? val[i] : vj;
            int rank = 0;
#pragma unroll
            for (int i = 1; i < 32; ++i) { const bool cand = (i <= qblk - 2); rank += (cand && (val[i] > vj || (val[i] == vj && i < j))) ? 1 : 0; }
            const bool forced = (j == 0) || (j == qblk) || (j == qblk - 1);
            const bool sel = forced || (j >= 1 && j <= qblk - 2 && rank < 13);
            bits |= sel ? (1u << j) : 0u;
        }
        __hip_atomic_fetch_or(SEL + q, bits, __ATOMIC_RELAXED, __HIP_MEMORY_SCOPE_WORKGROUP);
        __syncthreads();
    } else {
        if (tid < 64) SEL[tid] = (2u << qblk) - 1u;
        __syncthreads();
    }
    if (tid < 64) { unsigned v = SEL[tid];
#pragma unroll
        for (int o = 1; o < 64; o <<= 1) v |= __shfl_xor(v, o);
        if (tid == 0) SEL[64] = v; }
    __syncthreads();
    const unsigned mysel = SEL[32 * (wave & 1) + r];
    unsigned uni = (unsigned)__builtin_amdgcn_readfirstlane(SEL[64]) & ((2u << qblk) - 1u);
#pragma unroll 1
    for (int mode = 0; mode < 2; ++mode) {
        const bf16_t* Kg = (const bf16_t*)(ws + (mode ? WS_KW : WS_KS)) + (size_t)bg * SEQ * 128;
        const bf16_t* Vg = (const bf16_t*)(ws + (mode ? WS_VWT : WS_VST)) + (size_t)bg * 128 * SEQ;
        unsigned todo;
        if (mode) { const int jlo = qblk >= 8 ? qblk - 8 : 0; todo = ((2u << qblk) - 1u) & ~((1u << jlo) - 1u); } else todo = uni;
        f32x16 o[4];
#pragma unroll
        for (int db = 0; db < 4; ++db)
#pragma unroll
            for (int i = 0; i < 16; ++i) o[db][i] = 0.f;
        float mrun = NEGB, lrun = 0.f;
        int cur = __builtin_ctz(todo); todo &= todo - 1u;
        kv_load(R, Kg + (size_t)cur * 64 * 128, Vg + cur * 64, SEQ, tid); kv_store(R, KB0, VB0, tid);
        int bi = 0;
        for (;;) {
            __syncthreads();
            const int nxt = todo ? __builtin_ctz(todo) : -1; todo &= todo - 1u;
            if (nxt >= 0) kv_load(R, Kg + (size_t)nxt * 64 * 128, Vg + nxt * 64, SEQ, tid);
            const int key0 = cur * 64;
            const bool rowok = mode ? true : (((mysel >> cur) & 1u) != 0u);
            const bool need_c = (key0 + 63 > qw0), need_w = mode && (key0 <= qw0 + 31 - 512);
            const bool wave_skip = mode ? (key0 + 63 <= qw0 - 512) : !__any(rowok);
            if (!wave_skip) flash_step(o, mrun, lrun, KB0 + bi * KVBUF, VB0 + bi * KVBUF, qr, r, hi, qpos, key0, rowok, need_c, need_w);
            if (nxt < 0) break;
            kv_store(R, KB0 + (bi ^ 1) * KVBUF, VB0 + (bi ^ 1) * KVBUF, tid);
            bi ^= 1; cur = nxt;
        }
        __syncthreads();
        lrun += __shfl_xor(lrun, 32);
        const float sc = (mode ? g2 : g1) / lrun;
#pragma unroll
        for (int db = 0; db < 4; ++db)
#pragma unroll
            for (int i = 0; i < 8; ++i) opk[db][i] = pk2(bflo(opk[db][i]) + o[db][2 * i] * sc, bfhi(opk[db][i]) + o[db][2 * i + 1] * sc);
    }
#pragma unroll
    for (int db = 0; db < 4; ++db)
#pragma unroll
        for (int g4 = 0; g4 < 4; ++g4) { u32x2 w; w.x = opk[db][2 * g4]; w.y = opk[db][2 * g4 + 1];
            *(u32x2*)(Qp + 32 * db + 8 * g4 + 4 * hi) = w; }
}

#define NOINL __forceinline__
#define LDS_PTR() ((LAS unsigned char*)lds_raw)
extern __shared__ __attribute__((aligned(16))) unsigned char lds_raw[];

NOINL __device__ void ph_ffn_up(unsigned char* ws) {
    pg8::Gemm g{(const bf16_t*)(ws + WS_U), (const bf16_t*)(ws + WS_WGU), DM, DM, DM}; pg8::Sched S; S.init(64, 44, gridDim.x, blockIdx.x, 256L * DM * 2, 256L * DM * 2);
    EpiFFN E{(bf16_t*)(ws + WS_H)}; pg8::gemm_phase(LDS_PTR(), g, S, E);
}
NOINL __device__ void ph_ffn_down(unsigned char* ws) {
    pg8::Gemm g{(const bf16_t*)(ws + WS_H), (const bf16_t*)(ws + WS_WD), DFF, DFF, DFF}; pg8::Sched S; S.init(64, 8, gridDim.x, blockIdx.x, 256L * DFF * 2, 256L * DFF * 2);
    EpiF32 E{(float*)(ws + WS_F)}; pg8::gemm_phase(LDS_PTR(), g, S, E);
}
NOINL __device__ void ph_inproj(unsigned char* ws) {
    pg8::Gemm g{(const bf16_t*)(ws + WS_U), (const bf16_t*)(ws + WS_WIN), DM, DM, DM}; pg8::Sched S; S.init(64, 49, gridDim.x, blockIdx.x, 256L * DM * 2, 256L * DM * 2);
    EpiIn E{ws, (const float*)(ws + WS_ROPE)}; pg8::gemm_phase(LDS_PTR(), g, S, E);
}
NOINL __device__ void ph_vt(unsigned char* ws) {
    pg8::Gemm g{(const bf16_t*)(ws + WS_WV), (const bf16_t*)(ws + WS_U), DM, DM, DM}; pg8::Sched S; S.init(4, 64, gridDim.x, blockIdx.x, 256L * DM * 2, 256L * DM * 2);
    EpiVT E{(bf16_t*)(ws + WS_VST), (bf16_t*)(ws + WS_VWT)}; pg8::gemm_phase(LDS_PTR(), g, S, E);
}
NOINL __device__ void ph_cmp1(unsigned char* ws) {
    pg8::Gemm g{(const bf16_t*)(ws + WS_KC), (const bf16_t*)(ws + WS_W1T), 2048, 4096, 512}; pg8::Sched S; S.init(16, 16, gridDim.x, blockIdx.x, 0, 0); S.mode = 1; S.srcstride = (long)(WS_VC - WS_KC);
    EpiPart E{(float*)(ws + WS_PART)}; pg8::gemm_phase(LDS_PTR(), g, S, E);
}
NOINL __device__ void ph_ya(unsigned char* ws) {
    pg8::Gemm g{(const bf16_t*)(ws + WS_GY), (const bf16_t*)(ws + WS_WA), DM, DM, DM}; pg8::Sched S; S.init(64, 8, gridDim.x, blockIdx.x, 256L * DM * 2, 256L * DM * 2);
    EpiGate E{(const bf16_t*)(ws + WS_MG), nullptr, (bf16_t*)(ws + WS_XA), 0}; pg8::gemm_phase(LDS_PTR(), g, S, E);
}
NOINL __device__ void ph_yb(unsigned char* ws) {
    pg8::Gemm g{(const bf16_t*)(ws + WS_Q), (const bf16_t*)(ws + WS_WB), DM, DM, DM}; pg8::Sched S; S.init(64, 8, gridDim.x, blockIdx.x, 256L * DM * 2, 256L * DM * 2);
    EpiGate E{(const bf16_t*)(ws + WS_MG), (const bf16_t*)(ws + WS_XA), (bf16_t*)(ws + WS_U), 1}; pg8::gemm_phase(LDS_PTR(), g, S, E);
}
NOINL __device__ void ph_out(unsigned char* ws) {
    pg8::Gemm g{(const bf16_t*)(ws + WS_U), (const bf16_t*)(ws + WS_WO), DM, DM, DM}; pg8::Sched S; S.init(64, 8, gridDim.x, blockIdx.x, 256L * DM * 2, 256L * DM * 2);
    EpiF32 E{(float*)(ws + WS_FMIX)}; pg8::gemm_phase(LDS_PTR(), g, S, E);
}
NOINL __device__ void ph_cmp2(unsigned char* ws) {
    const int tid = otid(), lane = tid & 63, wave = __builtin_amdgcn_readfirstlane(tid >> 6), bx = blockIdx.x;
    if (wave >= 4 || bx >= 256) return;
    const int src = bx >> 7, rt = bx & 127;
    const int r = lane & 31, hh = lane >> 5;
    const float* P = (const float*)(ws + WS_PART); const float* peb = (const float*)(ws + WS_PEB) + src * 128;
    const bf16_t* w2t = (const bf16_t*)(ws + WS_W2T) + (size_t)src * 128 * 128;
    f32x16 acc;
#pragma unroll
    for (int i = 0; i < 16; ++i) acc[i] = 0.f;
#pragma unroll 1
    for (int st = 0; st < 8; ++st) {
        const int k0 = 16 * st + 8 * hh; float a[8];
#pragma unroll
        for (int e = 0; e < 8; ++e) a[e] = peb[k0 + e];
#pragma unroll
        for (int ks = 0; ks < 8; ++ks) { const float* pp = P + ((size_t)((ks * 2 + src) * 4096 + rt * 32 + r)) * 128 + k0;
            const f32x4 x0 = *(const f32x4*)pp, x1 = *(const f32x4*)(pp + 4); a[0] += x0[0]; a[1] += x0[1]; a[2] += x0[2]; a[3] += x0[3]; a[4] += x1[0]; a[5] += x1[1]; a[6] += x1[2]; a[7] += x1[3]; }
        u32x4 w; w.x = pk2(gelu_t(a[0]), gelu_t(a[1])); w.y = pk2(gelu_t(a[2]), gelu_t(a[3])); w.z = pk2(gelu_t(a[4]), gelu_t(a[5])); w.w = pk2(gelu_t(a[6]), gelu_t(a[7]));
        const bf16x8 af = __builtin_bit_cast(bf16x8, w);
        const bf16x8 bfr = *(const bf16x8*)(w2t + (size_t)(32 * wave + r) * 128 + k0);
        acc = MFMA32(af, bfr, acc);
    }
#pragma unroll
    for (int i = 0; i < 16; ++i) {
        const int R = rt * 32 + crow(i, hh), nrow = R & 127, bgi = R >> 7, d = 32 * wave + r;
        const float v = (nrow == 127) ? 0.f : acc[i];
        const bf16_t o = (bf16_t)(pk2(v, 0.f) & 0xffffu);
        if (src == 0) ((bf16_t*)(ws + WS_KCC))[(size_t)R * 128 + d] = o;
        else ((bf16_t*)(ws + WS_VCT))[((size_t)bgi * 128 + d) * 128 + nrow] = o;
    }
}
NOINL __device__ void ph_lru_gates(unsigned char* ws, const float* conv_w, const float* conv_b, const float* lbr, const float* lbi, const float* llam) {
    const int tid = otid(), lane = tid & 63, wave = __builtin_amdgcn_readfirstlane(tid >> 6), bx = blockIdx.x, G = gridDim.x;
    LAS unsigned char* lds = LDS_PTR();
    const int h = bx & 15, cuh = bx >> 4, nch = G >> 4;
    LAS unsigned char* WL = lds; LAS unsigned char* XS = lds + 69632 + wave * 8704; LAS float* CW = (LAS float*)(lds + 139264);
    const bf16_t* wri = (const bf16_t*)(ws + WS_WRI) + (size_t)h * 256 * 128;
#pragma unroll
    for (int e = 0; e < 8; ++e) { const int c = tid + 512 * e; *(LAS u32x4*)(WL + (c >> 4) * 272 + (c & 15) * 16) = *(const u32x4*)(wri + (c >> 4) * 128 + (c & 15) * 8); }
    if (tid < 128) { const int ch = h * 128 + tid;
        CW[tid] = conv_w[ch]; CW[128 + tid] = conv_w[DM + ch]; CW[256 + tid] = conv_w[2 * DM + ch]; CW[384 + tid] = conv_w[3 * DM + ch];
        CW[512 + tid] = conv_b[ch]; CW[640 + tid] = lbr[ch]; CW[768 + tid] = lbi[ch];
        const float lam = llam[ch], ex = __expf(-lam);
        CW[896 + tid] = (ex < 0.03f) ? ex * (1.f - ex * (0.5f - ex * (0.33333333f - ex * (0.25f - ex * 0.2f)))) : __logf(1.f + ex); }
    __syncthreads();
    const int r = lane & 31, hh = lane >> 5;
    const bf16_t* XA = (const bf16_t*)(ws + WS_XA); bf16_t* LA = (bf16_t*)(ws + WS_U); bf16_t* BBp = (bf16_t*)(ws + WS_BB);
#pragma unroll 1
    for (int rt = cuh * 8 + wave; rt < T / 32; rt += nch * 8) {
        const int t0 = rt * 32, tok = t0 + r, s = tok & 2047;
        bf16x8 af[8];
#pragma unroll
        for (int st = 0; st < 8; ++st) {
            const int ch0 = 16 * st + 8 * hh; float xc[8];
#pragma unroll
            for (int e = 0; e < 8; ++e) xc[e] = CW[512 + ch0 + e];
#pragma unroll
            for (int j = 0; j < 4; ++j) { if (s - 3 + j >= 0) { const u32x4 xv = *(const u32x4*)(XA + (size_t)(tok - 3 + j) * DM + h * 128 + ch0);
                xc[0] += CW[j * 128 + ch0 + 0] * bflo(xv.x); xc[1] += CW[j * 128 + ch0 + 1] * bfhi(xv.x); xc[2] += CW[j * 128 + ch0 + 2] * bflo(xv.y); xc[3] += CW[j * 128 + ch0 + 3] * bfhi(xv.y);
                xc[4] += CW[j * 128 + ch0 + 4] * bflo(xv.z); xc[5] += CW[j * 128 + ch0 + 5] * bfhi(xv.z); xc[6] += CW[j * 128 + ch0 + 6] * bflo(xv.w); xc[7] += CW[j * 128 + ch0 + 7] * bfhi(xv.w); } }
            u32x4 w; w.x = pk2(xc[0], xc[1]); w.y = pk2(xc[2], xc[3]); w.z = pk2(xc[4], xc[5]); w.w = pk2(xc[6], xc[7]);
            af[st] = __builtin_bit_cast(bf16x8, w);
            *(LAS u32x4*)(XS + r * 272 + ch0 * 2) = w;
            if (st & 1) asm volatile("" ::: "memory");
        }
        LDS_WAIT();
#pragma unroll 1
        for (int cb = 0; cb < 4; ++cb) {
            f32x16 aR, aI;
#pragma unroll
            for (int i = 0; i < 16; ++i) { aR[i] = 0.f; aI[i] = 0.f; }
#pragma unroll
            for (int st = 0; st < 8; ++st) {
                const bf16x8 bR = *(const LAS bf16x8*)(WL + (32 * cb + r) * 272 + st * 32 + hh * 16), bI = *(const LAS bf16x8*)(WL + (128 + 32 * cb + r) * 272 + st * 32 + hh * 16);
                aR = MFMA32(af[st], bR, aR); aI = MFMA32(af[st], bI, aI);
            }
            const int ch = 32 * cb + r; const float br_ = CW[640 + ch], bi_ = CW[768 + ch], sp_ = CW[896 + ch];
#pragma unroll
            for (int i = 0; i < 16; ++i) {
                const int tk = crow(i, hh);
                const float rr = sigm(aR[i] + br_), ig = sigm(aI[i] + bi_), la = -8.f * rr * sp_;
                const float xcv = bf2f(*(const LAS bf16_t*)(XS + tk * 272 + ch * 2));
                const float bm = sqrtf(fmaxf(1.f - __expf(2.f * la), 0.f)) * ig * xcv;
                const size_t o = (size_t)(t0 + tk) * DM + h * 128 + ch;
                LA[o] = (bf16_t)(pk2(la, 0.f) & 0xffffu); BBp[o] = (bf16_t)(pk2(bm, 0.f) & 0xffffu);
            }
        }
        LDS_WAIT();
    }
}
NOINL __device__ void ph_scan(unsigned char* ws) {
    const int tid = otid(), lane = tid & 63, wave = __builtin_amdgcn_readfirstlane(tid >> 6), bx = blockIdx.x, G = gridDim.x;
    LAS float* car = (LAS float*)LDS_PTR();
    const bf16_t* LA = (const bf16_t*)(ws + WS_U); const bf16_t* BBp = (const bf16_t*)(ws + WS_BB); bf16_t* GY = (bf16_t*)(ws + WS_GY);
    for (int unit = bx; unit < 256; unit += G) {
        const int b = unit >> 5, ch = (unit & 31) * 64 + lane;
        const size_t base = ((size_t)b * SEQ + wave * 256) * DM + ch;
        float hst = 0.f, ssum = 0.f;
#pragma unroll 1
        for (int t = 0; t < 256; t += 8) { float la[8], bb[8];
#pragma unroll
            for (int e = 0; e < 8; ++e) { la[e] = bf2f(LA[base + (size_t)(t + e) * DM]); bb[e] = bf2f(BBp[base + (size_t)(t + e) * DM]); }
#pragma unroll
            for (int e = 0; e < 8; ++e) { hst = __expf(la[e]) * hst + bb[e]; ssum += la[e]; } }
        car[(wave * 2) * 64 + lane] = __expf(ssum); car[(wave * 2 + 1) * 64 + lane] = hst;
        __syncthreads();
        float hin = 0.f;
        for (int w = 0; w < wave; ++w) hin = car[(w * 2) * 64 + lane] * hin + car[(w * 2 + 1) * 64 + lane];
        hst = hin;
#pragma unroll 1
        for (int t = 0; t < 256; t += 8) { float la[8], bb[8], gy[8];
#pragma unroll
            for (int e = 0; e < 8; ++e) { la[e] = bf2f(LA[base + (size_t)(t + e) * DM]); bb[e] = bf2f(BBp[base + (size_t)(t + e) * DM]); gy[e] = bf2f(GY[base + (size_t)(t + e) * DM]); }
#pragma unroll
            for (int e = 0; e < 8; ++e) { hst = __expf(la[e]) * hst + bb[e]; GY[base + (size_t)(t + e) * DM] = (bf16_t)(pk2(hst * gy[e], 0.f) & 0xffffu); } }
        __syncthreads();
    }
}
NOINL __device__ void ph_nsa(unsigned char* ws) {
    const int bx = blockIdx.x, G = gridDim.x;
    const int vcu = (G % 8 == 0) ? (bx % 8) * (G / 8) + bx / 8 : bx;
#pragma unroll 1
    for (int uu = vcu; uu < 1024; uu += G) {
        const int pr = uu & 255, it = uu >> 8, bg = pr >> 3, s = pr & 7;
        const int qblk = (it == 0) ? s : (it == 1) ? 15 - s : (it == 2) ? 16 + s : 31 - s;
        nsa_unit(bg, qblk, ws, LDS_PTR());
    }
}

DI KArgs oargs() { auto p = __builtin_amdgcn_kernarg_segment_ptr(); asm volatile("" : "+s"(p)); return (KArgs)p; }

DI void ph_prologue() {
    KArgs ka = oargs();
    LAS unsigned char* lds = LDS_PTR(); unsigned char* ws = ka->ws; float* mod = (float*)(ws + WS_MOD);
    const int tid = otid(), lane = tid & 63, wave = __builtin_amdgcn_readfirstlane(tid >> 6), G = gridDim.x, bx = blockIdx.x, gw = bx * NWV + wave, ngw = G * NWV;
    {
        LAS float* cact = (LAS float*)lds;
        LAS float* red = (LAS float*)(lds + 65536);
        const float* c = ka->in[1]; const float* wada = ka->in[2]; const float* bada = ka->in[3];
        for (int i = tid; i < NB * DM; i += NTHR) { const float v = c[i]; cact[i] = v * sigm(v); }
        __syncthreads();
        for (int item = bx; item < 288; item += G) {
            const int col = item * 64 + lane;
            float acc[8];
#pragma unroll
            for (int b = 0; b < 8; ++b) acc[b] = 0.f;
            const float* wp = wada + (size_t)(wave * 256) * (NADA * DM) + col;
#pragma unroll 4
            for (int k = 0; k < 256; ++k) { const float w = wp[(size_t)k * (NADA * DM)];
#pragma unroll
                for (int b = 0; b < 8; ++b) acc[b] += cact[b * DM + wave * 256 + k] * w; }
#pragma unroll
            for (int b = 0; b < 8; ++b) red[(wave * 8 + b) * 64 + lane] = acc[b];
            __syncthreads();
            { const int b = tid >> 6; float s = bada[col];
#pragma unroll
              for (int w = 0; w < 8; ++w) s += red[(w * 8 + b) * 64 + lane];
              mod[b * (NADA * DM) + col] = s; }
            __syncthreads();
        }
    }
    conv_jobs(0, 9, ka, lds, gw, ngw, wave, lane);
    conv_jobs(11, 12, ka, lds, gw, ngw, wave, lane);
    {
        const int idx = bx * NTHR + tid;
        if (idx < SEQ * 16) { const int pos = idx >> 4, i = idx & 15;
            const float invf = __builtin_amdgcn_exp2f(-(float)i * 1.1832230356f); const float ang = (float)pos * invf;
            const float rev = ang * 0.15915494309189535f, fr = rev - floorf(rev);
            float* rp = (float*)(ws + WS_ROPE) + pos * 32; rp[i] = __builtin_amdgcn_cosf(fr); rp[16 + i] = __builtin_amdgcn_sinf(fr); }
    }
    if (bx >= G - 2) {
        const int src = bx - (G - 2); const float* pe = ka->in[src ? 22 : 19]; const float* w1 = ka->in[src ? 23 : 20];
        __syncthreads();
        LAS float* red = (LAS float*)lds;
        const int d = tid & 127, qt = tid >> 7; float s = 0.f;
        for (int k = qt * 1024; k < qt * 1024 + 1024; ++k) s += pe[k] * w1[(size_t)k * 128 + d];
        red[tid] = s; __syncthreads();
        if (tid < 128) ((float*)(ws + WS_PEB))[src * 128 + tid] = (red[tid] + red[128 + tid]) + (red[256 + tid] + red[384 + tid]);
    }
}
DI void ph_rows(int which) {
    KArgs ka = oargs(); unsigned char* ws = ka->ws; float* out = ka->out; const float* mod = (const float*)(ws + WS_MOD);
    const int tid = otid(), lane = tid & 63, wave = __builtin_amdgcn_readfirstlane(tid >> 6), G = gridDim.x, bx = blockIdx.x, gw = bx * NWV + wave, ngw = G * NWV;
    if (which == 0) {
        const float* x = ka->in[0]; const float* g = ka->in[4];
        for (int row = gw; row < T; row += ngw) { const int b = row >> 11; f32x4 v[8]; row_load(v, x + (size_t)row * DM, lane); const float rs = row_rstd(v);
            row_modulate_store(v, rs, g, mod + b * (NADA * DM) + 0 * DM, mod + b * (NADA * DM) + 1 * DM, (bf16_t*)(ws + WS_U) + (size_t)row * DM, lane); }
    } else if (which == 1) {
        const float* x = ka->in[0]; const float* pg = ka->in[5]; const float* g = ka->in[9];
        for (int row = gw; row < T; row += ngw) { const int b = row >> 11; const float* mb = mod + b * (NADA * DM); f32x4 v[8];
            row_residual(v, (const float*)(ws + WS_F) + (size_t)row * DM, x + (size_t)row * DM, mb + 2 * DM, pg, 0.5f, out + (size_t)row * DM, lane);
            const float rs = row_rstd(v); row_modulate_store(v, rs, g, mb + 3 * DM, mb + 4 * DM, (bf16_t*)(ws + WS_U) + (size_t)row * DM, lane); }
    } else if (which == 2) {
        const float* pg = ka->in[10]; const float* g = ka->in[28];
        for (int row = gw; row < T; row += ngw) { const int b = row >> 11; const float* mb = mod + b * (NADA * DM); f32x4 v[8];
            row_residual(v, (const float*)(ws + WS_FMIX) + (size_t)row * DM, out + (size_t)row * DM, mb + 5 * DM, pg, 1.0f, out + (size_t)row * DM, lane);
            const float rs = row_rstd(v); row_modulate_store(v, rs, g, mb + 6 * DM, mb + 7 * DM, (bf16_t*)(ws + WS_U) + (size_t)row * DM, lane); }
        conv_jobs(9, 11, ka, LDS_PTR(), gw, ngw, wave, lane);
    } else {
        const float* pg = ka->in[29];
        for (int row = gw; row < T; row += ngw) { const int b = row >> 11; const float* mb = mod + b * (NADA * DM); f32x4 v[8];
            row_residual(v, (const float*)(ws + WS_F) + (size_t)row * DM, out + (size_t)row * DM, mb + 8 * DM, pg, 0.5f, out + (size_t)row * DM, lane); }
    }
}

__global__ void __launch_bounds__(NTHR) fwd_kernel(Args args_unused) {
    cg::grid_group grid = cg::this_grid();
#ifndef PH_MASK
#define PH_MASK 0xffff
#endif
#define WSP() (oargs()->ws)
#pragma unroll 1
    for (int ph = oargs()->ph_lo; ph < oargs()->ph_hi; ++ph) {
        switch (ph) {
#define ON(k) if (((PH_MASK) >> (k)) & 1)
        case 0: ON(0) ph_prologue(); break;
        case 1: ON(1) ph_rows(0); break;
        case 2: case 13: ON(2) ph_ffn_up(WSP()); break;
        case 3: case 14: ON(3) ph_ffn_down(WSP()); break;
        case 4: ON(4) ph_rows(1); break;
        case 5: ON(5) { ph_inproj(WSP()); ph_vt(WSP()); } break;
        case 6: ON(6) ph_cmp1(WSP()); break;
        case 7: ON(7) { ph_cmp2(WSP()); __syncthreads(); KArgs ka = oargs(); ph_lru_gates(ka->ws, ka->in[12], ka->in[13], ka->in[15], ka->in[17], ka->in[18]); } break;
        case 8: ON(8) { ph_scan(WSP()); ph_nsa(WSP()); } break;
        case 9: ON(9) ph_ya(WSP()); break;
        case 10: ON(10) ph_yb(WSP()); break;
        case 11: ON(11) ph_out(WSP()); break;
        case 12: ON(12) ph_rows(2); break;
        default: ON(15) ph_rows(3); break;
        }
        if (ph + 1 < oargs()->ph_hi) grid.sync();
    }
}

extern "C" void kernel_launch(void* const* d_in, const int* in_sizes, int n_in, void* d_out, int out_size, void* d_ws, size_t ws_size, hipStream_t stream) {
    static int grid = 0;
    if (grid == 0) {
        if (n_in != 33 || out_size != T * DM || ws_size < WS_END) { fprintf(stderr, "kernel_launch: unexpected problem (n_in %d out %d ws %zu)\n", n_in, out_size, ws_size); grid = -1; return; }
        int dev = 0, cus = 0, per_cu = 0;
        hipGetDevice(&dev); hipDeviceGetAttribute(&cus, hipDeviceAttributeMultiprocessorCount, dev);
        if (hipFuncSetAttribute((const void*)fwd_kernel, hipFuncAttributeMaxDynamicSharedMemorySize, LDS_BYTES) != hipSuccess) { fprintf(stderr, "kernel_launch: hipFuncSetAttribute failed\n"); grid = -1; return; }
        if (hipOccupancyMaxActiveBlocksPerMultiprocessor(&per_cu, (const void*)fwd_kernel, NTHR, LDS_BYTES) != hipSuccess || per_cu < 1) { fprintf(stderr, "kernel_launch: occupancy query gives %d\n", per_cu); per_cu = 1; }
        (void)hipGetLastError();
        grid = cus;
    }
    if (grid < 0) return;
    Args a{};
    for (int i = 0; i < 33; ++i) a.in[i] = (const float*)d_in[i];
    a.out = (float*)d_out; a.ws = (unsigned char*)d_ws;
#if ONE_LAUNCH
    a.ph_lo = 0; a.ph_hi = 16;
    void* params[] = {&a};
    hipError_t e = hipLaunchCooperativeKernel((const void*)fwd_kernel, dim3(grid), dim3(NTHR), params, LDS_BYTES, stream);
    if (e != hipSuccess) fprintf(stderr, "cooperative launch failed: %s (grid %d)\n", hipGetErrorString(e), grid);
#else
    for (int p = 0; p < 16; ++p) { a.ph_lo = p; a.ph_hi = p + 1; hipLaunchKernelGGL(fwd_kernel, dim3(grid), dim3(NTHR), LDS_BYTES, stream, a); }
#endif
}
```

```cpp
#include <hip/hip_runtime.h>
#include <hip/hip_cooperative_groups.h>
#include <cstdio>
#include <cstdint>
namespace cg = cooperative_groups;


#ifndef ONE_LAUNCH
#define ONE_LAUNCH 1
#endif

#define LAS __attribute__((address_space(3)))
#define DI __device__ __forceinline__
typedef unsigned short bf16_t;
typedef short bf16x8 __attribute__((ext_vector_type(8)));
typedef short s16x4 __attribute__((ext_vector_type(4)));
typedef float f32x2 __attribute__((ext_vector_type(2)));
typedef float f32x4 __attribute__((ext_vector_type(4)));
typedef float f32x16 __attribute__((ext_vector_type(16)));
typedef unsigned u32x2 __attribute__((ext_vector_type(2)));
typedef unsigned u32x4 __attribute__((ext_vector_type(4)));
typedef __bf16 bf16x2_t __attribute__((ext_vector_type(2)));

constexpr int DM = 2048, NB = 8, SEQ = 2048, T = NB * SEQ, DFF = 5632, NADA = 9;
constexpr int INW = 13360;
constexpr int NTHR = 512, NWV = 8;
constexpr float EPS = 1e-6f;
constexpr size_t MiB = 1u << 20;
constexpr size_t WS_MOD = 0;
constexpr size_t WS_ROPE = 640 * 1024;
constexpr size_t WS_PEB = 900 * 1024;
constexpr size_t WS_W2T = 1 * MiB;
constexpr size_t WS_WGU = 2 * MiB, WS_WD = 46 * MiB;
constexpr size_t WS_BB = 2 * MiB;
constexpr size_t WS_WIN = 68 * MiB, WS_WV = 117 * MiB, WS_WA = 121 * MiB, WS_WB = 129 * MiB, WS_WO = 137 * MiB;
constexpr size_t WS_PART = 68 * MiB;
constexpr size_t WS_W1T = 145 * MiB, WS_WRI = 147 * MiB, WS_KCC = 152 * MiB, WS_VCT = 153 * MiB, WS_NG = 154 * MiB;
constexpr size_t WS_U = 160 * MiB;
constexpr size_t WS_H = 224 * MiB, WS_F = 400 * MiB;
constexpr size_t WS_XA = 224 * MiB, WS_GY = 288 * MiB, WS_Q = 352 * MiB, WS_KC = 416 * MiB, WS_VC = 432 * MiB, WS_KS = 448 * MiB, WS_KW = 464 * MiB;
constexpr size_t WS_VST = 480 * MiB, WS_VWT = 496 * MiB, WS_MG = 512 * MiB, WS_FMIX = 512 * MiB;
constexpr size_t WS_END = 640 * MiB;
constexpr int LDS_BYTES = 147456;

struct Args { const float* in[33]; float* out; unsigned char* ws; int ph_lo, ph_hi; };
typedef const Args __attribute__((address_space(4)))* KArgs;

DI unsigned pk2(float lo, float hi) { f32x2 v = {lo, hi}; bf16x2_t b = __builtin_convertvector(v, bf16x2_t); return __builtin_bit_cast(unsigned, b); }
DI float bf2f(bf16_t v) { return __uint_as_float((unsigned)v << 16); }
DI float bflo(unsigned w) { return __uint_as_float(w << 16); }
DI float bfhi(unsigned w) { return __uint_as_float(w & 0xffff0000u); }
DI float sigm(float x) { return 1.f / (1.f + __expf(-x)); }
DI float gelu_t(float x) { const float u = 0.7978845608028654f * (x + 0.044715f * x * x * x); return x / (1.f + __expf(-2.f * u)); }
DI float wave_sum(float v) {
#pragma unroll
    for (int o = 1; o < 64; o <<= 1) v += __shfl_xor(v, o);
    return v;
}
#define LDS_WAIT() asm volatile("s_waitcnt lgkmcnt(0)" ::: "memory")
DI int otid() { int t = threadIdx.x; asm volatile("" : "+v"(t)); return t; }

namespace pg8 {
constexpr int BM = 256, BK = 64, HALF = 128, HTB = HALF * BK * 2, STAGE_BYTES = 8 * HTB, NXCD = 8, WGM = 8;
DI int lds_byte(int r, int c) { const int st = (r >> 4) * 2 + (c >> 5), rr = r & 15, cc = c & 31, ob = rr * 64 + cc * 2; return st * 1024 + (ob ^ (((ob >> 9) & 1) << 5)); }
DI void stage_rc(int b, int& R, int& C) { const int st = b / 1024, sb = b % 1024, swz = sb ^ (((sb >> 9) & 1) << 5); R = (st >> 1) * 16 + swz / 64; C = (st & 1) * 32 + (swz % 64) / 2; }
DI int perm32(int rho) { const int n = rho >> 4, i = rho & 15; return 8 * (i >> 2) + 4 * n + (i & 3); }

struct Unit { int pm, pn; long aoff, boff; };
struct Gemm { const bf16_t* A; const bf16_t* Bt; int lda, ldb, K; };
struct Sched {
    int nM, nN, nwg, G, c, mode; long astep, bstep, srcstride;
    DI void init(int nM_, int nN_, int G_, int c_, long astep_, long bstep_) { nM = nM_; nN = nN_; nwg = nM * nN; G = G_; c = c_; mode = 0; astep = astep_; bstep = bstep_; srcstride = 0; }
    DI bool next(int i, Unit& u) const {
        const long L = (long)i * G + c; if (L >= nwg) return false;
        int wgid = (int)L;
        if (mode == 1) {
            const int pm = wgid & 15, ks = (wgid >> 4) & 7, src = wgid >> 7;
            u.pm = pm; u.pn = src + 2 * ks; u.aoff = (long)src * srcstride + (long)pm * 256 * 2048 * 2 + (long)ks * 1024; u.boff = (long)ks * 1024; return true;
        }
        { const int q = nwg / NXCD, r = nwg % NXCD, xcd = wgid % NXCD, off = wgid / NXCD; wgid = (xcd < r ? xcd * (q + 1) : r * (q + 1) + (xcd - r) * q) + off; }
        const int nig = WGM * nN, gid = wgid / nig, fm = gid * WGM, gsz = (nM - fm) < WGM ? (nM - fm) : WGM;
        u.pm = fm + ((wgid % nig) % gsz); u.pn = (wgid % nig) / gsz; u.aoff = (long)u.pm * astep; u.boff = (long)u.pn * bstep; return true;
    }
};

template <class Epi>
DI void gemm_phase(LAS unsigned char* lds, const Gemm g, const Sched& S, const Epi& E) {
    const int tid = otid(), wid = __builtin_amdgcn_readfirstlane(tid >> 6), lane = tid & 63, wr = wid >> 2, wc = wid & 3, fr = lane & 15, fq = lane >> 4;
    const int K = g.K, nt = K / BK;
    unsigned voffA[2], voffB[2];
#pragma unroll
    for (int i = 0; i < 2; ++i) { int R, C; stage_rc(tid * 16 + i * 8192, R, C); const int Rb = Epi::PERM ? ((R & ~31) + perm32(R & 31)) : R;
        voffA[i] = (unsigned)(R * g.lda + C) * 2u; voffB[i] = (unsigned)(Rb * g.ldb + C) * 2u; }
    const size_t kstep = (size_t)(BK * 2);
    const size_t hsA = (size_t)HALF * g.lda * 2, hsB = (size_t)HALF * g.ldb * 2;
    const unsigned ldsw = (unsigned)wid * 1024u;
    const int aoff = lds_byte(wr * 64 + fr, fq * 8), boff = lds_byte(wc * 32 + fr, fq * 8);
#define PG8_SA(b, h) (((b) * 2 + (h)) * HTB)
#define PG8_SB(b, h) ((4 + (b) * 2 + (h)) * HTB)
#define PG8_STAGE(bufoff, gbase, voff) do { _Pragma("unroll") for (int _i = 0; _i < 2; ++_i) \
        __builtin_amdgcn_global_load_lds((const unsigned*)((const char*)(gbase) + (voff)[_i]), (LAS unsigned*)(lds + (bufoff) + ldsw + _i * 8192), 16, 0, 0); } while (0)
#define PG8_LDA(dst, b, h) do { _Pragma("unroll") for (int m = 0; m < 4; ++m) _Pragma("unroll") for (int k = 0; k < 2; ++k) dst[m][k] = *(const LAS bf16x8*)(lds + PG8_SA(b, h) + aoff + m * 2048 + k * 1024); } while (0)
#define PG8_LDB(dst, b, h) do { _Pragma("unroll") for (int n = 0; n < 2; ++n) _Pragma("unroll") for (int k = 0; k < 2; ++k) dst[n][k] = *(const LAS bf16x8*)(lds + PG8_SB(b, h) + boff + n * 2048 + k * 1024); } while (0)
#define PG8_MMA(ai, bj, At, Bt) do { __builtin_amdgcn_s_setprio(1); _Pragma("unroll") for (int m = 0; m < 4; ++m) _Pragma("unroll") for (int n = 0; n < 2; ++n) _Pragma("unroll") for (int k = 0; k < 2; ++k) \
        acc[ai][bj][m][n] = __builtin_amdgcn_mfma_f32_16x16x32_bf16(Bt[n][k], At[m][k], acc[ai][bj][m][n], 0, 0, 0); __builtin_amdgcn_s_setprio(0); } while (0)
#define PG8_WAIT_V(n) asm volatile("s_waitcnt vmcnt(" #n ")" ::: "memory")
#define PG8_WAIT_L(n) asm volatile("s_waitcnt lgkmcnt(" #n ")" ::: "memory")
#define PG8_BAR __builtin_amdgcn_s_barrier()
#define PG8_SCHED __builtin_amdgcn_sched_barrier(0)
    Unit cur, nxt; int ui = 0;
    if (!S.next(0, cur)) return;
    f32x4 acc[2][2][4][2];
#pragma unroll
    for (int a = 0; a < 2; ++a)
#pragma unroll
        for (int b = 0; b < 2; ++b)
#pragma unroll
            for (int m = 0; m < 4; ++m)
#pragma unroll
                for (int n = 0; n < 2; ++n) acc[a][b][m][n] = (f32x4){0.f, 0.f, 0.f, 0.f};
    bf16x8 At[4][2], B0[2][2], B1[2][2];
    const char* cA = (const char*)g.A + cur.aoff; const char* cB = (const char*)g.Bt + cur.boff;
    PG8_STAGE(PG8_SB(0, 0), cB, voffB); PG8_STAGE(PG8_SB(0, 1), cB + hsB, voffB); PG8_STAGE(PG8_SA(0, 0), cA, voffA); PG8_STAGE(PG8_SA(0, 1), cA + hsA, voffA);
    if (wr == 1) PG8_BAR;
    PG8_WAIT_V(2); PG8_BAR;
    PG8_STAGE(PG8_SB(1, 0), cB + kstep, voffB); PG8_STAGE(PG8_SA(1, 0), cA + kstep, voffA); PG8_STAGE(PG8_SB(1, 1), cB + hsB + kstep, voffB);
    PG8_WAIT_V(6); PG8_BAR;
    for (;;) {
        const bool has_next = S.next(ui + 1, nxt);
        const char* nA = has_next ? (const char*)g.A + nxt.aoff : cA; const char* nB = has_next ? (const char*)g.Bt + nxt.boff : cB;
        for (int t = 0; t < nt; t += 2) {
            const bool last = (t == nt - 2);
            const char* a1 = cA + (size_t)(t + 1) * kstep;
            const char* a2 = last ? nA : cA + (size_t)(t + 2) * kstep; const char* b2 = last ? nB : cB + (size_t)(t + 2) * kstep;
            const char* a3 = a2 + kstep; const char* b3 = b2 + kstep;
            PG8_LDB(B0, 0, 0); PG8_LDB(B1, 0, 1); PG8_SCHED; PG8_LDA(At, 0, 0); PG8_STAGE(PG8_SA(1, 1), a1 + hsA, voffA);
            PG8_WAIT_V(8); PG8_WAIT_L(0); PG8_BAR; PG8_MMA(0, 0, At, B0); PG8_MMA(0, 1, At, B1); PG8_BAR; PG8_SCHED;
            PG8_LDA(At, 0, 1); PG8_STAGE(PG8_SB(0, 0), b2, voffB); PG8_STAGE(PG8_SB(0, 1), b2 + hsB, voffB); PG8_STAGE(PG8_SA(0, 0), a2, voffA);
            PG8_WAIT_V(8); PG8_WAIT_L(0); PG8_BAR; PG8_MMA(1, 0, At, B0); PG8_MMA(1, 1, At, B1); PG8_BAR; PG8_SCHED;
            PG8_LDB(B0, 1, 0); PG8_LDB(B1, 1, 1); PG8_SCHED; PG8_LDA(At, 1, 0); PG8_STAGE(PG8_SA(0, 1), a2 + hsA, voffA);
            PG8_WAIT_V(8); PG8_WAIT_L(0); PG8_BAR; PG8_MMA(0, 0, At, B0); PG8_MMA(0, 1, At, B1); PG8_BAR; PG8_SCHED;
            PG8_LDA(At, 1, 1); PG8_STAGE(PG8_SB(1, 0), b3, voffB); PG8_STAGE(PG8_SB(1, 1), b3 + hsB, voffB); PG8_STAGE(PG8_SA(1, 0), a3, voffA);
            PG8_WAIT_V(8); PG8_WAIT_L(0); PG8_BAR; PG8_MMA(1, 0, At, B0); PG8_MMA(1, 1, At, B1); PG8_BAR; PG8_SCHED;
        }
        if (wr == 0) PG8_BAR;
        E(acc, cur, wr, wc, fr, fq);
        if (!has_next) break;
#pragma unroll
        for (int a = 0; a < 2; ++a)
#pragma unroll
            for (int b = 0; b < 2; ++b)
#pragma unroll
                for (int m = 0; m < 4; ++m)
#pragma unroll
                    for (int n = 0; n < 2; ++n) acc[a][b][m][n] = (f32x4){0.f, 0.f, 0.f, 0.f};
        cur = nxt; cA = nA; cB = nB; ++ui;
        if (wr == 1) PG8_BAR;
    }
    PG8_WAIT_V(0);
    PG8_BAR;
#undef PG8_SA
#undef PG8_SB
#undef PG8_STAGE
#undef PG8_LDA
#undef PG8_LDB
#undef PG8_MMA
#undef PG8_WAIT_V
#undef PG8_WAIT_L
#undef PG8_BAR
#undef PG8_SCHED
}
}
using pg8::Unit;
typedef f32x4 AccT[2][2][4][2];

struct EpiFFN {
    static constexpr bool PERM = true; bf16_t* H;
    DI void operator()(const AccT& acc, const Unit& u, int wr, int wc, int fr, int fq) const {
        const int col = u.pn * 128 + wc * 32 + fq * 8;
#pragma unroll
        for (int ai = 0; ai < 2; ++ai)
#pragma unroll
            for (int m = 0; m < 4; ++m) {
                const int row = u.pm * 256 + ai * 128 + wr * 64 + m * 16 + fr;
                float v[8];
#pragma unroll
                for (int n = 0; n < 2; ++n)
#pragma unroll
                    for (int e = 0; e < 4; ++e) { const float gt = acc[ai][0][m][n][e], up = acc[ai][1][m][n][e]; v[n * 4 + e] = gt * sigm(gt) * up; }
                u32x4 w; w.x = pk2(v[0], v[1]); w.y = pk2(v[2], v[3]); w.z = pk2(v[4], v[5]); w.w = pk2(v[6], v[7]);
                *(u32x4*)(H + (size_t)row * DFF + col) = w;
            }
    }
};
struct EpiF32 {
    static constexpr bool PERM = false; float* O;
    DI void operator()(const AccT& acc, const Unit& u, int wr, int wc, int fr, int fq) const {
#pragma unroll
        for (int ai = 0; ai < 2; ++ai)
#pragma unroll
            for (int m = 0; m < 4; ++m) {
                const int row = u.pm * 256 + ai * 128 + wr * 64 + m * 16 + fr;
#pragma unroll
                for (int bj = 0; bj < 2; ++bj)
#pragma unroll
                    for (int n = 0; n < 2; ++n) *(f32x4*)(O + (size_t)row * DM + u.pn * 256 + bj * 128 + wc * 32 + n * 16 + fq * 4) = acc[ai][bj][m][n];
            }
    }
};
struct EpiPart {
    static constexpr bool PERM = false; float* P;
    DI void operator()(const AccT& acc, const Unit& u, int wr, int wc, int fr, int fq) const {
        const int src = u.pn & 1, ks = u.pn >> 1;
        float* base = P + ((size_t)(ks * 2 + src) * 4096) * 128;
#pragma unroll
        for (int ai = 0; ai < 2; ++ai)
#pragma unroll
            for (int m = 0; m < 4; ++m) {
                const int row = u.pm * 256 + ai * 128 + wr * 64 + m * 16 + fr;
#pragma unroll
                for (int n = 0; n < 2; ++n) { const f32x4 v = src ? acc[ai][1][m][n] : acc[ai][0][m][n]; *(f32x4*)(base + (size_t)row * 128 + wc * 32 + n * 16 + fq * 4) = v; }
            }
    }
};
struct EpiVT {
    static constexpr bool PERM = true; bf16_t* VT0; bf16_t* VT1;
    DI void operator()(const AccT& acc, const Unit& u, int wr, int wc, int fr, int fq) const {
#pragma unroll
        for (int ai = 0; ai < 2; ++ai)
#pragma unroll
            for (int m = 0; m < 4; ++m) {
                const int r = u.pm * 256 + ai * 128 + wr * 64 + m * 16 + fr;
                const int piece = r >> 9, gg = (r >> 7) & 3, d = r & 127;
                bf16_t* base = piece ? VT1 : VT0;
#pragma unroll
                for (int bj = 0; bj < 2; ++bj) {
                    const int t = u.pn * 256 + bj * 128 + wc * 32 + fq * 8, b = t >> 11, s = t & 2047;
                    const f32x4 v0 = acc[ai][bj][m][0], v1 = acc[ai][bj][m][1];
                    u32x4 w; w.x = pk2(v0[0], v0[1]); w.y = pk2(v0[2], v0[3]); w.z = pk2(v1[0], v1[1]); w.w = pk2(v1[2], v1[3]);
                    *(u32x4*)(base + ((size_t)((b * 4 + gg) * 128 + d)) * 2048 + s) = w;
                }
            }
    }
};
struct EpiGate {
    static constexpr bool PERM = true; const bf16_t* MG; const bf16_t* YAG; bf16_t* O; int mode;
    DI void operator()(const AccT& acc, const Unit& u, int wr, int wc, int fr, int fq) const {
#pragma unroll
        for (int ai = 0; ai < 2; ++ai)
#pragma unroll
            for (int m = 0; m < 4; ++m) {
                const int row = u.pm * 256 + ai * 128 + wr * 64 + m * 16 + fr;
#pragma unroll
                for (int bj = 0; bj < 2; ++bj) {
                    const int col = u.pn * 256 + bj * 128 + wc * 32 + fq * 8;
                    const u32x4 gw = *(const u32x4*)(MG + (size_t)row * 4096 + (mode ? 2048 : 0) + col);
                    const f32x4 v0 = acc[ai][bj][m][0], v1 = acc[ai][bj][m][1];
                    float o[8] = {v0[0] * bflo(gw.x), v0[1] * bfhi(gw.x), v0[2] * bflo(gw.y), v0[3] * bfhi(gw.y), v1[0] * bflo(gw.z), v1[1] * bfhi(gw.z), v1[2] * bflo(gw.w), v1[3] * bfhi(gw.w)};
                    if (mode) { const u32x4 yw = *(const u32x4*)(YAG + (size_t)row * DM + col);
                        o[0] += bflo(yw.x); o[1] += bfhi(yw.x); o[2] += bflo(yw.y); o[3] += bfhi(yw.y); o[4] += bflo(yw.z); o[5] += bfhi(yw.z); o[6] += bflo(yw.w); o[7] += bfhi(yw.w); }
                    u32x4 w; w.x = pk2(o[0], o[1]); w.y = pk2(o[2], o[3]); w.z = pk2(o[4], o[5]); w.w = pk2(o[6], o[7]);
                    *(u32x4*)(O + (size_t)row * DM + col) = w;
                }
            }
    }
};
struct EpiIn {
    static constexpr bool PERM = true; unsigned char* ws; const float* rope;
    DI void operator()(const AccT& acc, const Unit& u, int wr, int wc, int fr, int fq) const {
#pragma unroll
        for (int bj = 0; bj < 2; ++bj) {
            const int c0 = u.pn * 256 + bj * 128 + wc * 32;
            const int col = c0 + fq * 8;
#pragma unroll
            for (int ai = 0; ai < 2; ++ai)
#pragma unroll
                for (int m = 0; m < 4; ++m) {
                    const int row = u.pm * 256 + ai * 128 + wr * 64 + m * 16 + fr;
                    const int b = row >> 11, s = row & 2047;
                    float v[8];
#pragma unroll
                    for (int n = 0; n < 2; ++n)
#pragma unroll
                        for (int e = 0; e < 4; ++e) v[n * 4 + e] = acc[ai][bj][m][n][e];
                    bf16_t* dst = nullptr;
                    if (c0 < 2048) { dst = (bf16_t*)(ws + WS_XA) + (size_t)row * DM + col; }
                    else if (c0 < 4096) {
#pragma unroll
                        for (int e = 0; e < 8; ++e) v[e] = gelu_t(v[e]);
                        dst = (bf16_t*)(ws + WS_GY) + (size_t)row * DM + (col - 2048); }
                    else if (c0 < 8192) {
                        const bool isq = c0 < 6144;
                        const int pc = (c0 - 6144) >> 9;
                        if ((c0 & 127) == 0 && (isq || pc != 1)) {
                            const float* rp = rope + (size_t)s * 32 + 8 * (fq & 1);
                            const f32x4 cA = *(const f32x4*)(rp), cB = *(const f32x4*)(rp + 4), sA = *(const f32x4*)(rp + 16), sB = *(const f32x4*)(rp + 20);
                            const float cs[8] = {cA[0], cA[1], cA[2], cA[3], cB[0], cB[1], cB[2], cB[3]}, sn[8] = {sA[0], sA[1], sA[2], sA[3], sB[0], sB[1], sB[2], sB[3]};
#pragma unroll
                            for (int e = 0; e < 8; ++e) { const float mine = v[e], other = __shfl_xor(mine, 32); v[e] = (fq < 2) ? mine * cs[e] - other * sn[e] : mine * cs[e] + other * sn[e]; }
                        }
                        if (isq) dst = (bf16_t*)(ws + WS_Q) + (size_t)row * DM + (col - 4096);
                        else { const int gg = ((c0 - 6144) >> 7) & 3, d = col & 127; dst = (bf16_t*)(ws + WS_KC + (size_t)pc * 16 * MiB) + ((size_t)((b * 4 + gg) * 2048 + s)) * 128 + d; }
                    }
                    else if (c0 < 12288) {
#pragma unroll
                        for (int e = 0; e < 8; ++e) v[e] = sigm(v[e]);
                        dst = (bf16_t*)(ws + WS_MG) + (size_t)row * 4096 + (col - 8192); }
                    else {
                        const int cc = col - 12288;
                        if (cc < 48) { float* ng = (float*)(ws + WS_NG) + (size_t)row * 48 + cc;
                            *(f32x4*)ng = (f32x4){sigm(v[0]), sigm(v[1]), sigm(v[2]), sigm(v[3])}; *(f32x4*)(ng + 4) = (f32x4){sigm(v[4]), sigm(v[5]), sigm(v[6]), sigm(v[7])}; }
                    }
                    if (dst) { u32x4 w; w.x = pk2(v[0], v[1]); w.y = pk2(v[2], v[3]); w.z = pk2(v[4], v[5]); w.w = pk2(v[6], v[7]); *(u32x4*)dst = w; }
                }
        }
    }
};

struct ConvJob { int K, Nd; };
DI const float* conv_src(int job, int d, KArgs a, int& ld) {
    switch (job) {
    case 0: case 9: { const int pn = d >> 8, half = (d >> 7) & 1, j = d & 127; ld = DFF; const int base = job == 0 ? 6 : 30; return a->in[base + half] + 128 * pn + j; }
    case 1: ld = DM; return a->in[8] + d;
    case 10: ld = DM; return a->in[32] + d;
    case 2: { ld = INW; int col;
        if (d < 7680) col = d; else if (d < 8192) col = d + 512; else if (d < 12288) col = d - 8192 + 9264; else if (d < 12336) col = d - 12288 + 9216; else return nullptr;
        return a->in[11] + col; }
    case 3: ld = INW; return a->in[11] + (d < 512 ? 7680 + d : 8704 + (d - 512));
    case 4: ld = DM; return a->in[25] + d;
    case 5: ld = DM; return a->in[26] + d;
    case 6: ld = DM; return a->in[27] + d;
    case 7: ld = 128; return (d < 128) ? a->in[20] + d : a->in[23] + (d - 128);
    case 8: { const int h = d >> 8, half = (d >> 7) & 1, j = d & 127; ld = 128; return (half ? a->in[16] : a->in[14]) + h * 16384 + j; }
    default: ld = 128; return (d < 128) ? a->in[21] + d : a->in[24] + (d - 128);
    }
}
DI bf16_t* conv_dst(int job, unsigned char* ws) {
    switch (job) {
    case 0: case 9: return (bf16_t*)(ws + WS_WGU);
    case 1: case 10: return (bf16_t*)(ws + WS_WD);
    case 2: return (bf16_t*)(ws + WS_WIN);
    case 3: return (bf16_t*)(ws + WS_WV);
    case 4: return (bf16_t*)(ws + WS_WA);
    case 5: return (bf16_t*)(ws + WS_WB);
    case 6: return (bf16_t*)(ws + WS_WO);
    case 7: return (bf16_t*)(ws + WS_W1T);
    case 8: return (bf16_t*)(ws + WS_WRI);
    default: return (bf16_t*)(ws + WS_W2T);
    }
}
DI void conv_dims(int job, int& K, int& Nd) {
    switch (job) {
    case 0: case 9: K = DM; Nd = 11264; break;
    case 1: case 10: K = DFF; Nd = DM; break;
    case 2: K = DM; Nd = 12544; break;
    case 3: K = DM; Nd = 1024; break;
    case 4: case 5: case 6: K = DM; Nd = DM; break;
    case 7: K = 4096; Nd = 256; break;
    case 8: K = 128; Nd = 4096; break;
    default: K = 128; Nd = 256; break;
    }
}
DI void conv_item(int job, int item, KArgs a, LAS float* scr, int lane) {
    int K, Nd; conv_dims(job, K, Nd);
    const int nblk = Nd / 64, kb = item / nblk, nb = item % nblk, k0 = 64 * kb, n0 = 64 * nb;
    const int kk = lane >> 4, n4 = lane & 15;
    int ld; const float* src = conv_src(job, n0 + 4 * n4, a, ld);
    f32x4 v[16];
#pragma unroll
    for (int i = 0; i < 16; ++i) v[i] = src ? *(const f32x4*)(src + (size_t)(k0 + 4 * i + kk) * ld) : (f32x4){0.f, 0.f, 0.f, 0.f};
#pragma unroll
    for (int i = 0; i < 16; ++i) { LAS float* q = scr + (4 * i + kk) * 65 + 4 * n4; q[0] = v[i][0]; q[1] = v[i][1]; q[2] = v[i][2]; q[3] = v[i][3]; }
    LDS_WAIT();
    bf16_t* WT = conv_dst(job, a->ws);
    const int c = lane & 7, nn = lane >> 3;
#pragma unroll
    for (int j = 0; j < 8; ++j) { const int n = nn + 8 * j; const LAS float* q = scr + (8 * c) * 65 + n;
        u32x4 o; o.x = pk2(q[0 * 65], q[1 * 65]); o.y = pk2(q[2 * 65], q[3 * 65]); o.z = pk2(q[4 * 65], q[5 * 65]); o.w = pk2(q[6 * 65], q[7 * 65]);
        *(u32x4*)(WT + (size_t)(n0 + n) * K + k0 + 8 * c) = o; }
    LDS_WAIT();
}
DI void conv_jobs(int jlo, int jhi, KArgs a, LAS unsigned char* lds, int gw, int ngw, int wave, int lane) {
    LAS float* scr = (LAS float*)(lds + wave * 16640);
    for (int job = jlo; job < jhi; ++job) {
        int K, Nd; conv_dims(job, K, Nd);
        const int nit = (K / 64) * (Nd / 64);
        for (int it = gw; it < nit; it += ngw) conv_item(job, it, a, scr, lane);
    }
}

DI void row_load(f32x4 (&v)[8], const float* p, int lane) {
#pragma unroll
    for (int j = 0; j < 8; ++j) v[j] = *(const f32x4*)(p + 256 * j + 4 * lane);
}
DI float row_rstd(const f32x4 (&v)[8]) {
    float s = 0.f;
#pragma unroll
    for (int j = 0; j < 8; ++j) s += (v[j][0] * v[j][0] + v[j][1] * v[j][1]) + (v[j][2] * v[j][2] + v[j][3] * v[j][3]);
    return rsqrtf(wave_sum(s) * (1.f / DM) + EPS);
}
DI void row_modulate_store(const f32x4 (&v)[8], float rstd, const float* g, const float* sh, const float* sc, bf16_t* o, int lane) {
#pragma unroll
    for (int j = 0; j < 8; ++j) { const int c = 256 * j + 4 * lane; const f32x4 gg = *(const f32x4*)(g + c), s1 = *(const f32x4*)(sh + c), s2 = *(const f32x4*)(sc + c);
        const f32x4 r = (v[j] * rstd * gg) * (s2 + 1.f) + s1; u32x2 w; w.x = pk2(r[0], r[1]); w.y = pk2(r[2], r[3]); *(u32x2*)(o + c) = w; }
}
DI void row_residual(f32x4 (&v)[8], const float* f, const float* xres, const float* gate, const float* pg, float wgt, float* xo, int lane) {
    f32x4 fv[8]; row_load(fv, f, lane); const float rs = row_rstd(fv);
#pragma unroll
    for (int j = 0; j < 8; ++j) { const int c = 256 * j + 4 * lane; const f32x4 xr = *(const f32x4*)(xres + c), gt = *(const f32x4*)(gate + c), pp = *(const f32x4*)(pg + c);
        v[j] = xr + (gt * wgt) * (fv[j] * rs * pp); *(f32x4*)(xo + c) = v[j]; }
}

#define MFMA32(a, b, c) __builtin_amdgcn_mfma_f32_32x32x16_bf16((a), (b), (c), 0, 0, 0)
DI int crow(int r, int hi) { return (r & 3) + 8 * (r >> 2) + 4 * hi; }
constexpr int KPITCH = 272, VPITCH = 136, KVBUF = 17408;
constexpr int AL_K = 0, AL_V = 2 * KVBUF, AL_IMP4 = 4 * KVBUF, AL_IMPS = AL_IMP4 + 32768, AL_SEL = AL_IMPS + 8192;
constexpr float NEGB = -1e30f;
struct KVRegs { u32x4 k0, k1, v0, v1; };
DI void kv_load(KVRegs& R, const bf16_t* Kt, const bf16_t* Vt, int vpitch, int tid) {
    const int c = tid, c2 = tid + 512;
    R.k0 = *(const u32x4*)(Kt + (c >> 4) * 128 + (c & 15) * 8); R.k1 = *(const u32x4*)(Kt + (c2 >> 4) * 128 + (c2 & 15) * 8);
    R.v0 = *(const u32x4*)(Vt + (size_t)(c >> 3) * vpitch + (c & 7) * 8); R.v1 = *(const u32x4*)(Vt + (size_t)(c2 >> 3) * vpitch + (c2 & 7) * 8);
}
DI void kv_store(const KVRegs& R, LAS unsigned char* KB, LAS unsigned char* VB, int tid) {
    const int c = tid, c2 = tid + 512;
    *(LAS u32x4*)(KB + (c >> 4) * KPITCH + (c & 15) * 16) = R.k0; *(LAS u32x4*)(KB + (c2 >> 4) * KPITCH + (c2 & 15) * 16) = R.k1;
    LAS unsigned char* p = VB + (c >> 3) * VPITCH + (c & 7) * 16; *(LAS u32x2*)p = (u32x2){R.v0.x, R.v0.y}; *(LAS u32x2*)(p + 8) = (u32x2){R.v0.z, R.v0.w};
    p = VB + (c2 >> 3) * VPITCH + (c2 & 7) * 16; *(LAS u32x2*)p = (u32x2){R.v1.x, R.v1.y}; *(LAS u32x2*)(p + 8) = (u32x2){R.v1.z, R.v1.w};
}
DI void qk_tile(f32x16& p0, f32x16& p1, const LAS unsigned char* KB, const bf16x8 (&qr)[8], int r, int hi) {
#pragma unroll
    for (int i = 0; i < 16; ++i) { p0[i] = 0.f; p1[i] = 0.f; }
#pragma unroll
    for (int d0 = 0; d0 < 8; ++d0) {
        const bf16x8 a0 = *(const LAS bf16x8*)(KB + r * KPITCH + d0 * 32 + hi * 16), a1 = *(const LAS bf16x8*)(KB + (32 + r) * KPITCH + d0 * 32 + hi * 16);
        p0 = MFMA32(a0, qr[d0], p0); p1 = MFMA32(a1, qr[d0], p1);
    }
}
DI bf16x8 pack8(const f32x16& p, int s2) {
    u32x4 w; w.x = pk2(p[8 * s2], p[8 * s2 + 1]); w.y = pk2(p[8 * s2 + 2], p[8 * s2 + 3]); w.z = pk2(p[8 * s2 + 4], p[8 * s2 + 5]); w.w = pk2(p[8 * s2 + 6], p[8 * s2 + 7]);
    return __builtin_bit_cast(bf16x8, w);
}
DI void pv_tile(f32x16 (&o)[4], const LAS unsigned char* VB, const f32x16& p0, const f32x16& p1, int r, int hi) {
#pragma unroll
    for (int kb = 0; kb < 2; ++kb)
#pragma unroll
        for (int s2 = 0; s2 < 2; ++s2) {
            const bf16x8 pf = pack8(kb ? p1 : p0, s2);
#pragma unroll
            for (int db = 0; db < 4; ++db) {
                const LAS unsigned char* base = VB + (32 * db + r) * VPITCH + (32 * kb + 16 * s2 + 4 * hi) * 2;
                const s16x4 lo = *(const LAS s16x4*)base, hh = *(const LAS s16x4*)(base + 16);
                const bf16x8 af = __builtin_shufflevector(lo, hh, 0, 1, 2, 3, 4, 5, 6, 7);
                o[db] = MFMA32(af, pf, o[db]);
            }
        }
}
constexpr float SCL = 0.08838834764831845f * 1.4426950408889634f;

DI void flash_step(f32x16 (&o)[4], float& mrun, float& lrun, const LAS unsigned char* KB, const LAS unsigned char* VB, const bf16x8 (&qr)[8],
                   int r, int hi, int qpos, int key0, bool rowok, bool need_c, bool need_w) {
    f32x16 p0, p1; qk_tile(p0, p1, KB, qr, r, hi);
    float mt = NEGB;
#pragma unroll
    for (int i = 0; i < 16; ++i) {
        const int k0 = key0 + crow(i, hi), k1 = k0 + 32;
        bool v0 = rowok, v1 = rowok;
        if (need_c) { v0 = v0 && (k0 <= qpos); v1 = v1 && (k1 <= qpos); }
        if (need_w) { v0 = v0 && (k0 > qpos - 512); v1 = v1 && (k1 > qpos - 512); }
        p0[i] = v0 ? p0[i] * SCL : NEGB; p1[i] = v1 ? p1[i] * SCL : NEGB;
        mt = fmaxf(mt, fmaxf(p0[i], p1[i]));
    }
    mt = fmaxf(mt, __shfl_xor(mt, 32));
    const float mnew = fmaxf(mrun, mt);
    const float alpha = __builtin_amdgcn_exp2f(mrun - mnew);
    float ls = 0.f;
#pragma unroll
    for (int i = 0; i < 16; ++i) {
        p0[i] = (p0[i] > -1e29f) ? __builtin_amdgcn_exp2f(p0[i] - mnew) : 0.f;
        p1[i] = (p1[i] > -1e29f) ? __builtin_amdgcn_exp2f(p1[i] - mnew) : 0.f;
        ls += p0[i] + p1[i];
    }
    lrun = lrun * alpha + ls;
    if (__any(mnew > mrun)) {
#pragma unroll
        for (int db = 0; db < 4; ++db)
#pragma unroll
            for (int i = 0; i < 16; ++i) o[db][i] *= alpha;
    }
    mrun = mnew;
    pv_tile(o, VB, p0, p1, r, hi);
}

DI void nsa_unit(int bg, int qblk, unsigned char* ws, LAS unsigned char* lds) {
    const int tid = otid(), lane = tid & 63, r = lane & 31, hi = lane >> 5, wave = __builtin_amdgcn_readfirstlane(tid >> 6);
    const int b = bg >> 2, g = bg & 3, head = g * 4 + (wave >> 1), q0 = qblk * 64, qw0 = q0 + 32 * (wave & 1), qpos = qw0 + r;
    const size_t trow = (size_t)b * SEQ + qpos;
    const bf16_t* Qp = (const bf16_t*)(ws + WS_Q) + trow * DM + head * 128;
    bf16_t* Op = (bf16_t*)(ws + WS_XA) + trow * DM + head * 128;
    bf16x8 qr[8];
#pragma unroll
    for (int d0 = 0; d0 < 8; ++d0) qr[d0] = *(const bf16x8*)(Qp + d0 * 16 + hi * 8);
    const float* ngp = (const float*)(ws + WS_NG) + trow * 48 + head * 3;
    const float g0 = ngp[0], g1 = ngp[1], g2 = ngp[2];
    LAS unsigned char* KB0 = lds + AL_K; LAS unsigned char* VB0 = lds + AL_V;
    LAS float* IMP4 = (LAS float*)(lds + AL_IMP4); LAS float* IMPS = (LAS float*)(lds + AL_IMPS); LAS unsigned* SEL = (LAS unsigned*)(lds + AL_SEL);
    unsigned opk[4][8];
    KVRegs R;
    {
        const bf16_t* kc = (const bf16_t*)(ws + WS_KCC) + (size_t)bg * 128 * 128;
        const bf16_t* vct = (const bf16_t*)(ws + WS_VCT) + (size_t)bg * 128 * 128;
        kv_load(R, kc, vct, 128, tid); kv_store(R, KB0, VB0, tid);
        kv_load(R, kc + 64 * 128, vct + 64, 128, tid); kv_store(R, KB0 + KVBUF, VB0 + KVBUF, tid);
        if (tid < 65) SEL[tid] = 0u;
        __syncthreads();
        f32x16 pa0, pa1, pb0, pb1;
        qk_tile(pa0, pa1, KB0, qr, r, hi); qk_tile(pb0, pb1, KB0 + KVBUF, qr, r, hi);
        float mt = NEGB;
#pragma unroll
        for (int i = 0; i < 16; ++i) {
            const int n = crow(i, hi);
            pa0[i] = (16 * n + 31 <= qpos) ? pa0[i] * SCL : NEGB; pa1[i] = (16 * (n + 32) + 31 <= qpos) ? pa1[i] * SCL : NEGB;
            pb0[i] = (16 * (n + 64) + 31 <= qpos) ? pb0[i] * SCL : NEGB; pb1[i] = (16 * (n + 96) + 31 <= qpos) ? pb1[i] * SCL : NEGB;
            mt = fmaxf(fmaxf(mt, fmaxf(pa0[i], pa1[i])), fmaxf(pb0[i], pb1[i]));
        }
        mt = fmaxf(mt, __shfl_xor(mt, 32));
        float ls = 0.f;
#pragma unroll
        for (int i = 0; i < 16; ++i) {
            pa0[i] = (pa0[i] > -1e29f) ? __builtin_amdgcn_exp2f(pa0[i] - mt) : 0.f; pa1[i] = (pa1[i] > -1e29f) ? __builtin_amdgcn_exp2f(pa1[i] - mt) : 0.f;
            pb0[i] = (pb0[i] > -1e29f) ? __builtin_amdgcn_exp2f(pb0[i] - mt) : 0.f; pb1[i] = (pb1[i] > -1e29f) ? __builtin_amdgcn_exp2f(pb1[i] - mt) : 0.f;
            ls += (pa0[i] + pa1[i]) + (pb0[i] + pb1[i]);
        }
        ls += __shfl_xor(ls, 32);
        const float inv = ls > 0.f ? 1.f / ls : 0.f;
#pragma unroll
        for (int i = 0; i < 16; ++i) { pa0[i] *= inv; pa1[i] *= inv; pb0[i] *= inv; pb1[i] *= inv; }
        if (qblk >= 16) {
            LAS float* ip = IMP4 + ((wave >> 1) * 64 + 32 * (wave & 1) + r) * 32;
#define IMP_G(P, blk) _Pragma("unroll") for (int g4 = 0; g4 < 4; ++g4) ip[8 * (blk) + 2 * g4 + hi] = (P[4 * g4] + P[4 * g4 + 1]) + (P[4 * g4 + 2] + P[4 * g4 + 3]);
            IMP_G(pa0, 0) IMP_G(pa1, 1) IMP_G(pb0, 2) IMP_G(pb1, 3)
            LDS_WAIT();
#define IMP_L(P, blk) _Pragma("unroll") for (int g4 = 0; g4 < 4; ++g4) { const int j1 = 8 * (blk) + 2 * g4 + hi + 1; if (j1 < 32) ip[j1] += P[4 * g4 + 3]; }
            IMP_L(pa0, 0) IMP_L(pa1, 1) IMP_L(pb0, 2) IMP_L(pb1, 3)
#undef IMP_G
#undef IMP_L
        }
        f32x16 oc[4];
#pragma unroll
        for (int db = 0; db < 4; ++db)
#pragma unroll
            for (int i = 0; i < 16; ++i) oc[db][i] = 0.f;
        pv_tile(oc, VB0, pa0, pa1, r, hi); pv_tile(oc, VB0 + KVBUF, pb0, pb1, r, hi);
#pragma unroll
        for (int db = 0; db < 4; ++db)
#pragma unroll
            for (int i = 0; i < 8; ++i) opk[db][i] = pk2(oc[db][2 * i] * g0, oc[db][2 * i + 1] * g0);
    }
    __syncthreads();
    if (qblk >= 16) {
#pragma unroll
        for (int e = 0; e < 4; ++e) { const int idx = tid + 512 * e; IMPS[idx] = (IMP4[idx] + IMP4[2048 + idx]) + (IMP4[4096 + idx] + IMP4[6144 + idx]); }
        __syncthreads();
        const int q = tid >> 3;
        float val[32];
#pragma unroll
        for (int j4 = 0; j4 < 8; ++j4) { const f32x4 t4 = *(const LAS f32x4*)(IMPS + q * 32 + 4 * j4); val[4 * j4] = t4[0]; val[4 * j4 + 1] = t4[1]; val[4 * j4 + 2] = t4[2]; val[4 * j4 + 3] = t4[3]; }
        unsigned bits = 0u;
#pragma unroll
        for (int e = 0; e < 4; ++e) {
            const int j = (tid & 7) * 4 + e;
            float vj = 0.f;
#pragma unroll
            for (int i = 0; i < 32; ++i) vj = (i == j) ? val[i] : vj;
            int rank = 0;
#pragma unroll
            for (int i = 1; i < 32; ++i) { const bool cand = (i <= qblk - 2); rank += (cand && (val[i] > vj || (val[i] == vj && i < j))) ? 1 : 0; }
            const bool forced = (j == 0) || (j == qblk) || (j == qblk - 1);
            const bool sel = forced || (j >= 1 && j <= qblk - 2 && rank < 13);
            bits |= sel ? (1u << j) : 0u;
        }
        __hip_atomic_fetch_or(SEL + q, bits, __ATOMIC_RELAXED, __HIP_MEMORY_SCOPE_WORKGROUP);
        __syncthreads();
    } else {
        if (tid < 64) SEL[tid] = (2u << qblk) - 1u;
        __syncthreads();
    }
    if (tid < 64) { unsigned v = SEL[tid];
#pragma unroll
        for (int o = 1; o < 64; o <<= 1) v |= __shfl_xor(v, o);
        if (tid == 0) SEL[64] = v; }
    __syncthreads();
    const unsigned mysel = SEL[32 * (wave & 1) + r];
    unsigned uni = (unsigned)__builtin_amdgcn_readfirstlane(SEL[64]) & ((2u << qblk) - 1u);
#pragma unroll 1
    for (int mode = 0; mode < 2; ++mode) {
        const bf16_t* Kg = (const bf16_t*)(ws + (mode ? WS_KW : WS_KS)) + (size_t)bg * SEQ * 128;
        const bf16_t* Vg = (const bf16_t*)(ws + (mode ? WS_VWT : WS_VST)) + (size_t)bg * 128 * SEQ;
        unsigned todo;
        if (mode) { const int jlo = qblk >= 8 ? qblk - 8 : 0; todo = ((2u << qblk) - 1u) & ~((1u << jlo) - 1u); } else todo = uni;
        f32x16 o[4];
#pragma unroll
        for (int db = 0; db < 4; ++db)
#pragma unroll
            for (int i = 0; i < 16; ++i) o[db][i] = 0.f;
        float mrun = NEGB, lrun = 0.f;
        int cur = __builtin_ctz(todo); todo &= todo - 1u;
        kv_load(R, Kg + (size_t)cur * 64 * 128, Vg + cur * 64, SEQ, tid); kv_store(R, KB0, VB0, tid);
        int bi = 0;
        for (;;) {
            __syncthreads();
            const int nxt = todo ? __builtin_ctz(todo) : -1; todo &= todo - 1u;
            if (nxt >= 0) kv_load(R, Kg + (size_t)nxt * 64 * 128, Vg + nxt * 64, SEQ, tid);
            const int key0 = cur * 64;
            const bool rowok = mode ? true : (((mysel >> cur) & 1u) != 0u);
            const bool need_c = (key0 + 63 > qw0), need_w = mode && (key0 <= qw0 + 31 - 512);
            const bool wave_skip = mode ? (key0 + 63 <= qw0 - 512) : !__any(rowok);
            if (!wave_skip) flash_step(o, mrun, lrun, KB0 + bi * KVBUF, VB0 + bi * KVBUF, qr, r, hi, qpos, key0, rowok, need_c, need_w);
            if (nxt < 0) break;
            kv_store(R, KB0 + (bi ^ 1) * KVBUF, VB0 + (bi ^ 1) * KVBUF, tid);
            bi ^= 1; cur = nxt;
        }
        __syncthreads();
        lrun += __shfl_xor(lrun, 32);
        const float sc = (mode ? g2 : g1) / lrun;
#pragma unroll
        for (int db = 0; db < 4; ++db)
#pragma unroll
            for (int i = 0; i < 8; ++i) opk[db][i] = pk2(bflo(opk[db][i]) + o[db][2 * i] * sc, bfhi(opk[db][i]) + o[db][2 * i + 1] * sc);
    }
#pragma unroll
    for (int db = 0; db < 4; ++db)
#pragma unroll
        for (int g4 = 0; g4 < 4; ++g4) { u32x2 w; w.x = opk[db][2 * g4]; w.y = opk[db][2 * g4 + 1];
            *(u32x2*)(Op + 32 * db + 8 * g4 + 4 * hi) = w; }
}

#define NOINL __forceinline__
#define LDS_PTR() ((LAS unsigned char*)lds_raw)
extern __shared__ __attribute__((aligned(16))) unsigned char lds_raw[];

NOINL __device__ void ph_ffn_up(unsigned char* ws) {
    pg8::Gemm g{(const bf16_t*)(ws + WS_U), (const bf16_t*)(ws + WS_WGU), DM, DM, DM}; pg8::Sched S; S.init(64, 44, gridDim.x, blockIdx.x, 256L * DM * 2, 256L * DM * 2);
    EpiFFN E{(bf16_t*)(ws + WS_H)}; pg8::gemm_phase(LDS_PTR(), g, S, E);
}
NOINL __device__ void ph_ffn_down(unsigned char* ws) {
    pg8::Gemm g{(const bf16_t*)(ws + WS_H), (const bf16_t*)(ws + WS_WD), DFF, DFF, DFF}; pg8::Sched S; S.init(64, 8, gridDim.x, blockIdx.x, 256L * DFF * 2, 256L * DFF * 2);
    EpiF32 E{(float*)(ws + WS_F)}; pg8::gemm_phase(LDS_PTR(), g, S, E);
}
NOINL __device__ void ph_inproj(unsigned char* ws) {
    pg8::Gemm g{(const bf16_t*)(ws + WS_U), (const bf16_t*)(ws + WS_WIN), DM, DM, DM}; pg8::Sched S; S.init(64, 49, gridDim.x, blockIdx.x, 256L * DM * 2, 256L * DM * 2);
    EpiIn E{ws, (const float*)(ws + WS_ROPE)}; pg8::gemm_phase(LDS_PTR(), g, S, E);
}
NOINL __device__ void ph_vt(unsigned char* ws) {
    pg8::Gemm g{(const bf16_t*)(ws + WS_WV), (const bf16_t*)(ws + WS_U), DM, DM, DM}; pg8::Sched S; S.init(4, 64, gridDim.x, blockIdx.x, 256L * DM * 2, 256L * DM * 2);
    EpiVT E{(bf16_t*)(ws + WS_VST), (bf16_t*)(ws + WS_VWT)}; pg8::gemm_phase(LDS_PTR(), g, S, E);
}
NOINL __device__ void ph_cmp1(unsigned char* ws) {
    pg8::Gemm g{(const bf16_t*)(ws + WS_KC), (const bf16_t*)(ws + WS_W1T), 2048, 4096, 512}; pg8::Sched S; S.init(16, 16, gridDim.x, blockIdx.x, 0, 0); S.mode = 1; S.srcstride = (long)(WS_VC - WS_KC);
    EpiPart E{(float*)(ws + WS_PART)}; pg8::gemm_phase(LDS_PTR(), g, S, E);
}
NOINL __device__ void ph_ya(unsigned char* ws) {
    pg8::Gemm g{(const bf16_t*)(ws + WS_GY), (const bf16_t*)(ws + WS_WA), DM, DM, DM}; pg8::Sched S; S.init(64, 8, gridDim.x, blockIdx.x, 256L * DM * 2, 256L * DM * 2);
    EpiGate E{(const bf16_t*)(ws + WS_MG), nullptr, (bf16_t*)(ws + WS_Q), 0}; pg8::gemm_phase(LDS_PTR(), g, S, E);
}
NOINL __device__ void ph_yb(unsigned char* ws) {
    pg8::Gemm g{(const bf16_t*)(ws + WS_XA), (const bf16_t*)(ws + WS_WB), DM, DM, DM}; pg8::Sched S; S.init(64, 8, gridDim.x, blockIdx.x, 256L * DM * 2, 256L * DM * 2);
    EpiGate E{(const bf16_t*)(ws + WS_MG), (const bf16_t*)(ws + WS_Q), (bf16_t*)(ws + WS_U), 1}; pg8::gemm_phase(LDS_PTR(), g, S, E);
}
NOINL __device__ void ph_out(unsigned char* ws) {
    pg8::Gemm g{(const bf16_t*)(ws + WS_U), (const bf16_t*)(ws + WS_WO), DM, DM, DM}; pg8::Sched S; S.init(64, 8, gridDim.x, blockIdx.x, 256L * DM * 2, 256L * DM * 2);
    EpiF32 E{(float*)(ws + WS_FMIX)}; pg8::gemm_phase(LDS_PTR(), g, S, E);
}
NOINL __device__ void ph_cmp2(unsigned char* ws) {
    const int tid = otid(), lane = tid & 63, wave = __builtin_amdgcn_readfirstlane(tid >> 6), bx = blockIdx.x;
    if (wave >= 4 || bx >= 256) return;
    const int src = bx >> 7, rt = bx & 127;
    const int r = lane & 31, hh = lane >> 5;
    const float* P = (const float*)(ws + WS_PART); const float* peb = (const float*)(ws + WS_PEB) + src * 128;
    const bf16_t* w2t = (const bf16_t*)(ws + WS_W2T) + (size_t)src * 128 * 128;
    f32x16 acc;
#pragma unroll
    for (int i = 0; i < 16; ++i) acc[i] = 0.f;
#pragma unroll 1
    for (int st = 0; st < 8; ++st) {
        const int k0 = 16 * st + 8 * hh; float a[8];
#pragma unroll
        for (int e = 0; e < 8; ++e) a[e] = peb[k0 + e];
#pragma unroll
        for (int ks = 0; ks < 8; ++ks) { const float* pp = P + ((size_t)((ks * 2 + src) * 4096 + rt * 32 + r)) * 128 + k0;
            const f32x4 x0 = *(const f32x4*)pp, x1 = *(const f32x4*)(pp + 4); a[0] += x0[0]; a[1] += x0[1]; a[2] += x0[2]; a[3] += x0[3]; a[4] += x1[0]; a[5] += x1[1]; a[6] += x1[2]; a[7] += x1[3]; }
        u32x4 w; w.x = pk2(gelu_t(a[0]), gelu_t(a[1])); w.y = pk2(gelu_t(a[2]), gelu_t(a[3])); w.z = pk2(gelu_t(a[4]), gelu_t(a[5])); w.w = pk2(gelu_t(a[6]), gelu_t(a[7]));
        const bf16x8 af = __builtin_bit_cast(bf16x8, w);
        const bf16x8 bfr = *(const bf16x8*)(w2t + (size_t)(32 * wave + r) * 128 + k0);
        acc = MFMA32(af, bfr, acc);
    }
#pragma unroll
    for (int i = 0; i < 16; ++i) {
        const int R = rt * 32 + crow(i, hh), nrow = R & 127, bgi = R >> 7, d = 32 * wave + r;
        const float v = (nrow == 127) ? 0.f : acc[i];
        const bf16_t o = (bf16_t)(pk2(v, 0.f) & 0xffffu);
        if (src == 0) ((bf16_t*)(ws + WS_KCC))[(size_t)R * 128 + d] = o;
        else ((bf16_t*)(ws + WS_VCT))[((size_t)bgi * 128 + d) * 128 + nrow] = o;
    }
}
NOINL __device__ void ph_lru_gates(unsigned char* ws, const float* conv_w, const float* conv_b, const float* lbr, const float* lbi, const float* llam) {
    const int tid = otid(), lane = tid & 63, wave = __builtin_amdgcn_readfirstlane(tid >> 6), bx = blockIdx.x, G = gridDim.x;
    LAS unsigned char* lds = LDS_PTR();
    const int h = bx & 15, cuh = bx >> 4, nch = G >> 4;
    LAS unsigned char* WL = lds; LAS unsigned char* XS = lds + 69632 + wave * 8704; LAS float* CW = (LAS float*)(lds + 139264);
    const bf16_t* wri = (const bf16_t*)(ws + WS_WRI) + (size_t)h * 256 * 128;
#pragma unroll
    for (int e = 0; e < 8; ++e) { const int c = tid + 512 * e; *(LAS u32x4*)(WL + (c >> 4) * 272 + (c & 15) * 16) = *(const u32x4*)(wri + (c >> 4) * 128 + (c & 15) * 8); }
    if (tid < 128) { const int ch = h * 128 + tid;
        CW[tid] = conv_w[ch]; CW[128 + tid] = conv_w[DM + ch]; CW[256 + tid] = conv_w[2 * DM + ch]; CW[384 + tid] = conv_w[3 * DM + ch];
        CW[512 + tid] = conv_b[ch]; CW[640 + tid] = lbr[ch]; CW[768 + tid] = lbi[ch];
        const float lam = llam[ch], ex = __expf(-lam);
        CW[896 + tid] = (ex < 0.03f) ? ex * (1.f - ex * (0.5f - ex * (0.33333333f - ex * (0.25f - ex * 0.2f)))) : __logf(1.f + ex); }
    __syncthreads();
    const int r = lane & 31, hh = lane >> 5;
    const bf16_t* XA = (const bf16_t*)(ws + WS_XA); bf16_t* LA = (bf16_t*)(ws + WS_U); bf16_t* BBp = (bf16_t*)(ws + WS_BB);
#pragma unroll 1
    for (int rt = cuh * 8 + wave; rt < T / 32; rt += nch * 8) {
        const int t0 = rt * 32, tok = t0 + r, s = tok & 2047;
        bf16x8 af[8];
#pragma unroll
        for (int st = 0; st < 8; ++st) {
            const int ch0 = 16 * st + 8 * hh; float xc[8];
#pragma unroll
            for (int e = 0; e < 8; ++e) xc[e] = CW[512 + ch0 + e];
#pragma unroll
            for (int j = 0; j < 4; ++j) { if (s - 3 + j >= 0) { const u32x4 xv = *(const u32x4*)(XA + (size_t)(tok - 3 + j) * DM + h * 128 + ch0);
                xc[0] += CW[j * 128 + ch0 + 0] * bflo(xv.x); xc[1] += CW[j * 128 + ch0 + 1] * bfhi(xv.x); xc[2] += CW[j * 128 + ch0 + 2] * bflo(xv.y); xc[3] += CW[j * 128 + ch0 + 3] * bfhi(xv.y);
                xc[4] += CW[j * 128 + ch0 + 4] * bflo(xv.z); xc[5] += CW[j * 128 + ch0 + 5] * bfhi(xv.z); xc[6] += CW[j * 128 + ch0 + 6] * bflo(xv.w); xc[7] += CW[j * 128 + ch0 + 7] * bfhi(xv.w); } }
            u32x4 w; w.x = pk2(xc[0], xc[1]); w.y = pk2(xc[2], xc[3]); w.z = pk2(xc[4], xc[5]); w.w = pk2(xc[6], xc[7]);
            af[st] = __builtin_bit_cast(bf16x8, w);
            *(LAS u32x4*)(XS + r * 272 + ch0 * 2) = w;
            if (st & 1) asm volatile("" ::: "memory");
        }
        LDS_WAIT();
#pragma unroll 1
        for (int cb = 0; cb < 4; ++cb) {
            f32x16 aR, aI;
#pragma unroll
            for (int i = 0; i < 16; ++i) { aR[i] = 0.f; aI[i] = 0.f; }
#pragma unroll
            for (int st = 0; st < 8; ++st) {
                const bf16x8 bR = *(const LAS bf16x8*)(WL + (32 * cb + r) * 272 + st * 32 + hh * 16), bI = *(const LAS bf16x8*)(WL + (128 + 32 * cb + r) * 272 + st * 32 + hh * 16);
                aR = MFMA32(af[st], bR, aR); aI = MFMA32(af[st], bI, aI);
            }
            const int ch = 32 * cb + r; const float br_ = CW[640 + ch], bi_ = CW[768 + ch], sp_ = CW[896 + ch];
#pragma unroll
            for (int i = 0; i < 16; ++i) {
                const int tk = crow(i, hh);
                const float rr = sigm(aR[i] + br_), ig = sigm(aI[i] + bi_), la = -8.f * rr * sp_;
                const float xcv = bf2f(*(const LAS bf16_t*)(XS + tk * 272 + ch * 2));
                const float bm = sqrtf(fmaxf(1.f - __expf(2.f * la), 0.f)) * ig * xcv;
                const size_t o = (size_t)(t0 + tk) * DM + h * 128 + ch;
                LA[o] = (bf16_t)(pk2(la, 0.f) & 0xffffu); BBp[o] = (bf16_t)(pk2(bm, 0.f) & 0xffffu);
            }
        }
        LDS_WAIT();
    }
}
NOINL __device__ void ph_scan(unsigned char* ws) {
    const int tid = otid(), lane = tid & 63, wave = __builtin_amdgcn_readfirstlane(tid >> 6), bx = blockIdx.x, G = gridDim.x;
    LAS float* car = (LAS float*)LDS_PTR();
    const bf16_t* LA = (const bf16_t*)(ws + WS_U); const bf16_t* BBp = (const bf16_t*)(ws + WS_BB); bf16_t* GY = (bf16_t*)(ws + WS_GY);
    for (int unit = bx; unit < 256; unit += G) {
        const int b = unit >> 5, ch = (unit & 31) * 64 + lane;
        const size_t base = ((size_t)b * SEQ + wave * 256) * DM + ch;
        float hst = 0.f, ssum = 0.f;
#pragma unroll 1
        for (int t = 0; t < 256; t += 16) { float la[16], bb[16];
#pragma unroll
            for (int e = 0; e < 16; ++e) { la[e] = bf2f(LA[base + (size_t)(t + e) * DM]); bb[e] = bf2f(BBp[base + (size_t)(t + e) * DM]); }
#pragma unroll
            for (int e = 0; e < 16; ++e) { hst = __expf(la[e]) * hst + bb[e]; ssum += la[e]; } }
        car[(wave * 2) * 64 + lane] = __expf(ssum); car[(wave * 2 + 1) * 64 + lane] = hst;
        __syncthreads();
        float hin = 0.f;
        for (int w = 0; w < wave; ++w) hin = car[(w * 2) * 64 + lane] * hin + car[(w * 2 + 1) * 64 + lane];
        hst = hin;
#pragma unroll 1
        for (int t = 0; t < 256; t += 16) { float la[16], bb[16], gy[16];
#pragma unroll
            for (int e = 0; e < 16; ++e) { la[e] = bf2f(LA[base + (size_t)(t + e) * DM]); bb[e] = bf2f(BBp[base + (size_t)(t + e) * DM]); gy[e] = bf2f(GY[base + (size_t)(t + e) * DM]); }
#pragma unroll
            for (int e = 0; e < 16; ++e) { hst = __expf(la[e]) * hst + bb[e]; GY[base + (size_t)(t + e) * DM] = (bf16_t)(pk2(hst * gy[e], 0.f) & 0xffffu); } }
        __syncthreads();
    }
}
NOINL __device__ void ph_nsa(unsigned char* ws) {
    const int bx = blockIdx.x, G = gridDim.x;
    const int vcu = (G % 8 == 0) ? (bx % 8) * (G / 8) + bx / 8 : bx;
#pragma unroll 1
    for (int uu = vcu; uu < 1024; uu += G) {
        const int pr = uu & 255, it = uu >> 8, bg = pr >> 3, s = pr & 7;
        const int qblk = (it == 0) ? s : (it == 1) ? 15 - s : (it == 2) ? 16 + s : 31 - s;
        nsa_unit(bg, qblk, ws, LDS_PTR());
    }
}

constexpr size_t WS_BAR = 960 * 1024;
constexpr int LDS_BARST = LDS_BYTES - 16;
#define XB_TMO      128
#define XB_XCNT(j)  (256  + 64 * (j))
#define XB_XSUB(j)  (1280 + 64 * (j))
#define XB_XGEN(j)  (2304 + 64 * (j))
#define XB_TOP      3328
#define XB_TOPGEN   3392
#define XCD_BAR_WORDS 3456
#define XB_SPIN_CAP (1u << 18)
DI unsigned xb_ld(unsigned* p)              { return __hip_atomic_load(p, __ATOMIC_RELAXED, __HIP_MEMORY_SCOPE_AGENT); }
DI unsigned xb_add(unsigned* p, unsigned v) { return __hip_atomic_fetch_add(p, v, __ATOMIC_RELAXED, __HIP_MEMORY_SCOPE_AGENT); }
DI unsigned xb_xcc_id() { return (unsigned)__builtin_amdgcn_s_getreg((3 << 11) | 20) & 0xFu; }
#define XB_SPIN(cond, bar) do { unsigned _sp = 0; while (cond) { __builtin_amdgcn_s_sleep(1); \
    if ((++_sp & 255u) == 0u) { if (xb_ld(&(bar)[XB_TMO])) break; if (_sp > XB_SPIN_CAP) { atomicAdd(&(bar)[XB_TMO], 1u); break; } } } } while (0)
DI void xcd_barrier_complete(unsigned* bar, unsigned x, unsigned& nloc, unsigned& nx) {
    const unsigned G = gridDim.x * gridDim.y * gridDim.z;
    unsigned sum, cnt, mine, sp = 0u;
    for (;;) {
        sum = 0u; cnt = 0u; mine = 0u;
#pragma unroll
        for (unsigned j = 0; j < 16; ++j) { const unsigned c = xb_ld(&bar[XB_XCNT(j)]); sum += c; cnt += (c > 0u) ? 1u : 0u; mine = (j == x) ? c : mine; }
        if (sum == G) break;
        __builtin_amdgcn_s_sleep(1);
        if ((++sp & 255u) == 0u) { if (xb_ld(&bar[XB_TMO])) break; if (sp > XB_SPIN_CAP) { atomicAdd(&bar[XB_TMO], 1u); break; } }
    }
    nloc = mine > 0u ? mine : 1u; nx = cnt > 0u ? cnt : 1u;
}
DI void xcd_barrier(unsigned* bar) {
    asm volatile("s_waitcnt vmcnt(0)" ::: "memory");
    __syncthreads();
    if (threadIdx.x == 0) {
        volatile LAS unsigned* st = (volatile LAS unsigned*)(LDS_PTR() + LDS_BARST);
        const unsigned x = xb_xcc_id();
        __builtin_amdgcn_s_waitcnt(0);
        unsigned nloc = st[0], nx = st[1];
        if (nloc == 0u) { xcd_barrier_complete(bar, x, nloc, nx); st[0] = nloc; st[1] = nx; }
        const unsigned old = xb_add(&bar[XB_XSUB(x)], 1u);
        const unsigned gen = old / nloc;
        if (old + 1u == (gen + 1u) * nloc) {
            __builtin_amdgcn_fence(__ATOMIC_RELEASE, "agent");
            asm volatile("s_waitcnt vmcnt(0)" ::: "memory");
            const unsigned og = xb_add(&bar[XB_TOP], 1u);
            const unsigned tg = og / nx;
            if (og + 1u == (tg + 1u) * nx) xb_add(&bar[XB_TOPGEN], 1u);
            else XB_SPIN(xb_ld(&bar[XB_TOPGEN]) == tg, bar);
            __builtin_amdgcn_fence(__ATOMIC_ACQUIRE, "agent");
            xb_add(&bar[XB_XGEN(x)], 1u);
            asm volatile("s_waitcnt vmcnt(0)" ::: "memory");
        } else {
            XB_SPIN(xb_ld(&bar[XB_XGEN(x)]) == gen, bar);
            __builtin_amdgcn_fence(__ATOMIC_ACQUIRE, "agent");
            asm volatile("s_waitcnt vmcnt(0)" ::: "memory");
        }
    }
    __syncthreads();
}

DI KArgs oargs() { auto p = __builtin_amdgcn_kernarg_segment_ptr(); asm volatile("" : "+s"(p)); return (KArgs)p; }

DI void ph_prologue() {
    KArgs ka = oargs();
    LAS unsigned char* lds = LDS_PTR(); unsigned char* ws = ka->ws; float* mod = (float*)(ws + WS_MOD);
    const int tid = otid(), lane = tid & 63, wave = __builtin_amdgcn_readfirstlane(tid >> 6), G = gridDim.x, bx = blockIdx.x, gw = bx * NWV + wave, ngw = G * NWV;
    if (bx < 72) {
        LAS float* cact = (LAS float*)lds;
        LAS float* red = (LAS float*)(lds + 65536);
        const float* c = ka->in[1]; const float* wada = ka->in[2]; const float* bada = ka->in[3];
        for (int i = tid; i < NB * DM; i += NTHR) { const float v = c[i]; cact[i] = v * sigm(v); }
        __syncthreads();
        const int col = bx * 256 + 4 * lane;
        f32x4 acc[8];
#pragma unroll
        for (int b = 0; b < 8; ++b) acc[b] = (f32x4){0.f, 0.f, 0.f, 0.f};
        const float* wp = wada + (size_t)(wave * 256) * (NADA * DM) + col;
#pragma unroll 1
        for (int k = 0; k < 256; k += 8) {
            f32x4 w[8];
#pragma unroll
            for (int e = 0; e < 8; ++e) w[e] = *(const f32x4*)(wp + (size_t)(k + e) * (NADA * DM));
#pragma unroll
            for (int e = 0; e < 8; ++e)
#pragma unroll
                for (int b = 0; b < 8; ++b) acc[b] += w[e] * cact[b * DM + wave * 256 + k + e];
        }
#pragma unroll
        for (int b = 0; b < 8; ++b) *(LAS f32x4*)(red + (wave * 8 + b) * 256 + 4 * lane) = acc[b];
        __syncthreads();
#pragma unroll
        for (int e = 0; e < 4; ++e) { const int idx = tid + 512 * e, b = idx >> 8, cc = idx & 255; float sum = bada[bx * 256 + cc];
#pragma unroll
            for (int w = 0; w < 8; ++w) sum += red[(w * 8 + b) * 256 + cc];
            mod[b * (NADA * DM) + bx * 256 + cc] = sum; }
        __syncthreads();
    }
    conv_jobs(0, 9, ka, lds, gw, ngw, wave, lane);
    conv_jobs(11, 12, ka, lds, gw, ngw, wave, lane);
    {
        const int idx = bx * NTHR + tid;
        if (idx < SEQ * 16) { const int pos = idx >> 4, i = idx & 15;
            const float invf = __builtin_amdgcn_exp2f(-(float)i * 1.1832230356f); const float ang = (float)pos * invf;
            const float rev = ang * 0.15915494309189535f, fr = rev - floorf(rev);
            float* rp = (float*)(ws + WS_ROPE) + pos * 32; rp[i] = __builtin_amdgcn_cosf(fr); rp[16 + i] = __builtin_amdgcn_sinf(fr); }
    }
    if (bx >= G - 2) {
        const int src = bx - (G - 2); const float* pe = ka->in[src ? 22 : 19]; const float* w1 = ka->in[src ? 23 : 20];
        __syncthreads();
        LAS float* red = (LAS float*)lds;
        const int d = tid & 127, qt = tid >> 7; float s = 0.f;
        for (int k = qt * 1024; k < qt * 1024 + 1024; ++k) s += pe[k] * w1[(size_t)k * 128 + d];
        red[tid] = s; __syncthreads();
        if (tid < 128) ((float*)(ws + WS_PEB))[src * 128 + tid] = (red[tid] + red[128 + tid]) + (red[256 + tid] + red[384 + tid]);
    }
    __syncthreads();
}
DI void ph_rows(int which) {
    KArgs ka = oargs(); unsigned char* ws = ka->ws; float* out = ka->out; const float* mod = (const float*)(ws + WS_MOD);
    const int tid = otid(), lane = tid & 63, wave = __builtin_amdgcn_readfirstlane(tid >> 6), G = gridDim.x, bx = blockIdx.x, gw = bx * NWV + wave, ngw = G * NWV;
    if (which == 0) {
        const float* x = ka->in[0]; const float* g = ka->in[4];
        for (int row = gw; row < T; row += ngw) { const int b = row >> 11; f32x4 v[8]; row_load(v, x + (size_t)row * DM, lane); const float rs = row_rstd(v);
            row_modulate_store(v, rs, g, mod + b * (NADA * DM) + 0 * DM, mod + b * (NADA * DM) + 1 * DM, (bf16_t*)(ws + WS_U) + (size_t)row * DM, lane); }
    } else if (which == 1) {
        const float* x = ka->in[0]; const float* pg = ka->in[5]; const float* g = ka->in[9];
        for (int row = gw; row < T; row += ngw) { const int b = row >> 11; const float* mb = mod + b * (NADA * DM); f32x4 v[8];
            row_residual(v, (const float*)(ws + WS_F) + (size_t)row * DM, x + (size_t)row * DM, mb + 2 * DM, pg, 0.5f, out + (size_t)row * DM, lane);
            const float rs = row_rstd(v); row_modulate_store(v, rs, g, mb + 3 * DM, mb + 4 * DM, (bf16_t*)(ws + WS_U) + (size_t)row * DM, lane); }
    } else if (which == 2) {
        const float* pg = ka->in[10]; const float* g = ka->in[28];
        for (int row = gw; row < T; row += ngw) { const int b = row >> 11; const float* mb = mod + b * (NADA * DM); f32x4 v[8];
            row_residual(v, (const float*)(ws + WS_FMIX) + (size_t)row * DM, out + (size_t)row * DM, mb + 5 * DM, pg, 1.0f, out + (size_t)row * DM, lane);
            const float rs = row_rstd(v); row_modulate_store(v, rs, g, mb + 6 * DM, mb + 7 * DM, (bf16_t*)(ws + WS_U) + (size_t)row * DM, lane); }
        conv_jobs(9, 11, ka, LDS_PTR(), gw, ngw, wave, lane);
    } else {
        const float* pg = ka->in[29];
        for (int row = gw; row < T; row += ngw) { const int b = row >> 11; const float* mb = mod + b * (NADA * DM); f32x4 v[8];
            row_residual(v, (const float*)(ws + WS_F) + (size_t)row * DM, out + (size_t)row * DM, mb + 8 * DM, pg, 0.5f, out + (size_t)row * DM, lane); }
    }
}

__global__ void __launch_bounds__(NTHR) fwd_kernel(Args args_unused) {
    cg::grid_group grid = cg::this_grid();
    {
        volatile LAS unsigned* st = (volatile LAS unsigned*)(LDS_PTR() + LDS_BARST);
        if (threadIdx.x < 2) st[threadIdx.x] = 0u;
        __syncthreads();
        if (threadIdx.x == 0) (void)xb_add((unsigned*)(oargs()->ws + WS_BAR) + XB_XCNT(xb_xcc_id()), 1u);
    }
#ifndef PH_MASK
#define PH_MASK 0xffff
#endif
#define WSP() (oargs()->ws)
#pragma unroll 1
    for (int ph = oargs()->ph_lo; ph < oargs()->ph_hi; ++ph) {
        switch (ph) {
#ifndef PROBE_DUP
#define PROBE_DUP 0
#endif
#define ON(k) for (int _rep = 0; _rep < 1 + (((PROBE_DUP) >> (k)) & 1); ++_rep) if (((PH_MASK) >> (k)) & 1)
        case 0: ON(0) ph_prologue(); break;
        case 1: ON(1) ph_rows(0); break;
        case 2: case 13: ON(2) ph_ffn_up(WSP()); break;
        case 3: case 14: ON(3) ph_ffn_down(WSP()); break;
        case 4: ON(4) ph_rows(1); break;
        case 5: ON(5) { ph_inproj(WSP()); ph_vt(WSP()); } break;
        case 6: ON(6) ph_cmp1(WSP()); break;
        case 7: ON(7) { ph_cmp2(WSP()); __syncthreads(); KArgs ka = oargs(); ph_lru_gates(ka->ws, ka->in[12], ka->in[13], ka->in[15], ka->in[17], ka->in[18]); } break;
        case 8: ph_scan(WSP()); ON(8) { ph_nsa(WSP()); } break;
        case 9: ON(9) ph_ya(WSP()); break;
        case 10: ON(10) ph_yb(WSP()); break;
        case 11: ON(11) ph_out(WSP()); break;
        case 12: ON(12) ph_rows(2); break;
        default: ON(15) ph_rows(3); break;
        }
        if (ph + 1 < oargs()->ph_hi) { if (ph == oargs()->ph_lo) grid.sync(); else xcd_barrier((unsigned*)(oargs()->ws + WS_BAR)); }
    }
}

extern "C" void kernel_launch(void* const* d_in, const int* in_sizes, int n_in, void* d_out, int out_size, void* d_ws, size_t ws_size, hipStream_t stream) {
    static int grid = 0;
    if (grid == 0) {
        if (n_in != 33 || out_size != T * DM || ws_size < WS_END) { fprintf(stderr, "kernel_launch: unexpected problem (n_in %d out %d ws %zu)\n", n_in, out_size, ws_size); grid = -1; return; }
        int dev = 0, cus = 0, per_cu = 0;
        hipGetDevice(&dev); hipDeviceGetAttribute(&cus, hipDeviceAttributeMultiprocessorCount, dev);
        if (hipFuncSetAttribute((const void*)fwd_kernel, hipFuncAttributeMaxDynamicSharedMemorySize, LDS_BYTES) != hipSuccess) { fprintf(stderr, "kernel_launch: hipFuncSetAttribute failed\n"); grid = -1; return; }
        if (hipOccupancyMaxActiveBlocksPerMultiprocessor(&per_cu, (const void*)fwd_kernel, NTHR, LDS_BYTES) != hipSuccess || per_cu < 1) { fprintf(stderr, "kernel_launch: occupancy query gives %d\n", per_cu); per_cu = 1; }
        (void)hipGetLastError();
        grid = cus;
    }
    if (grid < 0) return;
    if (hipMemsetAsync((char*)d_ws + WS_BAR, 0, 16384, stream) != hipSuccess) { fprintf(stderr, "kernel_launch: memset of the barrier words failed\n"); return; }
    Args a{};
    for (int i = 0; i < 33; ++i) a.in[i] = (const float*)d_in[i];
    a.out = (float*)d_out; a.ws = (unsigned char*)d_ws;
#if ONE_LAUNCH
    a.ph_lo = 0; a.ph_hi = 16;
    void* params[] = {&a};
    hipError_t e = hipLaunchCooperativeKernel((const void*)fwd_kernel, dim3(grid), dim3(NTHR), params, LDS_BYTES, stream);
    if (e != hipSuccess) fprintf(stderr, "cooperative launch failed: %s (grid %d)\n", hipGetErrorString(e), grid);
#else
    for (int p = 0; p < 16; ++p) { a.ph_lo = p; a.ph_hi = p + 1; hipLaunchKernelGGL(fwd_kernel, dim3(grid), dim3(NTHR), LDS_BYTES, stream, a); }
#endif
}
```

```cpp
#include <hip/hip_runtime.h>
#include <hip/hip_cooperative_groups.h>
#include <cstdio>
#include <cstdint>
namespace cg = cooperative_groups;


#ifndef ONE_LAUNCH
#define ONE_LAUNCH 1
#endif

#define LAS __attribute__((address_space(3)))
#define DI __device__ __forceinline__
typedef unsigned short bf16_t;
typedef short bf16x8 __attribute__((ext_vector_type(8)));
typedef short s16x4 __attribute__((ext_vector_type(4)));
typedef float f32x2 __attribute__((ext_vector_type(2)));
typedef float f32x4 __attribute__((ext_vector_type(4)));
typedef float f32x16 __attribute__((ext_vector_type(16)));
typedef unsigned u32x2 __attribute__((ext_vector_type(2)));
typedef unsigned u32x4 __attribute__((ext_vector_type(4)));
typedef __bf16 bf16x2_t __attribute__((ext_vector_type(2)));

constexpr int DM = 2048, NB = 8, SEQ = 2048, T = NB * SEQ, DFF = 5632, NADA = 9;
constexpr int INW = 13360;
constexpr int NTHR = 512, NWV = 8;
constexpr float EPS = 1e-6f;
constexpr size_t MiB = 1u << 20;
constexpr size_t WS_MOD = 0;
constexpr size_t WS_ROPE = 640 * 1024;
constexpr size_t WS_PEB = 900 * 1024;
constexpr size_t WS_W2T = 1 * MiB;
constexpr size_t WS_WGU = 2 * MiB, WS_WD = 46 * MiB;
constexpr size_t WS_BB = 2 * MiB;
constexpr size_t WS_WIN = 68 * MiB, WS_WV = 117 * MiB, WS_WA = 640 * MiB, WS_WB = 648 * MiB, WS_WO = 656 * MiB;
constexpr size_t WS_HG = 68 * MiB;
constexpr size_t WS_PART = 68 * MiB;
constexpr size_t WS_W1T = 145 * MiB, WS_WRI = 147 * MiB, WS_KCC = 152 * MiB, WS_VCT = 153 * MiB, WS_NG = 154 * MiB;
constexpr size_t WS_U = 160 * MiB;
constexpr size_t WS_H = 224 * MiB, WS_F = 400 * MiB;
constexpr size_t WS_XA = 224 * MiB, WS_GY = 288 * MiB, WS_Q = 352 * MiB, WS_KC = 416 * MiB, WS_VC = 432 * MiB, WS_KS = 448 * MiB, WS_KW = 464 * MiB;
constexpr size_t WS_VST = 480 * MiB, WS_VWT = 496 * MiB, WS_MG = 512 * MiB, WS_FMIX = 512 * MiB;
constexpr size_t WS_END = 664 * MiB;
constexpr int LDS_BYTES = 147456;

struct Args { const float* in[33]; float* out; unsigned char* ws; int ph_lo, ph_hi; };
typedef const Args __attribute__((address_space(4)))* KArgs;

DI unsigned pk2(float lo, float hi) { f32x2 v = {lo, hi}; bf16x2_t b = __builtin_convertvector(v, bf16x2_t); return __builtin_bit_cast(unsigned, b); }
DI float bf2f(bf16_t v) { return __uint_as_float((unsigned)v << 16); }
DI float bflo(unsigned w) { return __uint_as_float(w << 16); }
DI float bfhi(unsigned w) { return __uint_as_float(w & 0xffff0000u); }
DI float sigm(float x) { return 1.f / (1.f + __expf(-x)); }
DI float gelu_t(float x) { const float u = 0.7978845608028654f * (x + 0.044715f * x * x * x); return x / (1.f + __expf(-2.f * u)); }
DI float wave_sum(float v) {
#pragma unroll
    for (int o = 1; o < 64; o <<= 1) v += __shfl_xor(v, o);
    return v;
}
#define LDS_WAIT() asm volatile("s_waitcnt lgkmcnt(0)" ::: "memory")
DI int otid() { int t = threadIdx.x; asm volatile("" : "+v"(t)); return t; }

namespace pg8 {
constexpr int BM = 256, BK = 64, HALF = 128, HTB = HALF * BK * 2, STAGE_BYTES = 8 * HTB, NXCD = 8, WGM = 8;
DI int lds_byte(int r, int c) { const int st = (r >> 4) * 2 + (c >> 5), rr = r & 15, cc = c & 31, ob = rr * 64 + cc * 2; return st * 1024 + (ob ^ (((ob >> 9) & 1) << 5)); }
DI void stage_rc(int b, int& R, int& C) { const int st = b / 1024, sb = b % 1024, swz = sb ^ (((sb >> 9) & 1) << 5); R = (st >> 1) * 16 + swz / 64; C = (st & 1) * 32 + (swz % 64) / 2; }
DI int perm32(int rho) { const int n = rho >> 4, i = rho & 15; return 8 * (i >> 2) + 4 * n + (i & 3); }

struct Unit { int pm, pn; long aoff, boff; };
struct Gemm { const bf16_t* A; const bf16_t* Bt; int lda, ldb, K; };
struct Sched {
    int nM, nN, nwg, G, c, mode; long astep, bstep, srcstride;
    DI void init(int nM_, int nN_, int G_, int c_, long astep_, long bstep_) { nM = nM_; nN = nN_; nwg = nM * nN; G = G_; c = c_; mode = 0; astep = astep_; bstep = bstep_; srcstride = 0; }
    DI bool next(int i, Unit& u) const {
        const long L = (long)i * G + c; if (L >= nwg) return false;
        int wgid = (int)L;
        if (mode == 1) {
            const int pm = wgid & 15, ks = (wgid >> 4) & 7, src = wgid >> 7;
            u.pm = pm; u.pn = src + 2 * ks; u.aoff = (long)src * srcstride + (long)pm * 256 * 2048 * 2 + (long)ks * 1024; u.boff = (long)ks * 1024; return true;
        }
        { const int q = nwg / NXCD, r = nwg % NXCD, xcd = wgid % NXCD, off = wgid / NXCD; wgid = (xcd < r ? xcd * (q + 1) : r * (q + 1) + (xcd - r) * q) + off; }
        const int nig = WGM * nN, gid = wgid / nig, fm = gid * WGM, gsz = (nM - fm) < WGM ? (nM - fm) : WGM;
        u.pm = fm + ((wgid % nig) % gsz); u.pn = (wgid % nig) / gsz; u.aoff = (long)u.pm * astep; u.boff = (long)u.pn * bstep; return true;
    }
};

template <class Epi>
DI void gemm_phase(LAS unsigned char* lds, const Gemm g, const Sched& S, const Epi& E) {
    const int tid = otid(), wid = __builtin_amdgcn_readfirstlane(tid >> 6), lane = tid & 63, wr = wid >> 2, wc = wid & 3, fr = lane & 15, fq = lane >> 4;
    const int K = g.K, nt = K / BK;
    unsigned voffA[2], voffB[2];
#pragma unroll
    for (int i = 0; i < 2; ++i) { int R, C; stage_rc(tid * 16 + i * 8192, R, C); const int Rb = Epi::PERM ? ((R & ~31) + perm32(R & 31)) : R;
        voffA[i] = (unsigned)(R * g.lda + C) * 2u; voffB[i] = (unsigned)(Rb * g.ldb + C) * 2u; }
    const size_t kstep = (size_t)(BK * 2);
    const size_t hsA = (size_t)HALF * g.lda * 2, hsB = (size_t)HALF * g.ldb * 2;
    const unsigned ldsw = (unsigned)wid * 1024u;
    const int aoff = lds_byte(wr * 64 + fr, fq * 8), boff = lds_byte(wc * 32 + fr, fq * 8);
#define PG8_SA(b, h) (((b) * 2 + (h)) * HTB)
#define PG8_SB(b, h) ((4 + (b) * 2 + (h)) * HTB)
#define PG8_STAGE(bufoff, gbase, voff) do { _Pragma("unroll") for (int _i = 0; _i < 2; ++_i) \
        __builtin_amdgcn_global_load_lds((const unsigned*)((const char*)(gbase) + (voff)[_i]), (LAS unsigned*)(lds + (bufoff) + ldsw + _i * 8192), 16, 0, 0); } while (0)
#define PG8_LDA(dst, b, h) do { _Pragma("unroll") for (int m = 0; m < 4; ++m) _Pragma("unroll") for (int k = 0; k < 2; ++k) dst[m][k] = *(const LAS bf16x8*)(lds + PG8_SA(b, h) + aoff + m * 2048 + k * 1024); } while (0)
#define PG8_LDB(dst, b, h) do { _Pragma("unroll") for (int n = 0; n < 2; ++n) _Pragma("unroll") for (int k = 0; k < 2; ++k) dst[n][k] = *(const LAS bf16x8*)(lds + PG8_SB(b, h) + boff + n * 2048 + k * 1024); } while (0)
#define PG8_MMA(ai, bj, At, Bt) do { __builtin_amdgcn_s_setprio(1); _Pragma("unroll") for (int m = 0; m < 4; ++m) _Pragma("unroll") for (int n = 0; n < 2; ++n) _Pragma("unroll") for (int k = 0; k < 2; ++k) \
        acc[ai][bj][m][n] = __builtin_amdgcn_mfma_f32_16x16x32_bf16(Bt[n][k], At[m][k], acc[ai][bj][m][n], 0, 0, 0); __builtin_amdgcn_s_setprio(0); } while (0)
#define PG8_WAIT_V(n) asm volatile("s_waitcnt vmcnt(" #n ")" ::: "memory")
#define PG8_WAIT_L(n) asm volatile("s_waitcnt lgkmcnt(" #n ")" ::: "memory")
#define PG8_BAR __builtin_amdgcn_s_barrier()
#define PG8_SCHED __builtin_amdgcn_sched_barrier(0)
    Unit cur, nxt; int ui = 0;
    if (!S.next(0, cur)) return;
    f32x4 acc[2][2][4][2];
#pragma unroll
    for (int a = 0; a < 2; ++a)
#pragma unroll
        for (int b = 0; b < 2; ++b)
#pragma unroll
            for (int m = 0; m < 4; ++m)
#pragma unroll
                for (int n = 0; n < 2; ++n) acc[a][b][m][n] = (f32x4){0.f, 0.f, 0.f, 0.f};
    bf16x8 At[4][2], B0[2][2], B1[2][2];
    const char* cA = (const char*)g.A + cur.aoff; const char* cB = (const char*)g.Bt + cur.boff;
    PG8_STAGE(PG8_SB(0, 0), cB, voffB); PG8_STAGE(PG8_SB(0, 1), cB + hsB, voffB); PG8_STAGE(PG8_SA(0, 0), cA, voffA); PG8_STAGE(PG8_SA(0, 1), cA + hsA, voffA);
    if (wr == 1) PG8_BAR;
    PG8_WAIT_V(2); PG8_BAR;
    PG8_STAGE(PG8_SB(1, 0), cB + kstep, voffB); PG8_STAGE(PG8_SA(1, 0), cA + kstep, voffA); PG8_STAGE(PG8_SB(1, 1), cB + hsB + kstep, voffB);
    PG8_WAIT_V(6); PG8_BAR;
    for (;;) {
        const bool has_next = S.next(ui + 1, nxt);
        const char* nA = has_next ? (const char*)g.A + nxt.aoff : cA; const char* nB = has_next ? (const char*)g.Bt + nxt.boff : cB;
        for (int t = 0; t < nt; t += 2) {
            const bool last = (t == nt - 2);
            const char* a1 = cA + (size_t)(t + 1) * kstep;
            const char* a2 = last ? nA : cA + (size_t)(t + 2) * kstep; const char* b2 = last ? nB : cB + (size_t)(t + 2) * kstep;
            const char* a3 = a2 + kstep; const char* b3 = b2 + kstep;
            PG8_LDB(B0, 0, 0); PG8_LDB(B1, 0, 1); PG8_SCHED; PG8_LDA(At, 0, 0); PG8_STAGE(PG8_SA(1, 1), a1 + hsA, voffA);
            PG8_WAIT_V(8); PG8_WAIT_L(0); PG8_BAR; PG8_MMA(0, 0, At, B0); PG8_MMA(0, 1, At, B1); PG8_BAR; PG8_SCHED;
            PG8_LDA(At, 0, 1); PG8_STAGE(PG8_SB(0, 0), b2, voffB); PG8_STAGE(PG8_SB(0, 1), b2 + hsB, voffB); PG8_STAGE(PG8_SA(0, 0), a2, voffA);
            PG8_WAIT_V(8); PG8_WAIT_L(0); PG8_BAR; PG8_MMA(1, 0, At, B0); PG8_MMA(1, 1, At, B1); PG8_BAR; PG8_SCHED;
            PG8_LDB(B0, 1, 0); PG8_LDB(B1, 1, 1); PG8_SCHED; PG8_LDA(At, 1, 0); PG8_STAGE(PG8_SA(0, 1), a2 + hsA, voffA);
            PG8_WAIT_V(8); PG8_WAIT_L(0); PG8_BAR; PG8_MMA(0, 0, At, B0); PG8_MMA(0, 1, At, B1); PG8_BAR; PG8_SCHED;
            PG8_LDA(At, 1, 1); PG8_STAGE(PG8_SB(1, 0), b3, voffB); PG8_STAGE(PG8_SB(1, 1), b3 + hsB, voffB); PG8_STAGE(PG8_SA(1, 0), a3, voffA);
            PG8_WAIT_V(8); PG8_WAIT_L(0); PG8_BAR; PG8_MMA(1, 0, At, B0); PG8_MMA(1, 1, At, B1); PG8_BAR; PG8_SCHED;
        }
        if (wr == 0) PG8_BAR;
        E(acc, cur, wr, wc, fr, fq);
        if (!has_next) break;
#pragma unroll
        for (int a = 0; a < 2; ++a)
#pragma unroll
            for (int b = 0; b < 2; ++b)
#pragma unroll
                for (int m = 0; m < 4; ++m)
#pragma unroll
                    for (int n = 0; n < 2; ++n) acc[a][b][m][n] = (f32x4){0.f, 0.f, 0.f, 0.f};
        cur = nxt; cA = nA; cB = nB; ++ui;
        if (wr == 1) PG8_BAR;
    }
    PG8_WAIT_V(0);
    PG8_BAR;
#undef PG8_SA
#undef PG8_SB
#undef PG8_STAGE
#undef PG8_LDA
#undef PG8_LDB
#undef PG8_MMA
#undef PG8_WAIT_V
#undef PG8_WAIT_L
#undef PG8_BAR
#undef PG8_SCHED
}
}
using pg8::Unit;
typedef f32x4 AccT[2][2][4][2];

struct EpiFFN {
    static constexpr bool PERM = true; bf16_t* H;
    DI void operator()(const AccT& acc, const Unit& u, int wr, int wc, int fr, int fq) const {
        const int col = u.pn * 128 + wc * 32 + fq * 8;
#pragma unroll
        for (int ai = 0; ai < 2; ++ai)
#pragma unroll
            for (int m = 0; m < 4; ++m) {
                const int row = u.pm * 256 + ai * 128 + wr * 64 + m * 16 + fr;
                float v[8];
#pragma unroll
                for (int n = 0; n < 2; ++n)
#pragma unroll
                    for (int e = 0; e < 4; ++e) { const float gt = acc[ai][0][m][n][e], up = acc[ai][1][m][n][e]; v[n * 4 + e] = gt * sigm(gt) * up; }
                u32x4 w; w.x = pk2(v[0], v[1]); w.y = pk2(v[2], v[3]); w.z = pk2(v[4], v[5]); w.w = pk2(v[6], v[7]);
                *(u32x4*)(H + (size_t)row * DFF + col) = w;
            }
    }
};
struct EpiBf {
    static constexpr bool PERM = true; bf16_t* O;
    DI void operator()(const AccT& acc, const Unit& u, int wr, int wc, int fr, int fq) const {
#pragma unroll
        for (int ai = 0; ai < 2; ++ai)
#pragma unroll
            for (int m = 0; m < 4; ++m) {
                const int row = u.pm * 256 + ai * 128 + wr * 64 + m * 16 + fr;
#pragma unroll
                for (int bj = 0; bj < 2; ++bj) { const f32x4 v0 = acc[ai][bj][m][0], v1 = acc[ai][bj][m][1];
                    u32x4 w; w.x = pk2(v0[0], v0[1]); w.y = pk2(v0[2], v0[3]); w.z = pk2(v1[0], v1[1]); w.w = pk2(v1[2], v1[3]);
                    *(u32x4*)(O + (size_t)row * DM + u.pn * 256 + bj * 128 + wc * 32 + fq * 8) = w; }
            }
    }
};
struct EpiPart {
    static constexpr bool PERM = false; float* P;
    DI void operator()(const AccT& acc, const Unit& u, int wr, int wc, int fr, int fq) const {
        const int src = u.pn & 1, ks = u.pn >> 1;
        float* base = P + ((size_t)(ks * 2 + src) * 4096) * 128;
#pragma unroll
        for (int ai = 0; ai < 2; ++ai)
#pragma unroll
            for (int m = 0; m < 4; ++m) {
                const int row = u.pm * 256 + ai * 128 + wr * 64 + m * 16 + fr;
#pragma unroll
                for (int n = 0; n < 2; ++n) { const f32x4 v = src ? acc[ai][1][m][n] : acc[ai][0][m][n]; *(f32x4*)(base + (size_t)row * 128 + wc * 32 + n * 16 + fq * 4) = v; }
            }
    }
};
struct EpiVT {
    static constexpr bool PERM = true; bf16_t* VT0; bf16_t* VT1;
    DI void operator()(const AccT& acc, const Unit& u, int wr, int wc, int fr, int fq) const {
#pragma unroll
        for (int ai = 0; ai < 2; ++ai)
#pragma unroll
            for (int m = 0; m < 4; ++m) {
                const int r = u.pm * 256 + ai * 128 + wr * 64 + m * 16 + fr;
                const int piece = r >> 9, gg = (r >> 7) & 3, d = r & 127;
                bf16_t* base = piece ? VT1 : VT0;
#pragma unroll
                for (int bj = 0; bj < 2; ++bj) {
                    const int t = u.pn * 256 + bj * 128 + wc * 32 + fq * 8, b = t >> 11, s = t & 2047;
                    const f32x4 v0 = acc[ai][bj][m][0], v1 = acc[ai][bj][m][1];
                    u32x4 w; w.x = pk2(v0[0], v0[1]); w.y = pk2(v0[2], v0[3]); w.z = pk2(v1[0], v1[1]); w.w = pk2(v1[2], v1[3]);
                    *(u32x4*)(base + ((size_t)((b * 4 + gg) * 128 + d)) * 2048 + s) = w;
                }
            }
    }
};
struct EpiGate {
    static constexpr bool PERM = true; const bf16_t* MG; const bf16_t* YAG; bf16_t* O; int mode;
    DI void operator()(const AccT& acc, const Unit& u, int wr, int wc, int fr, int fq) const {
#pragma unroll
        for (int ai = 0; ai < 2; ++ai)
#pragma unroll
            for (int m = 0; m < 4; ++m) {
                const int row = u.pm * 256 + ai * 128 + wr * 64 + m * 16 + fr;
#pragma unroll
                for (int bj = 0; bj < 2; ++bj) {
                    const int col = u.pn * 256 + bj * 128 + wc * 32 + fq * 8;
                    const u32x4 gw = *(const u32x4*)(MG + (size_t)row * 4096 + (mode ? 2048 : 0) + col);
                    const f32x4 v0 = acc[ai][bj][m][0], v1 = acc[ai][bj][m][1];
                    float o[8] = {v0[0] * bflo(gw.x), v0[1] * bfhi(gw.x), v0[2] * bflo(gw.y), v0[3] * bfhi(gw.y), v1[0] * bflo(gw.z), v1[1] * bfhi(gw.z), v1[2] * bflo(gw.w), v1[3] * bfhi(gw.w)};
                    if (mode) { const u32x4 yw = *(const u32x4*)(YAG + (size_t)row * DM + col);
                        o[0] += bflo(yw.x); o[1] += bfhi(yw.x); o[2] += bflo(yw.y); o[3] += bfhi(yw.y); o[4] += bflo(yw.z); o[5] += bfhi(yw.z); o[6] += bflo(yw.w); o[7] += bfhi(yw.w); }
                    u32x4 w; w.x = pk2(o[0], o[1]); w.y = pk2(o[2], o[3]); w.z = pk2(o[4], o[5]); w.w = pk2(o[6], o[7]);
                    *(u32x4*)(O + (size_t)row * DM + col) = w;
                }
            }
    }
};
struct EpiIn {
    static constexpr bool PERM = true; unsigned char* ws; const float* rope;
    DI void operator()(const AccT& acc, const Unit& u, int wr, int wc, int fr, int fq) const {
#pragma unroll
        for (int bj = 0; bj < 2; ++bj) {
            const int c0 = u.pn * 256 + bj * 128 + wc * 32;
            const int col = c0 + fq * 8;
#pragma unroll
            for (int ai = 0; ai < 2; ++ai)
#pragma unroll
                for (int m = 0; m < 4; ++m) {
                    const int row = u.pm * 256 + ai * 128 + wr * 64 + m * 16 + fr;
                    const int b = row >> 11, s = row & 2047;
                    float v[8];
#pragma unroll
                    for (int n = 0; n < 2; ++n)
#pragma unroll
                        for (int e = 0; e < 4; ++e) v[n * 4 + e] = acc[ai][bj][m][n][e];
                    bf16_t* dst = nullptr;
                    if (c0 < 2048) { dst = (bf16_t*)(ws + WS_XA) + ((size_t)((b * 16 + (col >> 7)) * 2048 + s)) * 128 + (col & 127); }
                    else if (c0 < 4096) {
#pragma unroll
                        for (int e = 0; e < 8; ++e) v[e] = gelu_t(v[e]);
                        { const int chn = col - 2048; dst = (bf16_t*)(ws + WS_GY) + ((size_t)((b * 32 + (chn >> 6)) * 2048 + s)) * 64 + (chn & 63); } }
                    else if (c0 < 8192) {
                        const bool isq = c0 < 6144;
                        const int pc = (c0 - 6144) >> 9;
                        if ((c0 & 127) == 0 && (isq || pc != 1)) {
                            const float* rp = rope + (size_t)s * 32 + 8 * (fq & 1);
                            const f32x4 cA = *(const f32x4*)(rp), cB = *(const f32x4*)(rp + 4), sA = *(const f32x4*)(rp + 16), sB = *(const f32x4*)(rp + 20);
                            const float cs[8] = {cA[0], cA[1], cA[2], cA[3], cB[0], cB[1], cB[2], cB[3]}, sn[8] = {sA[0], sA[1], sA[2], sA[3], sB[0], sB[1], sB[2], sB[3]};
#pragma unroll
                            for (int e = 0; e < 8; ++e) { const float mine = v[e], other = __shfl_xor(mine, 32); v[e] = (fq < 2) ? mine * cs[e] - other * sn[e] : mine * cs[e] + other * sn[e]; }
                        }
                        if (isq) dst = (bf16_t*)(ws + WS_Q) + (size_t)row * DM + (col - 4096);
                        else { const int gg = ((c0 - 6144) >> 7) & 3, d = col & 127; dst = (bf16_t*)(ws + WS_KC + (size_t)pc * 16 * MiB) + ((size_t)((b * 4 + gg) * 2048 + s)) * 128 + d; }
                    }
                    else if (c0 < 12288) {
#pragma unroll
                        for (int e = 0; e < 8; ++e) v[e] = sigm(v[e]);
                        dst = (bf16_t*)(ws + WS_MG) + (size_t)row * 4096 + (col - 8192); }
                    else {
                        const int cc = col - 12288;
                        if (cc < 48) { float* ng = (float*)(ws + WS_NG) + (size_t)row * 48 + cc;
                            *(f32x4*)ng = (f32x4){sigm(v[0]), sigm(v[1]), sigm(v[2]), sigm(v[3])}; *(f32x4*)(ng + 4) = (f32x4){sigm(v[4]), sigm(v[5]), sigm(v[6]), sigm(v[7])}; }
                    }
                    if (dst) { u32x4 w; w.x = pk2(v[0], v[1]); w.y = pk2(v[2], v[3]); w.z = pk2(v[4], v[5]); w.w = pk2(v[6], v[7]); *(u32x4*)dst = w; }
                }
        }
    }
};

struct ConvJob { int K, Nd; };
DI const float* conv_src(int job, int d, KArgs a, int& ld) {
    switch (job) {
    case 0: case 9: { const int pn = d >> 8, half = (d >> 7) & 1, j = d & 127; ld = DFF; const int base = job == 0 ? 6 : 30; return a->in[base + half] + 128 * pn + j; }
    case 1: ld = DM; return a->in[8] + d;
    case 10: ld = DM; return a->in[32] + d;
    case 2: { ld = INW; int col;
        if (d < 7680) col = d; else if (d < 8192) col = d + 512; else if (d < 12288) col = d - 8192 + 9264; else if (d < 12336) col = d - 12288 + 9216; else return nullptr;
        return a->in[11] + col; }
    case 3: ld = INW; return a->in[11] + (d < 512 ? 7680 + d : 8704 + (d - 512));
    case 4: ld = DM; return a->in[25] + d;
    case 5: ld = DM; return a->in[26] + d;
    case 6: ld = DM; return a->in[27] + d;
    case 7: ld = 128; return (d < 128) ? a->in[20] + d : a->in[23] + (d - 128);
    case 8: { const int h = d >> 8, half = (d >> 7) & 1, j = d & 127; ld = 128; return (half ? a->in[16] : a->in[14]) + h * 16384 + j; }
    default: ld = 128; return (d < 128) ? a->in[21] + d : a->in[24] + (d - 128);
    }
}
DI bf16_t* conv_dst(int job, unsigned char* ws) {
    switch (job) {
    case 0: case 9: return (bf16_t*)(ws + WS_WGU);
    case 1: case 10: return (bf16_t*)(ws + WS_WD);
    case 2: return (bf16_t*)(ws + WS_WIN);
    case 3: return (bf16_t*)(ws + WS_WV);
    case 4: return (bf16_t*)(ws + WS_WA);
    case 5: return (bf16_t*)(ws + WS_WB);
    case 6: return (bf16_t*)(ws + WS_WO);
    case 7: return (bf16_t*)(ws + WS_W1T);
    case 8: return (bf16_t*)(ws + WS_WRI);
    default: return (bf16_t*)(ws + WS_W2T);
    }
}
DI void conv_dims(int job, int& K, int& Nd) {
    switch (job) {
    case 0: case 9: K = DM; Nd = 11264; break;
    case 1: case 10: K = DFF; Nd = DM; break;
    case 2: K = DM; Nd = 12544; break;
    case 3: K = DM; Nd = 1024; break;
    case 4: case 5: case 6: K = DM; Nd = DM; break;
    case 7: K = 4096; Nd = 256; break;
    case 8: K = 128; Nd = 4096; break;
    default: K = 128; Nd = 256; break;
    }
}
DI void conv_item(int job, int item, KArgs a, LAS float* scr, int lane) {
    int K, Nd; conv_dims(job, K, Nd);
    const int nkb = K / 64, kb = item % nkb, nb = item / nkb, k0 = 64 * kb, n0 = 64 * nb;
    const int kk = lane >> 4, n4 = lane & 15;
    int ld; const float* src = conv_src(job, n0 + 4 * n4, a, ld);
    f32x4 v[16];
#pragma unroll
    for (int i = 0; i < 16; ++i) v[i] = src ? *(const f32x4*)(src + (size_t)(k0 + 4 * i + kk) * ld) : (f32x4){0.f, 0.f, 0.f, 0.f};
#pragma unroll
    for (int i = 0; i < 16; ++i) { LAS float* q = scr + (4 * i + kk) * 65 + 4 * n4; q[0] = v[i][0]; q[1] = v[i][1]; q[2] = v[i][2]; q[3] = v[i][3]; }
    LDS_WAIT();
    bf16_t* WT = conv_dst(job, a->ws);
    const int c = lane & 7, nn = lane >> 3;
#pragma unroll
    for (int j = 0; j < 8; ++j) { const int n = nn + 8 * j; const LAS float* q = scr + (8 * c) * 65 + n;
        u32x4 o; o.x = pk2(q[0 * 65], q[1 * 65]); o.y = pk2(q[2 * 65], q[3 * 65]); o.z = pk2(q[4 * 65], q[5 * 65]); o.w = pk2(q[6 * 65], q[7 * 65]);
        *(u32x4*)(WT + (size_t)(n0 + n) * K + k0 + 8 * c) = o; }
    LDS_WAIT();
}
DI void conv_jobs(int jlo, int jhi, KArgs a, LAS unsigned char* lds, int gw, int ngw, int wave, int lane) {
    LAS float* scr = (LAS float*)(lds + wave * 16640);
    for (int job = jlo; job < jhi; ++job) {
        int K, Nd; conv_dims(job, K, Nd);
        const int nit = (K / 64) * (Nd / 64);
        for (int it = gw; it < nit; it += ngw) conv_item(job, it, a, scr, lane);
    }
}
DI void conv_pair(int job, int itA, int itB, bool hasB, KArgs a, LAS float* scr, int lane) {
    int K, Nd; conv_dims(job, K, Nd);
    const int nkb = K / 64; const int kk = lane >> 4, n4 = lane & 15;
    const int k0A = 64 * (itA % nkb), n0A = 64 * (itA / nkb), k0B = 64 * (itB % nkb), n0B = 64 * (itB / nkb);
    int ldA, ldB; const float* srcA = conv_src(job, n0A + 4 * n4, a, ldA); const float* srcB = hasB ? conv_src(job, n0B + 4 * n4, a, ldB) : nullptr; if (!hasB) ldB = 0;
    f32x4 vA[16], vB[16];
#pragma unroll
    for (int i = 0; i < 16; ++i) vA[i] = srcA ? *(const f32x4*)(srcA + (size_t)(k0A + 4 * i + kk) * ldA) : (f32x4){0.f, 0.f, 0.f, 0.f};
#pragma unroll
    for (int i = 0; i < 16; ++i) vB[i] = srcB ? *(const f32x4*)(srcB + (size_t)(k0B + 4 * i + kk) * ldB) : (f32x4){0.f, 0.f, 0.f, 0.f};
    bf16_t* WT = conv_dst(job, a->ws);
    const int c = lane & 7, nn = lane >> 3;
#pragma unroll
    for (int half = 0; half < 2; ++half) {
        if (half && !hasB) break;
#pragma unroll
        for (int i = 0; i < 16; ++i) { const f32x4 t = half ? vB[i] : vA[i]; LAS float* q = scr + (4 * i + kk) * 65 + 4 * n4; q[0] = t[0]; q[1] = t[1]; q[2] = t[2]; q[3] = t[3]; }
        LDS_WAIT();
        const int n0 = half ? n0B : n0A, k0 = half ? k0B : k0A;
#pragma unroll
        for (int j = 0; j < 8; ++j) { const int n = nn + 8 * j; const LAS float* q = scr + (8 * c) * 65 + n;
            u32x4 o; o.x = pk2(q[0 * 65], q[1 * 65]); o.y = pk2(q[2 * 65], q[3 * 65]); o.z = pk2(q[4 * 65], q[5 * 65]); o.w = pk2(q[6 * 65], q[7 * 65]);
            *(u32x4*)(WT + (size_t)(n0 + n) * K + k0 + 8 * c) = o; }
        LDS_WAIT();
    }
}
DI void conv_jobs_w(int jlo, int jhi, KArgs a, LAS unsigned char* lds, int pair0, int npair, int npairs, int wave, int lane) {
    LAS float* scr = (LAS float*)(lds + wave * 16640);
    for (int job = jlo; job < jhi; ++job) {
        int K, Nd; conv_dims(job, K, Nd);
        const int nit = (K / 64) * (Nd / 64);
        for (int it0 = 0; it0 < nit; it0 += 2 * npairs)
            for (int sl = 0; sl < npair; ++sl) { const int it = it0 + 2 * (pair0 + sl); if (it < nit) conv_pair(job, it, it + 1, it + 1 < nit, a, scr, lane); }
    }
}

DI int rcol(int q, int lane) { return 512 * (q >> 1) + 8 * lane + 4 * (q & 1); }
DI void row_load(f32x4 (&v)[8], const float* p, int lane) {
#pragma unroll
    for (int q = 0; q < 8; ++q) v[q] = *(const f32x4*)(p + rcol(q, lane));
}
DI void row_load_bf16(f32x4 (&v)[8], const bf16_t* p, int lane) {
#pragma unroll
    for (int j = 0; j < 4; ++j) { const u32x4 w = *(const u32x4*)(p + 512 * j + 8 * lane);
        v[2 * j] = (f32x4){bflo(w.x), bfhi(w.x), bflo(w.y), bfhi(w.y)}; v[2 * j + 1] = (f32x4){bflo(w.z), bfhi(w.z), bflo(w.w), bfhi(w.w)}; }
}
DI float row_rstd(const f32x4 (&v)[8]) {
    float s = 0.f;
#pragma unroll
    for (int j = 0; j < 8; ++j) s += (v[j][0] * v[j][0] + v[j][1] * v[j][1]) + (v[j][2] * v[j][2] + v[j][3] * v[j][3]);
    return rsqrtf(wave_sum(s) * (1.f / DM) + EPS);
}
DI void row_modulate_store(const f32x4 (&v)[8], float rstd, const float* g, const float* sh, const float* sc, bf16_t* o, int lane) {
#pragma unroll
    for (int j = 0; j < 4; ++j) { f32x4 r[2];
#pragma unroll
        for (int e = 0; e < 2; ++e) { const int c = rcol(2 * j + e, lane); const f32x4 gg = *(const f32x4*)(g + c), s1 = *(const f32x4*)(sh + c), s2 = *(const f32x4*)(sc + c);
            r[e] = (v[2 * j + e] * rstd * gg) * (s2 + 1.f) + s1; }
        u32x4 w; w.x = pk2(r[0][0], r[0][1]); w.y = pk2(r[0][2], r[0][3]); w.z = pk2(r[1][0], r[1][1]); w.w = pk2(r[1][2], r[1][3]);
        *(u32x4*)(o + 512 * j + 8 * lane) = w; }
}
DI void row_residual(f32x4 (&v)[8], const bf16_t* f, const float* xres, const float* gate, const float* pg, float wgt, float* xo, int lane) {
    f32x4 fv[8]; row_load_bf16(fv, f, lane); const float rs = row_rstd(fv);
#pragma unroll
    for (int j = 0; j < 8; ++j) { const int c = rcol(j, lane); const f32x4 xr = *(const f32x4*)(xres + c), gt = *(const f32x4*)(gate + c), pp = *(const f32x4*)(pg + c);
        v[j] = xr + (gt * wgt) * (fv[j] * rs * pp); *(f32x4*)(xo + c) = v[j]; }
}

#define MFMA32(a, b, c) __builtin_amdgcn_mfma_f32_32x32x16_bf16((a), (b), (c), 0, 0, 0)
DI int crow(int r, int hi) { return (r & 3) + 8 * (r >> 2) + 4 * hi; }
constexpr int KPITCH = 272, VPITCH = 136, KVBUF = 17408;
constexpr int AL_K = 0, AL_V = 2 * KVBUF, AL_IMP4 = 4 * KVBUF, AL_IMPS = AL_IMP4 + 32768, AL_SEL = AL_IMPS + 8192;
constexpr float NEGB = -1e30f;
struct KVRegs { u32x4 k0, k1, v0, v1; };
DI void kv_load(KVRegs& R, const bf16_t* Kt, const bf16_t* Vt, int vpitch, int tid) {
    const int c = tid, c2 = tid + 512;
    R.k0 = *(const u32x4*)(Kt + (c >> 4) * 128 + (c & 15) * 8); R.k1 = *(const u32x4*)(Kt + (c2 >> 4) * 128 + (c2 & 15) * 8);
    R.v0 = *(const u32x4*)(Vt + (size_t)(c >> 3) * vpitch + (c & 7) * 8); R.v1 = *(const u32x4*)(Vt + (size_t)(c2 >> 3) * vpitch + (c2 & 7) * 8);
}
DI void kv_store(const KVRegs& R, LAS unsigned char* KB, LAS unsigned char* VB, int tid) {
    const int c = tid, c2 = tid + 512;
    *(LAS u32x4*)(KB + (c >> 4) * KPITCH + (c & 15) * 16) = R.k0; *(LAS u32x4*)(KB + (c2 >> 4) * KPITCH + (c2 & 15) * 16) = R.k1;
    LAS unsigned char* p = VB + (c >> 3) * VPITCH + (c & 7) * 16; *(LAS u32x2*)p = (u32x2){R.v0.x, R.v0.y}; *(LAS u32x2*)(p + 8) = (u32x2){R.v0.z, R.v0.w};
    p = VB + (c2 >> 3) * VPITCH + (c2 & 7) * 16; *(LAS u32x2*)p = (u32x2){R.v1.x, R.v1.y}; *(LAS u32x2*)(p + 8) = (u32x2){R.v1.z, R.v1.w};
}
DI void qk_tile(f32x16& p0, f32x16& p1, const LAS unsigned char* KB, const bf16x8 (&qr)[8], int r, int hi) {
#pragma unroll
    for (int i = 0; i < 16; ++i) { p0[i] = 0.f; p1[i] = 0.f; }
#pragma unroll
    for (int d0 = 0; d0 < 8; ++d0) {
        const bf16x8 a0 = *(const LAS bf16x8*)(KB + r * KPITCH + d0 * 32 + hi * 16), a1 = *(const LAS bf16x8*)(KB + (32 + r) * KPITCH + d0 * 32 + hi * 16);
        p0 = MFMA32(a0, qr[d0], p0); p1 = MFMA32(a1, qr[d0], p1);
    }
}
DI bf16x8 pack8(const f32x16& p, int s2) {
    u32x4 w; w.x = pk2(p[8 * s2], p[8 * s2 + 1]); w.y = pk2(p[8 * s2 + 2], p[8 * s2 + 3]); w.z = pk2(p[8 * s2 + 4], p[8 * s2 + 5]); w.w = pk2(p[8 * s2 + 6], p[8 * s2 + 7]);
    return __builtin_bit_cast(bf16x8, w);
}
DI void pv_tile(f32x16 (&o)[4], const LAS unsigned char* VB, const f32x16& p0, const f32x16& p1, int r, int hi) {
#pragma unroll
    for (int kb = 0; kb < 2; ++kb)
#pragma unroll
        for (int s2 = 0; s2 < 2; ++s2) {
            const bf16x8 pf = pack8(kb ? p1 : p0, s2);
#pragma unroll
            for (int db = 0; db < 4; ++db) {
                const LAS unsigned char* base = VB + (32 * db + r) * VPITCH + (32 * kb + 16 * s2 + 4 * hi) * 2;
                const s16x4 lo = *(const LAS s16x4*)base, hh = *(const LAS s16x4*)(base + 16);
                const bf16x8 af = __builtin_shufflevector(lo, hh, 0, 1, 2, 3, 4, 5, 6, 7);
                o[db] = MFMA32(af, pf, o[db]);
            }
        }
}
constexpr float SCL = 0.08838834764831845f * 1.4426950408889634f;

DI void flash_step(f32x16 (&o)[4], float& mrun, float& lrun, const LAS unsigned char* KB, const LAS unsigned char* VB, const bf16x8 (&qr)[8],
                   int r, int hi, int qpos, int key0, bool rowok, bool need_c, bool need_w) {
    f32x16 p0, p1; qk_tile(p0, p1, KB, qr, r, hi);
    float mnew, alpha, ls = 0.f;
    if (!need_c && !need_w) {
        float mt = fmaxf(p0[0], p1[0]);
#pragma unroll
        for (int i = 1; i < 16; ++i) mt = fmaxf(mt, fmaxf(p0[i], p1[i]));
        mt = rowok ? mt * SCL : NEGB;
        mt = fmaxf(mt, __shfl_xor(mt, 32));
        mnew = fmaxf(mrun, mt);
        alpha = __builtin_amdgcn_exp2f(mrun - mnew);
        const float nb = rowok ? -mnew : NEGB;
#pragma unroll
        for (int i = 0; i < 16; ++i) {
            p0[i] = __builtin_amdgcn_exp2f(__builtin_fmaf(p0[i], SCL, nb));
            p1[i] = __builtin_amdgcn_exp2f(__builtin_fmaf(p1[i], SCL, nb));
            ls += p0[i] + p1[i];
        }
    } else {
        float mt = NEGB;
#pragma unroll
        for (int i = 0; i < 16; ++i) {
            const int k0 = key0 + crow(i, hi), k1 = k0 + 32;
            bool v0 = rowok, v1 = rowok;
            if (need_c) { v0 = v0 && (k0 <= qpos); v1 = v1 && (k1 <= qpos); }
            if (need_w) { v0 = v0 && (k0 > qpos - 512); v1 = v1 && (k1 > qpos - 512); }
            p0[i] = v0 ? p0[i] * SCL : NEGB; p1[i] = v1 ? p1[i] * SCL : NEGB;
            mt = fmaxf(mt, fmaxf(p0[i], p1[i]));
        }
        mt = fmaxf(mt, __shfl_xor(mt, 32));
        mnew = fmaxf(mrun, mt);
        alpha = __builtin_amdgcn_exp2f(mrun - mnew);
#pragma unroll
        for (int i = 0; i < 16; ++i) {
            p0[i] = __builtin_amdgcn_exp2f(p0[i] - mnew);
            p1[i] = __builtin_amdgcn_exp2f(p1[i] - mnew);
            ls += p0[i] + p1[i];
        }
    }
    lrun = lrun * alpha + ls;
    if (__any(mnew > mrun)) {
#pragma unroll
        for (int db = 0; db < 4; ++db)
#pragma unroll
            for (int i = 0; i < 16; ++i) o[db][i] *= alpha;
    }
    mrun = mnew;
    pv_tile(o, VB, p0, p1, r, hi);
}

DI void nsa_unit(int bg, int qblk, unsigned char* ws, LAS unsigned char* lds) {
    const int tid = otid(), lane = tid & 63, r = lane & 31, hi = lane >> 5, wave = __builtin_amdgcn_readfirstlane(tid >> 6);
    const int b = bg >> 2, g = bg & 3, head = g * 4 + (wave >> 1), q0 = qblk * 64, qw0 = q0 + 32 * (wave & 1), qpos = qw0 + r;
    const size_t trow = (size_t)b * SEQ + qpos;
    const bf16_t* Qp = (const bf16_t*)(ws + WS_Q) + trow * DM + head * 128;
    bf16_t* Op = (bf16_t*)(ws + WS_XA) + trow * DM + head * 128;
    bf16x8 qr[8];
#pragma unroll
    for (int d0 = 0; d0 < 8; ++d0) qr[d0] = *(const bf16x8*)(Qp + d0 * 16 + hi * 8);
    const float* ngp = (const float*)(ws + WS_NG) + trow * 48 + head * 3;
    const float g0 = ngp[0], g1 = ngp[1], g2 = ngp[2];
    LAS unsigned char* KB0 = lds + AL_K; LAS unsigned char* VB0 = lds + AL_V;
    LAS float* IMP4 = (LAS float*)(lds + AL_IMP4); LAS float* IMPS = (LAS float*)(lds + AL_IMPS); LAS unsigned* SEL = (LAS unsigned*)(lds + AL_SEL);
    unsigned opk[4][8];
    KVRegs R;
    {
        const bf16_t* kc = (const bf16_t*)(ws + WS_KCC) + (size_t)bg * 128 * 128;
        const bf16_t* vct = (const bf16_t*)(ws + WS_VCT) + (size_t)bg * 128 * 128;
        kv_load(R, kc, vct, 128, tid); kv_store(R, KB0, VB0, tid);
        kv_load(R, kc + 64 * 128, vct + 64, 128, tid); kv_store(R, KB0 + KVBUF, VB0 + KVBUF, tid);
        if (tid < 65) SEL[tid] = 0u;
        __syncthreads();
        f32x16 pa0, pa1, pb0, pb1;
        qk_tile(pa0, pa1, KB0, qr, r, hi); qk_tile(pb0, pb1, KB0 + KVBUF, qr, r, hi);
        float mt = NEGB;
#pragma unroll
        for (int i = 0; i < 16; ++i) {
            const int n = crow(i, hi);
            pa0[i] = (16 * n + 31 <= qpos) ? pa0[i] * SCL : NEGB; pa1[i] = (16 * (n + 32) + 31 <= qpos) ? pa1[i] * SCL : NEGB;
            pb0[i] = (16 * (n + 64) + 31 <= qpos) ? pb0[i] * SCL : NEGB; pb1[i] = (16 * (n + 96) + 31 <= qpos) ? pb1[i] * SCL : NEGB;
            mt = fmaxf(fmaxf(mt, fmaxf(pa0[i], pa1[i])), fmaxf(pb0[i], pb1[i]));
        }
        mt = fmaxf(mt, __shfl_xor(mt, 32));
        float ls = 0.f;
#pragma unroll
        for (int i = 0; i < 16; ++i) {
            pa0[i] = (pa0[i] > -1e29f) ? __builtin_amdgcn_exp2f(pa0[i] - mt) : 0.f; pa1[i] = (pa1[i] > -1e29f) ? __builtin_amdgcn_exp2f(pa1[i] - mt) : 0.f;
            pb0[i] = (pb0[i] > -1e29f) ? __builtin_amdgcn_exp2f(pb0[i] - mt) : 0.f; pb1[i] = (pb1[i] > -1e29f) ? __builtin_amdgcn_exp2f(pb1[i] - mt) : 0.f;
            ls += (pa0[i] + pa1[i]) + (pb0[i] + pb1[i]);
        }
        ls += __shfl_xor(ls, 32);
        const float inv = ls > 0.f ? 1.f / ls : 0.f;
#pragma unroll
        for (int i = 0; i < 16; ++i) { pa0[i] *= inv; pa1[i] *= inv; pb0[i] *= inv; pb1[i] *= inv; }
        if (qblk >= 16) {
            LAS float* ip = IMP4 + ((wave >> 1) * 64 + 32 * (wave & 1) + r) * 32;
#define IMP_G(P, blk) _Pragma("unroll") for (int g4 = 0; g4 < 4; ++g4) ip[8 * (blk) + 2 * g4 + hi] = (P[4 * g4] + P[4 * g4 + 1]) + (P[4 * g4 + 2] + P[4 * g4 + 3]);
            IMP_G(pa0, 0) IMP_G(pa1, 1) IMP_G(pb0, 2) IMP_G(pb1, 3)
            LDS_WAIT();
#define IMP_L(P, blk) _Pragma("unroll") for (int g4 = 0; g4 < 4; ++g4) { const int j1 = 8 * (blk) + 2 * g4 + hi + 1; if (j1 < 32) ip[j1] += P[4 * g4 + 3]; }
            IMP_L(pa0, 0) IMP_L(pa1, 1) IMP_L(pb0, 2) IMP_L(pb1, 3)
#undef IMP_G
#undef IMP_L
        }
        f32x16 oc[4];
#pragma unroll
        for (int db = 0; db < 4; ++db)
#pragma unroll
            for (int i = 0; i < 16; ++i) oc[db][i] = 0.f;
        pv_tile(oc, VB0, pa0, pa1, r, hi); pv_tile(oc, VB0 + KVBUF, pb0, pb1, r, hi);
#pragma unroll
        for (int db = 0; db < 4; ++db)
#pragma unroll
            for (int i = 0; i < 8; ++i) opk[db][i] = pk2(oc[db][2 * i] * g0, oc[db][2 * i + 1] * g0);
    }
    __syncthreads();
    if (qblk >= 16) {
#pragma unroll
        for (int e = 0; e < 4; ++e) { const int idx = tid + 512 * e; IMPS[idx] = (IMP4[idx] + IMP4[2048 + idx]) + (IMP4[4096 + idx] + IMP4[6144 + idx]); }
        __syncthreads();
        const int q = tid >> 3;
        float val[32];
#pragma unroll
        for (int j4 = 0; j4 < 8; ++j4) { const f32x4 t4 = *(const LAS f32x4*)(IMPS + q * 32 + 4 * j4); val[4 * j4] = t4[0]; val[4 * j4 + 1] = t4[1]; val[4 * j4 + 2] = t4[2]; val[4 * j4 + 3] = t4[3]; }
        unsigned bits = 0u;
#pragma unroll
        for (int e = 0; e < 4; ++e) {
            const int j = (tid & 7) * 4 + e;
            float vj = 0.f;
#pragma unroll
            for (int i = 0; i < 32; ++i) vj = (i == j) ? val[i] : vj;
            int rank = 0;
#pragma unroll
            for (int i = 1; i < 32; ++i) { const bool cand = (i <= qblk - 2); rank += (cand && (val[i] > vj || (val[i] == vj && i < j))) ? 1 : 0; }
            const bool forced = (j == 0) || (j == qblk) || (j == qblk - 1);
            const bool sel = forced || (j >= 1 && j <= qblk - 2 && rank < 13);
            bits |= sel ? (1u << j) : 0u;
        }
        __hip_atomic_fetch_or(SEL + q, bits, __ATOMIC_RELAXED, __HIP_MEMORY_SCOPE_WORKGROUP);
        __syncthreads();
    } else {
        if (tid < 64) SEL[tid] = (2u << qblk) - 1u;
        __syncthreads();
    }
    if (tid < 64) { unsigned v = SEL[tid];
#pragma unroll
        for (int o = 1; o < 64; o <<= 1) v |= __shfl_xor(v, o);
        if (tid == 0) SEL[64] = v; }
    __syncthreads();
    const unsigned mysel = SEL[32 * (wave & 1) + r];
    unsigned uni = (unsigned)__builtin_amdgcn_readfirstlane(SEL[64]) & ((2u << qblk) - 1u);
#pragma unroll 1
    for (int mode = 0; mode < 2; ++mode) {
        const bf16_t* Kg = (const bf16_t*)(ws + (mode ? WS_KW : WS_KS)) + (size_t)bg * SEQ * 128;
        const bf16_t* Vg = (const bf16_t*)(ws + (mode ? WS_VWT : WS_VST)) + (size_t)bg * 128 * SEQ;
        unsigned todo;
        if (mode) { const int jlo = qblk >= 8 ? qblk - 8 : 0; todo = ((2u << qblk) - 1u) & ~((1u << jlo) - 1u); } else todo = uni;
        f32x16 o[4];
#pragma unroll
        for (int db = 0; db < 4; ++db)
#pragma unroll
            for (int i = 0; i < 16; ++i) o[db][i] = 0.f;
        float mrun = -1e20f, lrun = 0.f;
        int cur = __builtin_ctz(todo); todo &= todo - 1u;
        kv_load(R, Kg + (size_t)cur * 64 * 128, Vg + cur * 64, SEQ, tid); kv_store(R, KB0, VB0, tid);
        int bi = 0;
        for (;;) {
            __syncthreads();
            const int nxt = todo ? __builtin_ctz(todo) : -1; todo &= todo - 1u;
            if (nxt >= 0) kv_load(R, Kg + (size_t)nxt * 64 * 128, Vg + nxt * 64, SEQ, tid);
            const int key0 = cur * 64;
            const bool rowok = mode ? true : (((mysel >> cur) & 1u) != 0u);
            const bool need_c = (key0 + 63 > qw0), need_w = mode && (key0 <= qw0 + 31 - 512);
            const bool wave_skip = mode ? (key0 + 63 <= qw0 - 512) : !__any(rowok);
            if (!wave_skip) flash_step(o, mrun, lrun, KB0 + bi * KVBUF, VB0 + bi * KVBUF, qr, r, hi, qpos, key0, rowok, need_c, need_w);
            if (nxt < 0) break;
            kv_store(R, KB0 + (bi ^ 1) * KVBUF, VB0 + (bi ^ 1) * KVBUF, tid);
            bi ^= 1; cur = nxt;
        }
        __syncthreads();
        lrun += __shfl_xor(lrun, 32);
        const float sc = (mode ? g2 : g1) / lrun;
#pragma unroll
        for (int db = 0; db < 4; ++db)
#pragma unroll
            for (int i = 0; i < 8; ++i) opk[db][i] = pk2(bflo(opk[db][i]) + o[db][2 * i] * sc, bfhi(opk[db][i]) + o[db][2 * i + 1] * sc);
    }
#pragma unroll
    for (int db = 0; db < 4; ++db)
#pragma unroll
        for (int g4 = 0; g4 < 4; ++g4) { u32x2 w; w.x = opk[db][2 * g4]; w.y = opk[db][2 * g4 + 1];
            *(u32x2*)(Op + 32 * db + 8 * g4 + 4 * hi) = w; }
}

#define NOINL __forceinline__
#define LDS_PTR() ((LAS unsigned char*)lds_raw)
extern __shared__ __attribute__((aligned(16))) unsigned char lds_raw[];

NOINL __device__ void ph_ffn_up(unsigned char* ws) {
    pg8::Gemm g{(const bf16_t*)(ws + WS_U), (const bf16_t*)(ws + WS_WGU), DM, DM, DM}; pg8::Sched S; S.init(64, 44, gridDim.x, blockIdx.x, 256L * DM * 2, 256L * DM * 2);
    EpiFFN E{(bf16_t*)(ws + WS_H)}; pg8::gemm_phase(LDS_PTR(), g, S, E);
}
NOINL __device__ void ph_ffn_down(unsigned char* ws) {
    pg8::Gemm g{(const bf16_t*)(ws + WS_H), (const bf16_t*)(ws + WS_WD), DFF, DFF, DFF}; pg8::Sched S; S.init(64, 8, gridDim.x, blockIdx.x, 256L * DFF * 2, 256L * DFF * 2);
    EpiBf E{(bf16_t*)(ws + WS_F)}; pg8::gemm_phase(LDS_PTR(), g, S, E);
}
NOINL __device__ void ph_inproj(unsigned char* ws) {
    pg8::Gemm g{(const bf16_t*)(ws + WS_U), (const bf16_t*)(ws + WS_WIN), DM, DM, DM}; pg8::Sched S; S.init(64, 49, gridDim.x, blockIdx.x, 256L * DM * 2, 256L * DM * 2);
    EpiIn E{ws, (const float*)(ws + WS_ROPE)}; pg8::gemm_phase(LDS_PTR(), g, S, E);
}
NOINL __device__ void ph_vt(unsigned char* ws) {
    pg8::Gemm g{(const bf16_t*)(ws + WS_WV), (const bf16_t*)(ws + WS_U), DM, DM, DM}; pg8::Sched S; S.init(4, 64, gridDim.x, blockIdx.x, 256L * DM * 2, 256L * DM * 2);
    EpiVT E{(bf16_t*)(ws + WS_VST), (bf16_t*)(ws + WS_VWT)}; pg8::gemm_phase(LDS_PTR(), g, S, E);
}
NOINL __device__ void ph_cmp1(unsigned char* ws) {
    pg8::Gemm g{(const bf16_t*)(ws + WS_KC), (const bf16_t*)(ws + WS_W1T), 2048, 4096, 512}; pg8::Sched S; S.init(16, 16, gridDim.x, blockIdx.x, 0, 0); S.mode = 1; S.srcstride = (long)(WS_VC - WS_KC);
    EpiPart E{(float*)(ws + WS_PART)}; pg8::gemm_phase(LDS_PTR(), g, S, E);
}
NOINL __device__ void ph_ya(unsigned char* ws) {
    pg8::Gemm g{(const bf16_t*)(ws + WS_HG), (const bf16_t*)(ws + WS_WA), DM, DM, DM}; pg8::Sched S; S.init(64, 8, gridDim.x, blockIdx.x, 256L * DM * 2, 256L * DM * 2);
    EpiGate E{(const bf16_t*)(ws + WS_MG), nullptr, (bf16_t*)(ws + WS_Q), 0}; pg8::gemm_phase(LDS_PTR(), g, S, E);
}
NOINL __device__ void ph_yb(unsigned char* ws) {
    pg8::Gemm g{(const bf16_t*)(ws + WS_XA), (const bf16_t*)(ws + WS_WB), DM, DM, DM}; pg8::Sched S; S.init(64, 8, gridDim.x, blockIdx.x, 256L * DM * 2, 256L * DM * 2);
    EpiGate E{(const bf16_t*)(ws + WS_MG), (const bf16_t*)(ws + WS_Q), (bf16_t*)(ws + WS_U), 1}; pg8::gemm_phase(LDS_PTR(), g, S, E);
}
NOINL __device__ void ph_out(unsigned char* ws) {
    pg8::Gemm g{(const bf16_t*)(ws + WS_U), (const bf16_t*)(ws + WS_WO), DM, DM, DM}; pg8::Sched S; S.init(64, 8, gridDim.x, blockIdx.x, 256L * DM * 2, 256L * DM * 2);
    EpiBf E{(bf16_t*)(ws + WS_FMIX)}; pg8::gemm_phase(LDS_PTR(), g, S, E);
}
NOINL __device__ void ph_cmp2(unsigned char* ws) {
    const int tid = otid(), lane = tid & 63, wave = __builtin_amdgcn_readfirstlane(tid >> 6), bx = blockIdx.x;
    if (wave >= 4 || bx >= 256) return;
    const int src = bx >> 7, rt = bx & 127;
    const int r = lane & 31, hh = lane >> 5;
    const float* P = (const float*)(ws + WS_PART); const float* peb = (const float*)(ws + WS_PEB) + src * 128;
    const bf16_t* w2t = (const bf16_t*)(ws + WS_W2T) + (size_t)src * 128 * 128;
    f32x16 acc;
#pragma unroll
    for (int i = 0; i < 16; ++i) acc[i] = 0.f;
#pragma unroll 1
    for (int st = 0; st < 8; ++st) {
        const int k0 = 16 * st + 8 * hh; float a[8];
#pragma unroll
        for (int e = 0; e < 8; ++e) a[e] = peb[k0 + e];
#pragma unroll
        for (int ks = 0; ks < 8; ++ks) { const float* pp = P + ((size_t)((ks * 2 + src) * 4096 + rt * 32 + r)) * 128 + k0;
            const f32x4 x0 = *(const f32x4*)pp, x1 = *(const f32x4*)(pp + 4); a[0] += x0[0]; a[1] += x0[1]; a[2] += x0[2]; a[3] += x0[3]; a[4] += x1[0]; a[5] += x1[1]; a[6] += x1[2]; a[7] += x1[3]; }
        u32x4 w; w.x = pk2(gelu_t(a[0]), gelu_t(a[1])); w.y = pk2(gelu_t(a[2]), gelu_t(a[3])); w.z = pk2(gelu_t(a[4]), gelu_t(a[5])); w.w = pk2(gelu_t(a[6]), gelu_t(a[7]));
        const bf16x8 af = __builtin_bit_cast(bf16x8, w);
        const bf16x8 bfr = *(const bf16x8*)(w2t + (size_t)(32 * wave + r) * 128 + k0);
        acc = MFMA32(af, bfr, acc);
    }
#pragma unroll
    for (int i = 0; i < 16; ++i) {
        const int R = rt * 32 + crow(i, hh), nrow = R & 127, bgi = R >> 7, d = 32 * wave + r;
        const float v = (nrow == 127) ? 0.f : acc[i];
        const bf16_t o = (bf16_t)(pk2(v, 0.f) & 0xffffu);
        if (src == 0) ((bf16_t*)(ws + WS_KCC))[(size_t)R * 128 + d] = o;
        else ((bf16_t*)(ws + WS_VCT))[((size_t)bgi * 128 + d) * 128 + nrow] = o;
    }
}
NOINL __device__ void ph_lru_gates(unsigned char* ws, const float* conv_w, const float* conv_b, const float* lbr, const float* lbi, const float* llam) {
    const int tid = otid(), lane = tid & 63, wave = __builtin_amdgcn_readfirstlane(tid >> 6), bx = blockIdx.x, G = gridDim.x;
    LAS unsigned char* lds = LDS_PTR();
    const int h = bx & 15, cuh = bx >> 4, nch = G >> 4;
    LAS unsigned char* WL = lds; LAS unsigned char* XS = lds + 69632 + wave * 8704; LAS float* CW = (LAS float*)(lds + 139264);
    const bf16_t* wri = (const bf16_t*)(ws + WS_WRI) + (size_t)h * 256 * 128;
#pragma unroll
    for (int e = 0; e < 8; ++e) { const int c = tid + 512 * e; *(LAS u32x4*)(WL + (c >> 4) * 272 + (c & 15) * 16) = *(const u32x4*)(wri + (c >> 4) * 128 + (c & 15) * 8); }
    if (tid < 128) { const int ch = h * 128 + tid;
        CW[tid] = conv_w[ch]; CW[128 + tid] = conv_w[DM + ch]; CW[256 + tid] = conv_w[2 * DM + ch]; CW[384 + tid] = conv_w[3 * DM + ch];
        CW[512 + tid] = conv_b[ch]; CW[640 + tid] = lbr[ch]; CW[768 + tid] = lbi[ch];
        const float lam = llam[ch], ex = __expf(-lam);
        CW[896 + tid] = (ex < 0.03f) ? ex * (1.f - ex * (0.5f - ex * (0.33333333f - ex * (0.25f - ex * 0.2f)))) : __logf(1.f + ex); }
    __syncthreads();
    const int r = lane & 31, hh = lane >> 5;
    const bf16_t* XA = (const bf16_t*)(ws + WS_XA); bf16_t* LA = (bf16_t*)(ws + WS_U); bf16_t* BBp = (bf16_t*)(ws + WS_BB);
#pragma unroll 1
    for (int rt = cuh * 8 + wave; rt < T / 32; rt += nch * 8) {
        const int t0 = rt * 32, tok = t0 + r, s = tok & 2047;
        bf16x8 af[8];
#pragma unroll
        for (int st = 0; st < 8; ++st) {
            const int ch0 = 16 * st + 8 * hh; float xc[8];
#pragma unroll
            for (int e = 0; e < 8; ++e) xc[e] = CW[512 + ch0 + e];
#pragma unroll
            for (int j = 0; j < 4; ++j) { if (s - 3 + j >= 0) { const u32x4 xv = *(const u32x4*)(XA + ((size_t)(((tok >> 11) * 16 + h) * 2048 + (s - 3 + j))) * 128 + ch0);
                xc[0] += CW[j * 128 + ch0 + 0] * bflo(xv.x); xc[1] += CW[j * 128 + ch0 + 1] * bfhi(xv.x); xc[2] += CW[j * 128 + ch0 + 2] * bflo(xv.y); xc[3] += CW[j * 128 + ch0 + 3] * bfhi(xv.y);
                xc[4] += CW[j * 128 + ch0 + 4] * bflo(xv.z); xc[5] += CW[j * 128 + ch0 + 5] * bfhi(xv.z); xc[6] += CW[j * 128 + ch0 + 6] * bflo(xv.w); xc[7] += CW[j * 128 + ch0 + 7] * bfhi(xv.w); } }
            u32x4 w; w.x = pk2(xc[0], xc[1]); w.y = pk2(xc[2], xc[3]); w.z = pk2(xc[4], xc[5]); w.w = pk2(xc[6], xc[7]);
            af[st] = __builtin_bit_cast(bf16x8, w);
            *(LAS u32x4*)(XS + r * 272 + ch0 * 2) = w;
            if (st & 1) asm volatile("" ::: "memory");
        }
        LDS_WAIT();
#pragma unroll 1
        for (int cb = 0; cb < 4; ++cb) {
            f32x16 aR, aI;
#pragma unroll
            for (int i = 0; i < 16; ++i) { aR[i] = 0.f; aI[i] = 0.f; }
#pragma unroll
            for (int st = 0; st < 8; ++st) {
                const bf16x8 bR = *(const LAS bf16x8*)(WL + (32 * cb + r) * 272 + st * 32 + hh * 16), bI = *(const LAS bf16x8*)(WL + (128 + 32 * cb + r) * 272 + st * 32 + hh * 16);
                aR = MFMA32(af[st], bR, aR); aI = MFMA32(af[st], bI, aI);
            }
            const int ch = 32 * cb + r; const float br_ = CW[640 + ch], bi_ = CW[768 + ch], sp_ = CW[896 + ch];
#pragma unroll
            for (int i = 0; i < 16; ++i) {
                const int tk = crow(i, hh);
                const float rr = sigm(aR[i] + br_), ig = sigm(aI[i] + bi_), la = -8.f * rr * sp_;
                const float xcv = bf2f(*(const LAS bf16_t*)(XS + tk * 272 + ch * 2));
                const float bm = sqrtf(fmaxf(1.f - __expf(2.f * la), 0.f)) * ig * xcv;
                const int tkn = t0 + tk;
                const size_t o = ((size_t)(((tkn >> 11) * 32 + h * 2 + (cb >> 1)) * 2048 + (tkn & 2047))) * 64 + (cb & 1) * 32 + r;
                LA[o] = (bf16_t)(pk2(la, 0.f) & 0xffffu); BBp[o] = (bf16_t)(pk2(bm, 0.f) & 0xffffu);
            }
        }
        LDS_WAIT();
    }
}
NOINL __device__ void ph_scan(unsigned char* ws) {
    const int tid = otid(), lane = tid & 63, wave = __builtin_amdgcn_readfirstlane(tid >> 6), bx = blockIdx.x, G = gridDim.x;
    LAS float* car = (LAS float*)LDS_PTR();
    const bf16_t* LA = (const bf16_t*)(ws + WS_U); const bf16_t* BBp = (const bf16_t*)(ws + WS_BB); const bf16_t* GY = (const bf16_t*)(ws + WS_GY); bf16_t* HG = (bf16_t*)(ws + WS_HG);
    for (int unit = bx; unit < 256; unit += G) {
        const int b = unit >> 5, ch = (unit & 31) * 64 + lane;
        const size_t bbase = (size_t)unit * 2048 * 64 + lane;
        float hcarry = 0.f;
#pragma unroll 1
        for (int rd = 0; rd < 8; ++rd) {
            const size_t base = ((size_t)b * SEQ + rd * 256 + wave * 32) * DM + ch;
            float la[32], bb[32], gy[32];
#pragma unroll
            for (int e = 0; e < 32; ++e) { const size_t o = bbase + (size_t)(rd * 256 + wave * 32 + e) * 64; la[e] = bf2f(LA[o]); bb[e] = bf2f(BBp[o]); gy[e] = bf2f(GY[o]); }
            float hst = 0.f;
#pragma unroll
            for (int e = 0; e < 32; ++e) { la[e] = __expf(la[e]); hst = la[e] * hst + bb[e]; }
            float aprod = 1.f;
#pragma unroll
            for (int e = 0; e < 32; ++e) aprod *= la[e];
            LAS float* cb = car + (rd & 1) * 1024;
            cb[(wave * 2) * 64 + lane] = aprod; cb[(wave * 2 + 1) * 64 + lane] = hst;
            __syncthreads();
            float hin = hcarry, myhin = 0.f;
#pragma unroll
            for (int w = 0; w < 8; ++w) { if (w == wave) myhin = hin; hin = cb[(w * 2) * 64 + lane] * hin + cb[(w * 2 + 1) * 64 + lane]; }
            hcarry = hin; hst = myhin;
#pragma unroll
            for (int e = 0; e < 32; ++e) { hst = la[e] * hst + bb[e]; HG[base + (size_t)e * DM] = (bf16_t)(pk2(hst * gy[e], 0.f) & 0xffffu); }
        }
        __syncthreads();
    }
}
NOINL __device__ void ph_nsa(unsigned char* ws) {
    const int bx = blockIdx.x, G = gridDim.x;
    const int vcu = (G % 8 == 0) ? (bx % 8) * (G / 8) + bx / 8 : bx;
#pragma unroll 1
    for (int uu = vcu; uu < 1024; uu += G) {
        const int pr = uu & 255, it = uu >> 8, bg = pr >> 3, s = pr & 7;
        const int qblk = (it == 0) ? s : (it == 1) ? 15 - s : (it == 2) ? 16 + s : 31 - s;
        nsa_unit(bg, qblk, ws, LDS_PTR());
    }
}

constexpr size_t WS_BAR = 960 * 1024;
constexpr int LDS_BARST = LDS_BYTES - 16;
#define XB_TMO      128
#define XB_XCNT(j)  (256  + 64 * (j))
#define XB_XSUB(j)  (1280 + 64 * (j))
#define XB_XGEN(j)  (2304 + 64 * (j))
#define XB_TOP      3328
#define XB_TOPGEN   3392
#define XCD_BAR_WORDS 3456
#define XB_SPIN_CAP (1u << 18)
DI unsigned xb_ld(unsigned* p)              { return __hip_atomic_load(p, __ATOMIC_RELAXED, __HIP_MEMORY_SCOPE_AGENT); }
DI unsigned xb_add(unsigned* p, unsigned v) { return __hip_atomic_fetch_add(p, v, __ATOMIC_RELAXED, __HIP_MEMORY_SCOPE_AGENT); }
DI unsigned xb_xcc_id() { return (unsigned)__builtin_amdgcn_s_getreg((3 << 11) | 20) & 0xFu; }
#define XB_SPIN(cond, bar) do { unsigned _sp = 0; while (cond) { __builtin_amdgcn_s_sleep(1); \
    if ((++_sp & 255u) == 0u) { if (xb_ld(&(bar)[XB_TMO])) break; if (_sp > XB_SPIN_CAP) { atomicAdd(&(bar)[XB_TMO], 1u); break; } } } } while (0)
DI void xcd_barrier_complete(unsigned* bar, unsigned x, unsigned& nloc, unsigned& nx) {
    const unsigned G = gridDim.x * gridDim.y * gridDim.z;
    unsigned sum, cnt, mine, sp = 0u;
    for (;;) {
        sum = 0u; cnt = 0u; mine = 0u;
#pragma unroll
        for (unsigned j = 0; j < 16; ++j) { const unsigned c = xb_ld(&bar[XB_XCNT(j)]); sum += c; cnt += (c > 0u) ? 1u : 0u; mine = (j == x) ? c : mine; }
        if (sum == G) break;
        __builtin_amdgcn_s_sleep(1);
        if ((++sp & 255u) == 0u) { if (xb_ld(&bar[XB_TMO])) break; if (sp > XB_SPIN_CAP) { atomicAdd(&bar[XB_TMO], 1u); break; } }
    }
    nloc = mine > 0u ? mine : 1u; nx = cnt > 0u ? cnt : 1u;
}
DI void xcd_barrier(unsigned* bar) {
    asm volatile("s_waitcnt vmcnt(0)" ::: "memory");
    __syncthreads();
    if (threadIdx.x == 0) {
        volatile LAS unsigned* st = (volatile LAS unsigned*)(LDS_PTR() + LDS_BARST);
        const unsigned x = xb_xcc_id();
        __builtin_amdgcn_s_waitcnt(0);
        unsigned nloc = st[0], nx = st[1];
        if (nloc == 0u) { xcd_barrier_complete(bar, x, nloc, nx); st[0] = nloc; st[1] = nx; }
        const unsigned old = xb_add(&bar[XB_XSUB(x)], 1u);
        const unsigned gen = old / nloc;
        if (old + 1u == (gen + 1u) * nloc) {
            __builtin_amdgcn_fence(__ATOMIC_RELEASE, "agent");
            asm volatile("s_waitcnt vmcnt(0)" ::: "memory");
            const unsigned og = xb_add(&bar[XB_TOP], 1u);
            const unsigned tg = og / nx;
            if (og + 1u == (tg + 1u) * nx) xb_add(&bar[XB_TOPGEN], 1u);
            else XB_SPIN(xb_ld(&bar[XB_TOPGEN]) == tg, bar);
            __builtin_amdgcn_fence(__ATOMIC_ACQUIRE, "agent");
            xb_add(&bar[XB_XGEN(x)], 1u);
            asm volatile("s_waitcnt vmcnt(0)" ::: "memory");
        } else {
            XB_SPIN(xb_ld(&bar[XB_XGEN(x)]) == gen, bar);
            __builtin_amdgcn_fence(__ATOMIC_ACQUIRE, "agent");
            asm volatile("s_waitcnt vmcnt(0)" ::: "memory");
        }
    }
    __syncthreads();
}

DI KArgs oargs() { auto p = __builtin_amdgcn_kernarg_segment_ptr(); asm volatile("" : "+s"(p)); return (KArgs)p; }

DI void ph_prologue() {
    KArgs ka = oargs();
    LAS unsigned char* lds = LDS_PTR(); unsigned char* ws = ka->ws; float* mod = (float*)(ws + WS_MOD);
    const int tid = otid(), lane = tid & 63, wave = __builtin_amdgcn_readfirstlane(tid >> 6), G = gridDim.x, bx = blockIdx.x, gw = bx * NWV + wave, ngw = G * NWV;
#ifdef PROBE_ADA
    const unsigned long long tp0 = __builtin_amdgcn_s_memrealtime();
#endif
    if (bx < 72) {
        LAS float* cact = (LAS float*)lds;
        LAS float* red = (LAS float*)(lds + 65536);
        const float* c = ka->in[1]; const float* wada = ka->in[2]; const float* bada = ka->in[3];
        for (int i = tid; i < NB * DM; i += NTHR) { const float v = c[i]; cact[i] = v * sigm(v); }
        __syncthreads();
        const int col = bx * 256 + 4 * lane;
        f32x4 acc[8];
#pragma unroll
        for (int b = 0; b < 8; ++b) acc[b] = (f32x4){0.f, 0.f, 0.f, 0.f};
        const float* wp = wada + (size_t)(wave * 256) * (NADA * DM) + col;
#pragma unroll 1
        for (int k = 0; k < 256; k += 8) {
            f32x4 w[8];
#pragma unroll
            for (int e = 0; e < 8; ++e) w[e] = *(const f32x4*)(wp + (size_t)(k + e) * (NADA * DM));
#pragma unroll
            for (int e = 0; e < 8; ++e)
#pragma unroll
                for (int b = 0; b < 8; ++b) acc[b] += w[e] * cact[b * DM + wave * 256 + k + e];
        }
#pragma unroll
        for (int b = 0; b < 8; ++b) *(LAS f32x4*)(red + (wave * 8 + b) * 256 + 4 * lane) = acc[b];
        __syncthreads();
#pragma unroll
        for (int e = 0; e < 4; ++e) { const int idx = tid + 512 * e, b = idx >> 8, cc = idx & 255; float sum = bada[bx * 256 + cc];
#pragma unroll
            for (int w = 0; w < 8; ++w) sum += red[(w * 8 + b) * 256 + cc];
            mod[b * (NADA * DM) + bx * 256 + cc] = sum; }
        __syncthreads();
    }
#ifdef PROBE_ADA
    { const unsigned long long tp1 = __builtin_amdgcn_s_memrealtime(); while (__builtin_amdgcn_s_memrealtime() - tp1 < tp1 - tp0) __builtin_amdgcn_s_sleep(8); }
#endif
    {
        const int nada = (G > 72) ? 72 : 0, nslots = (G - nada) * NWV * 2 + nada * NWV;
        const int slot0 = (bx >= nada) ? ((bx - nada) * NWV + wave) * 2 : (G - nada) * NWV * 2 + bx * NWV + wave, nslot = (bx >= nada) ? 2 : 1;
        conv_jobs_w(0, 9, ka, lds, slot0, nslot, nslots, wave, lane);
        conv_jobs_w(11, 12, ka, lds, slot0, nslot, nslots, wave, lane);
    }
    {
        const int idx = bx * NTHR + tid;
        if (idx < SEQ * 16) { const int pos = idx >> 4, i = idx & 15;
            const float invf = __builtin_amdgcn_exp2f(-(float)i * 1.1832230356f); const float ang = (float)pos * invf;
            const float rev = ang * 0.15915494309189535f, fr = rev - floorf(rev);
            float* rp = (float*)(ws + WS_ROPE) + pos * 32; rp[i] = __builtin_amdgcn_cosf(fr); rp[16 + i] = __builtin_amdgcn_sinf(fr); }
    }
    if (bx >= G - 2) {
        const int src = bx - (G - 2); const float* pe = ka->in[src ? 22 : 19]; const float* w1 = ka->in[src ? 23 : 20];
        __syncthreads();
        LAS float* red = (LAS float*)lds;
        const int d = tid & 127, qt = tid >> 7; float s = 0.f;
        for (int k = qt * 1024; k < qt * 1024 + 1024; ++k) s += pe[k] * w1[(size_t)k * 128 + d];
        red[tid] = s; __syncthreads();
        if (tid < 128) ((float*)(ws + WS_PEB))[src * 128 + tid] = (red[tid] + red[128 + tid]) + (red[256 + tid] + red[384 + tid]);
    }
    __syncthreads();
}
DI void ph_rows(int which) {
    KArgs ka = oargs(); unsigned char* ws = ka->ws; float* out = ka->out; const float* mod = (const float*)(ws + WS_MOD);
    const int tid = otid(), lane = tid & 63, wave = __builtin_amdgcn_readfirstlane(tid >> 6), G = gridDim.x, bx = blockIdx.x, gw = bx * NWV + wave, ngw = G * NWV;
    if (which == 0) {
        const float* x = ka->in[0]; const float* g = ka->in[4];
        for (int row = gw; row < T; row += ngw) { const int b = row >> 11; f32x4 v[8]; row_load(v, x + (size_t)row * DM, lane); const float rs = row_rstd(v);
            row_modulate_store(v, rs, g, mod + b * (NADA * DM) + 0 * DM, mod + b * (NADA * DM) + 1 * DM, (bf16_t*)(ws + WS_U) + (size_t)row * DM, lane); }
    } else if (which == 1) {
        const float* x = ka->in[0]; const float* pg = ka->in[5]; const float* g = ka->in[9];
        for (int row = gw; row < T; row += ngw) { const int b = row >> 11; const float* mb = mod + b * (NADA * DM); f32x4 v[8];
            row_residual(v, (const bf16_t*)(ws + WS_F) + (size_t)row * DM, x + (size_t)row * DM, mb + 2 * DM, pg, 0.5f, out + (size_t)row * DM, lane);
            const float rs = row_rstd(v); row_modulate_store(v, rs, g, mb + 3 * DM, mb + 4 * DM, (bf16_t*)(ws + WS_U) + (size_t)row * DM, lane); }
    } else if (which == 2) {
        const float* pg = ka->in[10]; const float* g = ka->in[28];
        for (int row = gw; row < T; row += ngw) { const int b = row >> 11; const float* mb = mod + b * (NADA * DM); f32x4 v[8];
            row_residual(v, (const bf16_t*)(ws + WS_FMIX) + (size_t)row * DM, out + (size_t)row * DM, mb + 5 * DM, pg, 1.0f, out + (size_t)row * DM, lane);
            const float rs = row_rstd(v); row_modulate_store(v, rs, g, mb + 6 * DM, mb + 7 * DM, (bf16_t*)(ws + WS_U) + (size_t)row * DM, lane); }
        conv_jobs_w(9, 11, ka, LDS_PTR(), gw, 1, ngw, wave, lane);
    } else {
        const float* pg = ka->in[29];
        for (int row = gw; row < T; row += ngw) { const int b = row >> 11; const float* mb = mod + b * (NADA * DM); f32x4 v[8];
            row_residual(v, (const bf16_t*)(ws + WS_F) + (size_t)row * DM, out + (size_t)row * DM, mb + 8 * DM, pg, 0.5f, out + (size_t)row * DM, lane); }
    }
}

__global__ void __launch_bounds__(NTHR) fwd_kernel(Args args_unused) {
    cg::grid_group grid = cg::this_grid();
    {
        volatile LAS unsigned* st = (volatile LAS unsigned*)(LDS_PTR() + LDS_BARST);
        if (threadIdx.x < 2) st[threadIdx.x] = 0u;
        __syncthreads();
        if (threadIdx.x == 0) (void)xb_add((unsigned*)(oargs()->ws + WS_BAR) + XB_XCNT(xb_xcc_id()), 1u);
    }
#ifndef PH_MASK
#define PH_MASK 0xffff
#endif
#define WSP() (oargs()->ws)
#ifndef PROBE_DUP
#define PROBE_DUP 0
#endif
#define RUN(k, bit, body) if (oargs()->ph_lo <= (k) && (k) < oargs()->ph_hi) { for (int _rep = 0; _rep < 1 + (((PROBE_DUP) >> (bit)) & 1); ++_rep) if (((PH_MASK) >> (bit)) & 1) { body; } }
#define SEAMX(k) if (oargs()->ph_lo <= (k) && (k) + 1 < oargs()->ph_hi) { if ((k) == oargs()->ph_lo) grid.sync(); else xcd_barrier((unsigned*)(oargs()->ws + WS_BAR)); }
    RUN(0, 0, ph_prologue()) SEAMX(0)
    RUN(1, 1, ph_rows(0)) SEAMX(1)
    RUN(2, 2, ph_ffn_up(WSP())) SEAMX(2)
    RUN(3, 3, ph_ffn_down(WSP())) SEAMX(3)
    RUN(4, 4, ph_rows(1)) SEAMX(4)
    RUN(5, 5, ph_inproj(WSP()); ph_vt(WSP())) SEAMX(5)
    RUN(6, 6, ph_cmp1(WSP())) SEAMX(6)
    if (oargs()->ph_lo <= 7 && 7 < oargs()->ph_hi) { ph_cmp2(WSP()); __syncthreads(); KArgs ka = oargs(); ph_lru_gates(ka->ws, ka->in[12], ka->in[13], ka->in[15], ka->in[17], ka->in[18]); }
    SEAMX(7)
    RUN(8, 7, ph_scan(WSP())) RUN(8, 8, ph_nsa(WSP())) SEAMX(8)
    RUN(9, 9, ph_ya(WSP()))
    RUN(10, 10, ph_yb(WSP())) SEAMX(10)
    RUN(11, 11, ph_out(WSP())) SEAMX(11)
    RUN(12, 12, ph_rows(2)) SEAMX(12)
    RUN(13, 2, ph_ffn_up(WSP())) SEAMX(13)
    RUN(14, 3, ph_ffn_down(WSP())) SEAMX(14)
    RUN(15, 15, ph_rows(3))
}

extern "C" void kernel_launch(void* const* d_in, const int* in_sizes, int n_in, void* d_out, int out_size, void* d_ws, size_t ws_size, hipStream_t stream) {
    static int grid = 0;
    if (grid == 0) {
        if (n_in != 33 || out_size != T * DM || ws_size < WS_END) { fprintf(stderr, "kernel_launch: unexpected problem (n_in %d out %d ws %zu)\n", n_in, out_size, ws_size); grid = -1; return; }
        int dev = 0, cus = 0, per_cu = 0;
        hipGetDevice(&dev); hipDeviceGetAttribute(&cus, hipDeviceAttributeMultiprocessorCount, dev);
        if (hipFuncSetAttribute((const void*)fwd_kernel, hipFuncAttributeMaxDynamicSharedMemorySize, LDS_BYTES) != hipSuccess) { fprintf(stderr, "kernel_launch: hipFuncSetAttribute failed\n"); grid = -1; return; }
        if (hipOccupancyMaxActiveBlocksPerMultiprocessor(&per_cu, (const void*)fwd_kernel, NTHR, LDS_BYTES) != hipSuccess || per_cu < 1) { fprintf(stderr, "kernel_launch: occupancy query gives %d\n", per_cu); per_cu = 1; }
        (void)hipGetLastError();
        grid = cus;
    }
    if (grid < 0) return;
    if (hipMemsetAsync((char*)d_ws + WS_BAR, 0, 16384, stream) != hipSuccess) { fprintf(stderr, "kernel_launch: memset of the barrier words failed\n"); return; }
    Args a{};
    for (int i = 0; i < 33; ++i) a.in[i] = (const float*)d_in[i];
    a.out = (float*)d_out; a.ws = (unsigned char*)d_ws;
#if ONE_LAUNCH
    a.ph_lo = 0; a.ph_hi = 16;
    void* params[] = {&a};
    hipError_t e = hipLaunchCooperativeKernel((const void*)fwd_kernel, dim3(grid), dim3(NTHR), params, LDS_BYTES, stream);
    if (e != hipSuccess) fprintf(stderr, "cooperative launch failed: %s (grid %d)\n", hipGetErrorString(e), grid);
#else
    for (int p = 0; p < 16; ++p) { a.ph_lo = p; a.ph_hi = p + 1; hipLaunchKernelGGL(fwd_kernel, dim3(grid), dim3(NTHR), LDS_BYTES, stream, a); }
#endif
}
```

```cpp
#include <hip/hip_runtime.h>
#include <hip/hip_cooperative_groups.h>
#include <cstdio>
#include <cstdint>
namespace cg = cooperative_groups;


#ifndef ONE_LAUNCH
#define ONE_LAUNCH 1
#endif

#define LAS __attribute__((address_space(3)))
#define DI __device__ __forceinline__
typedef unsigned short bf16_t;
typedef short bf16x8 __attribute__((ext_vector_type(8)));
typedef short s16x4 __attribute__((ext_vector_type(4)));
typedef float f32x2 __attribute__((ext_vector_type(2)));
typedef float f32x4 __attribute__((ext_vector_type(4)));
typedef float f32x16 __attribute__((ext_vector_type(16)));
typedef unsigned u32x2 __attribute__((ext_vector_type(2)));
typedef unsigned u32x4 __attribute__((ext_vector_type(4)));
typedef __bf16 bf16x2_t __attribute__((ext_vector_type(2)));

constexpr int DM = 2048, NB = 8, SEQ = 2048, T = NB * SEQ, DFF = 5632, NADA = 9;
constexpr int INW = 13360;
constexpr int NTHR = 512, NWV = 8;
constexpr float EPS = 1e-6f;
constexpr size_t MiB = 1u << 20;
constexpr size_t WS_MOD = 0;
constexpr size_t WS_ROPE = 640 * 1024;
constexpr size_t WS_PEB = 900 * 1024;
constexpr size_t WS_W2T = 1 * MiB;
constexpr size_t WS_WGU = 2 * MiB, WS_WD = 46 * MiB;
constexpr size_t WS_BB = 2 * MiB;
constexpr size_t WS_WIN = 68 * MiB, WS_WV = 117 * MiB, WS_WA = 640 * MiB, WS_WB = 648 * MiB, WS_WO = 656 * MiB;
constexpr size_t WS_HG = 68 * MiB;
constexpr size_t WS_PART = 68 * MiB;
constexpr size_t WS_W1T = 145 * MiB, WS_WRI = 147 * MiB, WS_KCC = 152 * MiB, WS_VCT = 153 * MiB, WS_NG = 154 * MiB;
constexpr size_t WS_U = 160 * MiB;
constexpr size_t WS_H = 224 * MiB, WS_F = 400 * MiB;
constexpr size_t WS_XA = 224 * MiB, WS_GY = 288 * MiB, WS_Q = 352 * MiB, WS_KC = 416 * MiB, WS_VC = 432 * MiB, WS_KS = 448 * MiB, WS_KW = 464 * MiB;
constexpr size_t WS_VST = 480 * MiB, WS_VWT = 496 * MiB, WS_MG = 512 * MiB, WS_FMIX = 512 * MiB;
constexpr size_t WS_END = 664 * MiB;
constexpr int LDS_BYTES = 147456;

struct Args { const float* in[33]; float* out; unsigned char* ws; int ph_lo, ph_hi; };
typedef const Args __attribute__((address_space(4)))* KArgs;

DI unsigned pk2(float lo, float hi) { f32x2 v = {lo, hi}; bf16x2_t b = __builtin_convertvector(v, bf16x2_t); return __builtin_bit_cast(unsigned, b); }
DI float bf2f(bf16_t v) { return __uint_as_float((unsigned)v << 16); }
DI float bflo(unsigned w) { return __uint_as_float(w << 16); }
DI float bfhi(unsigned w) { return __uint_as_float(w & 0xffff0000u); }
DI float sigm(float x) { return 1.f / (1.f + __expf(-x)); }
DI float gelu_t(float x) { const float u = 0.7978845608028654f * (x + 0.044715f * x * x * x); return x / (1.f + __expf(-2.f * u)); }
DI float wave_sum(float v) {
#pragma unroll
    for (int o = 1; o < 64; o <<= 1) v += __shfl_xor(v, o);
    return v;
}
#define LDS_WAIT() asm volatile("s_waitcnt lgkmcnt(0)" ::: "memory")
DI int otid() { int t = threadIdx.x; asm volatile("" : "+v"(t)); return t; }

namespace pg8 {
constexpr int BM = 256, BK = 64, HALF = 128, HTB = HALF * BK * 2, STAGE_BYTES = 8 * HTB, NXCD = 8, WGM = 8;
DI int lds_byte(int r, int c) { const int st = (r >> 4) * 2 + (c >> 5), rr = r & 15, cc = c & 31, ob = rr * 64 + cc * 2; return st * 1024 + (ob ^ (((ob >> 9) & 1) << 5)); }
DI void stage_rc(int b, int& R, int& C) { const int st = b / 1024, sb = b % 1024, swz = sb ^ (((sb >> 9) & 1) << 5); R = (st >> 1) * 16 + swz / 64; C = (st & 1) * 32 + (swz % 64) / 2; }
DI int perm32(int rho) { const int n = rho >> 4, i = rho & 15; return 8 * (i >> 2) + 4 * n + (i & 3); }

struct Unit { int pm, pn; long aoff, boff; };
struct Gemm { const bf16_t* A; const bf16_t* Bt; int lda, ldb, K; };
struct Sched {
    int nM, nN, nwg, G, c, mode; long astep, bstep, srcstride;
    DI void init(int nM_, int nN_, int G_, int c_, long astep_, long bstep_) { nM = nM_; nN = nN_; nwg = nM * nN; G = G_; c = c_; mode = 0; astep = astep_; bstep = bstep_; srcstride = 0; }
    DI bool next(int i, Unit& u) const {
        const long L = (long)i * G + c; if (L >= nwg) return false;
        int wgid = (int)L;
        if (mode == 1) {
            const int pm = wgid & 15, ks = (wgid >> 4) & 7, src = wgid >> 7;
            u.pm = pm; u.pn = src + 2 * ks; u.aoff = (long)src * srcstride + (long)pm * 256 * 2048 * 2 + (long)ks * 1024; u.boff = (long)ks * 1024; return true;
        }
        { const int q = nwg / NXCD, r = nwg % NXCD, xcd = wgid % NXCD, off = wgid / NXCD; wgid = (xcd < r ? xcd * (q + 1) : r * (q + 1) + (xcd - r) * q) + off; }
        const int nig = WGM * nN, gid = wgid / nig, fm = gid * WGM, gsz = (nM - fm) < WGM ? (nM - fm) : WGM;
        u.pm = fm + ((wgid % nig) % gsz); u.pn = (wgid % nig) / gsz; u.aoff = (long)u.pm * astep; u.boff = (long)u.pn * bstep; return true;
    }
};

template <class Epi>
DI void gemm_phase(LAS unsigned char* lds, const Gemm g, const Sched& S, const Epi& E) {
    const int tid = otid(), wid = __builtin_amdgcn_readfirstlane(tid >> 6), lane = tid & 63, wr = wid >> 2, wc = wid & 3, fr = lane & 15, fq = lane >> 4;
    const int K = g.K, nt = K / BK;
    unsigned voffA[2], voffB[2];
#pragma unroll
    for (int i = 0; i < 2; ++i) { int R, C; stage_rc(tid * 16 + i * 8192, R, C); const int Rb = Epi::PERM ? ((R & ~31) + perm32(R & 31)) : R;
        voffA[i] = (unsigned)(R * g.lda + C) * 2u; voffB[i] = (unsigned)(Rb * g.ldb + C) * 2u; }
    const size_t kstep = (size_t)(BK * 2);
    const size_t hsA = (size_t)HALF * g.lda * 2, hsB = (size_t)HALF * g.ldb * 2;
    const unsigned ldsw = (unsigned)wid * 1024u;
    const int aoff = lds_byte(wr * 64 + fr, fq * 8), boff = lds_byte(wc * 32 + fr, fq * 8);
#define PG8_SA(b, h) (((b) * 2 + (h)) * HTB)
#define PG8_SB(b, h) ((4 + (b) * 2 + (h)) * HTB)
#define PG8_STAGE(bufoff, gbase, voff) do { _Pragma("unroll") for (int _i = 0; _i < 2; ++_i) \
        __builtin_amdgcn_global_load_lds((const unsigned*)((const char*)(gbase) + (voff)[_i]), (LAS unsigned*)(lds + (bufoff) + ldsw + _i * 8192), 16, 0, 0); } while (0)
#define PG8_LDA(dst, b, h) do { _Pragma("unroll") for (int m = 0; m < 4; ++m) _Pragma("unroll") for (int k = 0; k < 2; ++k) dst[m][k] = *(const LAS bf16x8*)(lds + PG8_SA(b, h) + aoff + m * 2048 + k * 1024); } while (0)
#define PG8_LDB(dst, b, h) do { _Pragma("unroll") for (int n = 0; n < 2; ++n) _Pragma("unroll") for (int k = 0; k < 2; ++k) dst[n][k] = *(const LAS bf16x8*)(lds + PG8_SB(b, h) + boff + n * 2048 + k * 1024); } while (0)
#define PG8_MMA(ai, bj, At, Bt) do { __builtin_amdgcn_s_setprio(1); _Pragma("unroll") for (int m = 0; m < 4; ++m) _Pragma("unroll") for (int n = 0; n < 2; ++n) _Pragma("unroll") for (int k = 0; k < 2; ++k) \
        acc[ai][bj][m][n] = __builtin_amdgcn_mfma_f32_16x16x32_bf16(Bt[n][k], At[m][k], acc[ai][bj][m][n], 0, 0, 0); __builtin_amdgcn_s_setprio(0); } while (0)
#define PG8_WAIT_V(n) asm volatile("s_waitcnt vmcnt(" #n ")" ::: "memory")
#define PG8_WAIT_L(n) asm volatile("s_waitcnt lgkmcnt(" #n ")" ::: "memory")
#define PG8_BAR __builtin_amdgcn_s_barrier()
#define PG8_SCHED __builtin_amdgcn_sched_barrier(0)
    Unit cur, nxt; int ui = 0;
    if (!S.next(0, cur)) return;
    f32x4 acc[2][2][4][2];
#pragma unroll
    for (int a = 0; a < 2; ++a)
#pragma unroll
        for (int b = 0; b < 2; ++b)
#pragma unroll
            for (int m = 0; m < 4; ++m)
#pragma unroll
                for (int n = 0; n < 2; ++n) acc[a][b][m][n] = (f32x4){0.f, 0.f, 0.f, 0.f};
    bf16x8 At[4][2], B0[2][2], B1[2][2];
    const char* cA = (const char*)g.A + cur.aoff; const char* cB = (const char*)g.Bt + cur.boff;
    PG8_STAGE(PG8_SB(0, 0), cB, voffB); PG8_STAGE(PG8_SB(0, 1), cB + hsB, voffB); PG8_STAGE(PG8_SA(0, 0), cA, voffA); PG8_STAGE(PG8_SA(0, 1), cA + hsA, voffA);
    if (wr == 1) PG8_BAR;
    PG8_WAIT_V(2); PG8_BAR;
    PG8_STAGE(PG8_SB(1, 0), cB + kstep, voffB); PG8_STAGE(PG8_SA(1, 0), cA + kstep, voffA); PG8_STAGE(PG8_SB(1, 1), cB + hsB + kstep, voffB);
    PG8_WAIT_V(6); PG8_BAR;
    for (;;) {
        const bool has_next = S.next(ui + 1, nxt);
        const char* nA = has_next ? (const char*)g.A + nxt.aoff : cA; const char* nB = has_next ? (const char*)g.Bt + nxt.boff : cB;
        for (int t = 0; t < nt; t += 2) {
            const bool last = (t == nt - 2);
            const char* a1 = cA + (size_t)(t + 1) * kstep;
            const char* a2 = last ? nA : cA + (size_t)(t + 2) * kstep; const char* b2 = last ? nB : cB + (size_t)(t + 2) * kstep;
            const char* a3 = a2 + kstep; const char* b3 = b2 + kstep;
            PG8_LDB(B0, 0, 0); PG8_LDB(B1, 0, 1); PG8_SCHED; PG8_LDA(At, 0, 0); PG8_STAGE(PG8_SA(1, 1), a1 + hsA, voffA);
            PG8_WAIT_V(8); PG8_WAIT_L(0); PG8_BAR; PG8_MMA(0, 0, At, B0); PG8_MMA(0, 1, At, B1); PG8_BAR; PG8_SCHED;
            PG8_LDA(At, 0, 1); PG8_STAGE(PG8_SB(0, 0), b2, voffB); PG8_STAGE(PG8_SB(0, 1), b2 + hsB, voffB); PG8_STAGE(PG8_SA(0, 0), a2, voffA);
            PG8_WAIT_V(8); PG8_WAIT_L(0); PG8_BAR; PG8_MMA(1, 0, At, B0); PG8_MMA(1, 1, At, B1); PG8_BAR; PG8_SCHED;
            PG8_LDB(B0, 1, 0); PG8_LDB(B1, 1, 1); PG8_SCHED; PG8_LDA(At, 1, 0); PG8_STAGE(PG8_SA(0, 1), a2 + hsA, voffA);
            PG8_WAIT_V(8); PG8_WAIT_L(0); PG8_BAR; PG8_MMA(0, 0, At, B0); PG8_MMA(0, 1, At, B1); PG8_BAR; PG8_SCHED;
            PG8_LDA(At, 1, 1); PG8_STAGE(PG8_SB(1, 0), b3, voffB); PG8_STAGE(PG8_SB(1, 1), b3 + hsB, voffB); PG8_STAGE(PG8_SA(1, 0), a3, voffA);
            PG8_WAIT_V(8); PG8_WAIT_L(0); PG8_BAR; PG8_MMA(1, 0, At, B0); PG8_MMA(1, 1, At, B1); PG8_BAR; PG8_SCHED;
        }
        if (wr == 0) PG8_BAR;
        E(acc, cur, wr, wc, fr, fq);
        if (!has_next) break;
#pragma unroll
        for (int a = 0; a < 2; ++a)
#pragma unroll
            for (int b = 0; b < 2; ++b)
#pragma unroll
                for (int m = 0; m < 4; ++m)
#pragma unroll
                    for (int n = 0; n < 2; ++n) acc[a][b][m][n] = (f32x4){0.f, 0.f, 0.f, 0.f};
        cur = nxt; cA = nA; cB = nB; ++ui;
        if (wr == 1) PG8_BAR;
    }
    PG8_WAIT_V(0);
    PG8_BAR;
#undef PG8_SA
#undef PG8_SB
#undef PG8_STAGE
#undef PG8_LDA
#undef PG8_LDB
#undef PG8_MMA
#undef PG8_WAIT_V
#undef PG8_WAIT_L
#undef PG8_BAR
#undef PG8_SCHED
}
}
using pg8::Unit;
typedef f32x4 AccT[2][2][4][2];

struct EpiFFN {
    static constexpr bool PERM = true; bf16_t* H;
    DI void operator()(const AccT& acc, const Unit& u, int wr, int wc, int fr, int fq) const {
        const int col = u.pn * 128 + wc * 32 + fq * 8;
#pragma unroll
        for (int ai = 0; ai < 2; ++ai)
#pragma unroll
            for (int m = 0; m < 4; ++m) {
                const int row = u.pm * 256 + ai * 128 + wr * 64 + m * 16 + fr;
                float v[8];
#pragma unroll
                for (int n = 0; n < 2; ++n)
#pragma unroll
                    for (int e = 0; e < 4; ++e) { const float gt = acc[ai][0][m][n][e], up = acc[ai][1][m][n][e]; v[n * 4 + e] = gt * sigm(gt) * up; }
                u32x4 w; w.x = pk2(v[0], v[1]); w.y = pk2(v[2], v[3]); w.z = pk2(v[4], v[5]); w.w = pk2(v[6], v[7]);
                *(u32x4*)(H + (size_t)row * DFF + col) = w;
            }
    }
};
struct EpiBf {
    static constexpr bool PERM = true; bf16_t* O;
    DI void operator()(const AccT& acc, const Unit& u, int wr, int wc, int fr, int fq) const {
#pragma unroll
        for (int ai = 0; ai < 2; ++ai)
#pragma unroll
            for (int m = 0; m < 4; ++m) {
                const int row = u.pm * 256 + ai * 128 + wr * 64 + m * 16 + fr;
#pragma unroll
                for (int bj = 0; bj < 2; ++bj) { const f32x4 v0 = acc[ai][bj][m][0], v1 = acc[ai][bj][m][1];
                    u32x4 w; w.x = pk2(v0[0], v0[1]); w.y = pk2(v0[2], v0[3]); w.z = pk2(v1[0], v1[1]); w.w = pk2(v1[2], v1[3]);
                    *(u32x4*)(O + (size_t)row * DM + u.pn * 256 + bj * 128 + wc * 32 + fq * 8) = w; }
            }
    }
};
struct EpiPart {
    static constexpr bool PERM = false; float* P;
    DI void operator()(const AccT& acc, const Unit& u, int wr, int wc, int fr, int fq) const {
        const int src = u.pn & 1, ks = u.pn >> 1;
        float* base = P + ((size_t)(ks * 2 + src) * 4096) * 128;
#pragma unroll
        for (int ai = 0; ai < 2; ++ai)
#pragma unroll
            for (int m = 0; m < 4; ++m) {
                const int row = u.pm * 256 + ai * 128 + wr * 64 + m * 16 + fr;
#pragma unroll
                for (int n = 0; n < 2; ++n) { const f32x4 v = src ? acc[ai][1][m][n] : acc[ai][0][m][n]; *(f32x4*)(base + (size_t)row * 128 + wc * 32 + n * 16 + fq * 4) = v; }
            }
    }
};
struct EpiVT {
    static constexpr bool PERM = true; bf16_t* VT0; bf16_t* VT1;
    DI void operator()(const AccT& acc, const Unit& u, int wr, int wc, int fr, int fq) const {
#pragma unroll
        for (int ai = 0; ai < 2; ++ai)
#pragma unroll
            for (int m = 0; m < 4; ++m) {
                const int r = u.pm * 256 + ai * 128 + wr * 64 + m * 16 + fr;
                const int piece = r >> 9, gg = (r >> 7) & 3, d = r & 127;
                bf16_t* base = piece ? VT1 : VT0;
#pragma unroll
                for (int bj = 0; bj < 2; ++bj) {
                    const int t = u.pn * 256 + bj * 128 + wc * 32 + fq * 8, b = t >> 11, s = t & 2047;
                    const f32x4 v0 = acc[ai][bj][m][0], v1 = acc[ai][bj][m][1];
                    u32x4 w; w.x = pk2(v0[0], v0[1]); w.y = pk2(v0[2], v0[3]); w.z = pk2(v1[0], v1[1]); w.w = pk2(v1[2], v1[3]);
                    *(u32x4*)(base + ((size_t)((b * 4 + gg) * 128 + d)) * 2048 + s) = w;
                }
            }
    }
};
struct EpiGate {
    static constexpr bool PERM = true; const bf16_t* MG; const bf16_t* YAG; bf16_t* O; int mode;
    DI void operator()(const AccT& acc, const Unit& u, int wr, int wc, int fr, int fq) const {
#pragma unroll
        for (int ai = 0; ai < 2; ++ai)
#pragma unroll
            for (int m = 0; m < 4; ++m) {
                const int row = u.pm * 256 + ai * 128 + wr * 64 + m * 16 + fr;
#pragma unroll
                for (int bj = 0; bj < 2; ++bj) {
                    const int col = u.pn * 256 + bj * 128 + wc * 32 + fq * 8;
                    const u32x4 gw = *(const u32x4*)(MG + (size_t)row * 4096 + (mode ? 2048 : 0) + col);
                    const f32x4 v0 = acc[ai][bj][m][0], v1 = acc[ai][bj][m][1];
                    float o[8] = {v0[0] * bflo(gw.x), v0[1] * bfhi(gw.x), v0[2] * bflo(gw.y), v0[3] * bfhi(gw.y), v1[0] * bflo(gw.z), v1[1] * bfhi(gw.z), v1[2] * bflo(gw.w), v1[3] * bfhi(gw.w)};
                    if (mode) { const u32x4 yw = *(const u32x4*)(YAG + (size_t)row * DM + col);
                        o[0] += bflo(yw.x); o[1] += bfhi(yw.x); o[2] += bflo(yw.y); o[3] += bfhi(yw.y); o[4] += bflo(yw.z); o[5] += bfhi(yw.z); o[6] += bflo(yw.w); o[7] += bfhi(yw.w); }
                    u32x4 w; w.x = pk2(o[0], o[1]); w.y = pk2(o[2], o[3]); w.z = pk2(o[4], o[5]); w.w = pk2(o[6], o[7]);
                    *(u32x4*)(O + (size_t)row * DM + col) = w;
                }
            }
    }
};
struct EpiIn {
    static constexpr bool PERM = true; unsigned char* ws; const float* rope;
    DI void operator()(const AccT& acc, const Unit& u, int wr, int wc, int fr, int fq) const {
#pragma unroll
        for (int bj = 0; bj < 2; ++bj) {
            const int c0 = u.pn * 256 + bj * 128 + wc * 32;
            const int col = c0 + fq * 8;
#pragma unroll
            for (int ai = 0; ai < 2; ++ai)
#pragma unroll
                for (int m = 0; m < 4; ++m) {
                    const int row = u.pm * 256 + ai * 128 + wr * 64 + m * 16 + fr;
                    const int b = row >> 11, s = row & 2047;
                    float v[8];
#pragma unroll
                    for (int n = 0; n < 2; ++n)
#pragma unroll
                        for (int e = 0; e < 4; ++e) v[n * 4 + e] = acc[ai][bj][m][n][e];
                    bf16_t* dst = nullptr;
                    if (c0 < 2048) { dst = (bf16_t*)(ws + WS_XA) + ((size_t)((b * 16 + (col >> 7)) * 2048 + s)) * 128 + (col & 127); }
                    else if (c0 < 4096) {
#pragma unroll
                        for (int e = 0; e < 8; ++e) v[e] = gelu_t(v[e]);
                        { const int chn = col - 2048; dst = (bf16_t*)(ws + WS_GY) + ((size_t)((b * 32 + (chn >> 6)) * 2048 + s)) * 64 + (chn & 63); } }
                    else if (c0 < 8192) {
                        const bool isq = c0 < 6144;
                        const int pc = (c0 - 6144) >> 9;
                        if ((c0 & 127) == 0 && (isq || pc != 1)) {
                            const float* rp = rope + (size_t)s * 32 + 8 * (fq & 1);
                            const f32x4 cA = *(const f32x4*)(rp), cB = *(const f32x4*)(rp + 4), sA = *(const f32x4*)(rp + 16), sB = *(const f32x4*)(rp + 20);
                            const float cs[8] = {cA[0], cA[1], cA[2], cA[3], cB[0], cB[1], cB[2], cB[3]}, sn[8] = {sA[0], sA[1], sA[2], sA[3], sB[0], sB[1], sB[2], sB[3]};
#pragma unroll
                            for (int e = 0; e < 8; ++e) { const float mine = v[e], other = __shfl_xor(mine, 32); v[e] = (fq < 2) ? mine * cs[e] - other * sn[e] : mine * cs[e] + other * sn[e]; }
                        }
                        if (isq) dst = (bf16_t*)(ws + WS_Q) + (size_t)row * DM + (col - 4096);
                        else { const int gg = ((c0 - 6144) >> 7) & 3, d = col & 127; dst = (bf16_t*)(ws + WS_KC + (size_t)pc * 16 * MiB) + ((size_t)((b * 4 + gg) * 2048 + s)) * 128 + d; }
                    }
                    else if (c0 < 12288) {
#pragma unroll
                        for (int e = 0; e < 8; ++e) v[e] = sigm(v[e]);
                        dst = (bf16_t*)(ws + WS_MG) + (size_t)row * 4096 + (col - 8192); }
                    else {
                        const int cc = col - 12288;
                        if (cc < 48) { float* ng = (float*)(ws + WS_NG) + (size_t)row * 48 + cc;
                            *(f32x4*)ng = (f32x4){sigm(v[0]), sigm(v[1]), sigm(v[2]), sigm(v[3])}; *(f32x4*)(ng + 4) = (f32x4){sigm(v[4]), sigm(v[5]), sigm(v[6]), sigm(v[7])}; }
                    }
                    if (dst) { u32x4 w; w.x = pk2(v[0], v[1]); w.y = pk2(v[2], v[3]); w.z = pk2(v[4], v[5]); w.w = pk2(v[6], v[7]); *(u32x4*)dst = w; }
                }
        }
    }
};

struct ConvJob { int K, Nd; };
DI const float* conv_src(int job, int d, KArgs a, int& ld) {
    switch (job) {
    case 0: case 9: { const int pn = d >> 8, half = (d >> 7) & 1, j = d & 127; ld = DFF; const int base = job == 0 ? 6 : 30; return a->in[base + half] + 128 * pn + j; }
    case 1: ld = DM; return a->in[8] + d;
    case 10: ld = DM; return a->in[32] + d;
    case 2: { ld = INW; int col;
        if (d < 7680) col = d; else if (d < 8192) col = d + 512; else if (d < 12288) col = d - 8192 + 9264; else if (d < 12336) col = d - 12288 + 9216; else return nullptr;
        return a->in[11] + col; }
    case 3: ld = INW; return a->in[11] + (d < 512 ? 7680 + d : 8704 + (d - 512));
    case 4: ld = DM; return a->in[25] + d;
    case 5: ld = DM; return a->in[26] + d;
    case 6: ld = DM; return a->in[27] + d;
    case 7: ld = 128; return (d < 128) ? a->in[20] + d : a->in[23] + (d - 128);
    case 8: { const int h = d >> 8, half = (d >> 7) & 1, j = d & 127; ld = 128; return (half ? a->in[16] : a->in[14]) + h * 16384 + j; }
    default: ld = 128; return (d < 128) ? a->in[21] + d : a->in[24] + (d - 128);
    }
}
DI bf16_t* conv_dst(int job, unsigned char* ws) {
    switch (job) {
    case 0: case 9: return (bf16_t*)(ws + WS_WGU);
    case 1: case 10: return (bf16_t*)(ws + WS_WD);
    case 2: return (bf16_t*)(ws + WS_WIN);
    case 3: return (bf16_t*)(ws + WS_WV);
    case 4: return (bf16_t*)(ws + WS_WA);
    case 5: return (bf16_t*)(ws + WS_WB);
    case 6: return (bf16_t*)(ws + WS_WO);
    case 7: return (bf16_t*)(ws + WS_W1T);
    case 8: return (bf16_t*)(ws + WS_WRI);
    default: return (bf16_t*)(ws + WS_W2T);
    }
}
DI void conv_dims(int job, int& K, int& Nd) {
    switch (job) {
    case 0: case 9: K = DM; Nd = 11264; break;
    case 1: case 10: K = DFF; Nd = DM; break;
    case 2: K = DM; Nd = 12544; break;
    case 3: K = DM; Nd = 1024; break;
    case 4: case 5: case 6: K = DM; Nd = DM; break;
    case 7: K = 4096; Nd = 256; break;
    case 8: K = 128; Nd = 4096; break;
    default: K = 128; Nd = 256; break;
    }
}
DI void conv_item(int job, int item, KArgs a, LAS float* scr, int lane) {
    int K, Nd; conv_dims(job, K, Nd);
    const int nkb = K / 64, kb = item % nkb, nb = item / nkb, k0 = 64 * kb, n0 = 64 * nb;
    const int kk = lane >> 4, n4 = lane & 15;
    int ld; const float* src = conv_src(job, n0 + 4 * n4, a, ld);
    f32x4 v[16];
#pragma unroll
    for (int i = 0; i < 16; ++i) v[i] = src ? *(const f32x4*)(src + (size_t)(k0 + 4 * i + kk) * ld) : (f32x4){0.f, 0.f, 0.f, 0.f};
#pragma unroll
    for (int i = 0; i < 16; ++i) { LAS float* q = scr + (4 * i + kk) * 65 + 4 * n4; q[0] = v[i][0]; q[1] = v[i][1]; q[2] = v[i][2]; q[3] = v[i][3]; }
    LDS_WAIT();
    bf16_t* WT = conv_dst(job, a->ws);
    const int c = lane & 7, nn = lane >> 3;
#pragma unroll
    for (int j = 0; j < 8; ++j) { const int n = nn + 8 * j; const LAS float* q = scr + (8 * c) * 65 + n;
        u32x4 o; o.x = pk2(q[0 * 65], q[1 * 65]); o.y = pk2(q[2 * 65], q[3 * 65]); o.z = pk2(q[4 * 65], q[5 * 65]); o.w = pk2(q[6 * 65], q[7 * 65]);
        *(u32x4*)(WT + (size_t)(n0 + n) * K + k0 + 8 * c) = o; }
    LDS_WAIT();
}
DI void conv_jobs(int jlo, int jhi, KArgs a, LAS unsigned char* lds, int gw, int ngw, int wave, int lane) {
    LAS float* scr = (LAS float*)(lds + wave * 16640);
    for (int job = jlo; job < jhi; ++job) {
        int K, Nd; conv_dims(job, K, Nd);
        const int nit = (K / 64) * (Nd / 64);
        for (int it = gw; it < nit; it += ngw) conv_item(job, it, a, scr, lane);
    }
}
DI void conv_pair(int job, int itA, int itB, bool hasB, KArgs a, LAS float* scr, int lane) {
    int K, Nd; conv_dims(job, K, Nd);
    const int nkb = K / 64; const int kk = lane >> 4, n4 = lane & 15;
    const int nblk = Nd / 64; (void)nkb;
    const int k0A = 64 * (itA / nblk), n0A = 64 * (itA % nblk), k0B = 64 * (itB / nblk), n0B = 64 * (itB % nblk);
    int ldA, ldB; const float* srcA = conv_src(job, n0A + 4 * n4, a, ldA); const float* srcB = hasB ? conv_src(job, n0B + 4 * n4, a, ldB) : nullptr; if (!hasB) ldB = 0;
    f32x4 vA[16], vB[16];
#pragma unroll
    for (int i = 0; i < 16; ++i) vA[i] = srcA ? *(const f32x4*)(srcA + (size_t)(k0A + 4 * i + kk) * ldA) : (f32x4){0.f, 0.f, 0.f, 0.f};
#pragma unroll
    for (int i = 0; i < 16; ++i) vB[i] = srcB ? *(const f32x4*)(srcB + (size_t)(k0B + 4 * i + kk) * ldB) : (f32x4){0.f, 0.f, 0.f, 0.f};
    bf16_t* WT = conv_dst(job, a->ws);
    const int c = lane & 7, nn = lane >> 3;
#pragma unroll
    for (int half = 0; half < 2; ++half) {
        if (half && !hasB) break;
#pragma unroll
        for (int i = 0; i < 16; ++i) { const f32x4 t = half ? vB[i] : vA[i]; LAS float* q = scr + (4 * i + kk) * 65 + 4 * n4; q[0] = t[0]; q[1] = t[1]; q[2] = t[2]; q[3] = t[3]; }
        LDS_WAIT();
        const int n0 = half ? n0B : n0A, k0 = half ? k0B : k0A;
#pragma unroll
        for (int j = 0; j < 8; ++j) { const int n = nn + 8 * j; const LAS float* q = scr + (8 * c) * 65 + n;
            u32x4 o; o.x = pk2(q[0 * 65], q[1 * 65]); o.y = pk2(q[2 * 65], q[3 * 65]); o.z = pk2(q[4 * 65], q[5 * 65]); o.w = pk2(q[6 * 65], q[7 * 65]);
            *(u32x4*)(WT + (size_t)(n0 + n) * K + k0 + 8 * c) = o; }
        LDS_WAIT();
    }
}
DI void conv_jobs_w(int jlo, int jhi, KArgs a, LAS unsigned char* lds, int pair0, int npair, int npairs, int wave, int lane) {
    LAS float* scr = (LAS float*)(lds + wave * 16640);
    for (int job = jlo; job < jhi; ++job) {
        int K, Nd; conv_dims(job, K, Nd);
        const int nit = (K / 64) * (Nd / 64);
        for (int it0 = 0; it0 < nit; it0 += 2 * npairs)
            for (int sl = 0; sl < npair; ++sl) { const int it = it0 + 2 * (pair0 + sl); if (it < nit) conv_pair(job, it, it + 1, it + 1 < nit, a, scr, lane); }
    }
}

DI int rcol(int q, int lane) { return 512 * (q >> 1) + 8 * lane + 4 * (q & 1); }
DI void row_load(f32x4 (&v)[8], const float* p, int lane) {
#pragma unroll
    for (int q = 0; q < 8; ++q) v[q] = *(const f32x4*)(p + rcol(q, lane));
}
DI void row_load_bf16(f32x4 (&v)[8], const bf16_t* p, int lane) {
#pragma unroll
    for (int j = 0; j < 4; ++j) { const u32x4 w = *(const u32x4*)(p + 512 * j + 8 * lane);
        v[2 * j] = (f32x4){bflo(w.x), bfhi(w.x), bflo(w.y), bfhi(w.y)}; v[2 * j + 1] = (f32x4){bflo(w.z), bfhi(w.z), bflo(w.w), bfhi(w.w)}; }
}
DI float row_rstd(const f32x4 (&v)[8]) {
    float s = 0.f;
#pragma unroll
    for (int j = 0; j < 8; ++j) s += (v[j][0] * v[j][0] + v[j][1] * v[j][1]) + (v[j][2] * v[j][2] + v[j][3] * v[j][3]);
    return rsqrtf(wave_sum(s) * (1.f / DM) + EPS);
}
DI void row_modulate_store(const f32x4 (&v)[8], float rstd, const float* g, const float* sh, const float* sc, bf16_t* o, int lane) {
#pragma unroll
    for (int j = 0; j < 4; ++j) { f32x4 r[2];
#pragma unroll
        for (int e = 0; e < 2; ++e) { const int c = rcol(2 * j + e, lane); const f32x4 gg = *(const f32x4*)(g + c), s1 = *(const f32x4*)(sh + c), s2 = *(const f32x4*)(sc + c);
            r[e] = (v[2 * j + e] * rstd * gg) * (s2 + 1.f) + s1; }
        u32x4 w; w.x = pk2(r[0][0], r[0][1]); w.y = pk2(r[0][2], r[0][3]); w.z = pk2(r[1][0], r[1][1]); w.w = pk2(r[1][2], r[1][3]);
        *(u32x4*)(o + 512 * j + 8 * lane) = w; }
}
DI void row_residual(f32x4 (&v)[8], const bf16_t* f, const float* xres, const float* gate, const float* pg, float wgt, float* xo, int lane) {
    f32x4 fv[8]; row_load_bf16(fv, f, lane); const float rs = row_rstd(fv);
#pragma unroll
    for (int j = 0; j < 8; ++j) { const int c = rcol(j, lane); const f32x4 xr = *(const f32x4*)(xres + c), gt = *(const f32x4*)(gate + c), pp = *(const f32x4*)(pg + c);
        v[j] = xr + (gt * wgt) * (fv[j] * rs * pp); *(f32x4*)(xo + c) = v[j]; }
}

#define MFMA32(a, b, c) __builtin_amdgcn_mfma_f32_32x32x16_bf16((a), (b), (c), 0, 0, 0)
DI int crow(int r, int hi) { return (r & 3) + 8 * (r >> 2) + 4 * hi; }
constexpr int KPITCH = 272, VPITCH = 136, KVBUF = 17408;
constexpr int AL_K = 0, AL_V = 2 * KVBUF, AL_IMP4 = 4 * KVBUF, AL_IMPS = AL_IMP4 + 32768, AL_SEL = AL_IMPS + 8192;
constexpr float NEGB = -1e30f;
struct KVRegs { u32x4 k0, k1, v0, v1; };
DI void kv_load(KVRegs& R, const bf16_t* Kt, const bf16_t* Vt, int vpitch, int tid) {
    const int c = tid, c2 = tid + 512;
    R.k0 = *(const u32x4*)(Kt + (c >> 4) * 128 + (c & 15) * 8); R.k1 = *(const u32x4*)(Kt + (c2 >> 4) * 128 + (c2 & 15) * 8);
    R.v0 = *(const u32x4*)(Vt + (size_t)(c >> 3) * vpitch + (c & 7) * 8); R.v1 = *(const u32x4*)(Vt + (size_t)(c2 >> 3) * vpitch + (c2 & 7) * 8);
}
DI void kv_store(const KVRegs& R, LAS unsigned char* KB, LAS unsigned char* VB, int tid) {
    const int c = tid, c2 = tid + 512;
    *(LAS u32x4*)(KB + (c >> 4) * KPITCH + (c & 15) * 16) = R.k0; *(LAS u32x4*)(KB + (c2 >> 4) * KPITCH + (c2 & 15) * 16) = R.k1;
    LAS unsigned char* p = VB + (c >> 3) * VPITCH + (c & 7) * 16; *(LAS u32x2*)p = (u32x2){R.v0.x, R.v0.y}; *(LAS u32x2*)(p + 8) = (u32x2){R.v0.z, R.v0.w};
    p = VB + (c2 >> 3) * VPITCH + (c2 & 7) * 16; *(LAS u32x2*)p = (u32x2){R.v1.x, R.v1.y}; *(LAS u32x2*)(p + 8) = (u32x2){R.v1.z, R.v1.w};
}
DI void qk_tile(f32x16& p0, f32x16& p1, const LAS unsigned char* KB, const bf16x8 (&qr)[8], int r, int hi) {
#pragma unroll
    for (int i = 0; i < 16; ++i) { p0[i] = 0.f; p1[i] = 0.f; }
#pragma unroll
    for (int d0 = 0; d0 < 8; ++d0) {
        const bf16x8 a0 = *(const LAS bf16x8*)(KB + r * KPITCH + d0 * 32 + hi * 16), a1 = *(const LAS bf16x8*)(KB + (32 + r) * KPITCH + d0 * 32 + hi * 16);
        p0 = MFMA32(a0, qr[d0], p0); p1 = MFMA32(a1, qr[d0], p1);
    }
}
DI bf16x8 pack8(const f32x16& p, int s2) {
    u32x4 w; w.x = pk2(p[8 * s2], p[8 * s2 + 1]); w.y = pk2(p[8 * s2 + 2], p[8 * s2 + 3]); w.z = pk2(p[8 * s2 + 4], p[8 * s2 + 5]); w.w = pk2(p[8 * s2 + 6], p[8 * s2 + 7]);
    return __builtin_bit_cast(bf16x8, w);
}
DI void pv_tile(f32x16 (&o)[4], const LAS unsigned char* VB, const f32x16& p0, const f32x16& p1, int r, int hi) {
#pragma unroll
    for (int kb = 0; kb < 2; ++kb)
#pragma unroll
        for (int s2 = 0; s2 < 2; ++s2) {
            const bf16x8 pf = pack8(kb ? p1 : p0, s2);
#pragma unroll
            for (int db = 0; db < 4; ++db) {
                const LAS unsigned char* base = VB + (32 * db + r) * VPITCH + (32 * kb + 16 * s2 + 4 * hi) * 2;
                const s16x4 lo = *(const LAS s16x4*)base, hh = *(const LAS s16x4*)(base + 16);
                const bf16x8 af = __builtin_shufflevector(lo, hh, 0, 1, 2, 3, 4, 5, 6, 7);
                o[db] = MFMA32(af, pf, o[db]);
            }
        }
}
constexpr float SCL = 0.08838834764831845f * 1.4426950408889634f;

DI void flash_step(f32x16 (&o)[4], float& mrun, float& lrun, const LAS unsigned char* KB, const LAS unsigned char* VB, const bf16x8 (&qr)[8],
                   int r, int hi, int qpos, int key0, bool rowok, bool need_c, bool need_w) {
    f32x16 p0, p1; qk_tile(p0, p1, KB, qr, r, hi);
    float mnew, alpha, ls = 0.f;
    if (!need_c && !need_w) {
        float mt = fmaxf(p0[0], p1[0]);
#pragma unroll
        for (int i = 1; i < 16; ++i) mt = fmaxf(mt, fmaxf(p0[i], p1[i]));
        mt = rowok ? mt * SCL : NEGB;
        mt = fmaxf(mt, __shfl_xor(mt, 32));
        mnew = fmaxf(mrun, mt);
        alpha = __builtin_amdgcn_exp2f(mrun - mnew);
        const float nb = rowok ? -mnew : NEGB;
#pragma unroll
        for (int i = 0; i < 16; ++i) {
            p0[i] = __builtin_amdgcn_exp2f(__builtin_fmaf(p0[i], SCL, nb));
            p1[i] = __builtin_amdgcn_exp2f(__builtin_fmaf(p1[i], SCL, nb));
            ls += p0[i] + p1[i];
        }
    } else {
        float mt = NEGB;
#pragma unroll
        for (int i = 0; i < 16; ++i) {
            const int k0 = key0 + crow(i, hi), k1 = k0 + 32;
            bool v0 = rowok, v1 = rowok;
            if (need_c) { v0 = v0 && (k0 <= qpos); v1 = v1 && (k1 <= qpos); }
            if (need_w) { v0 = v0 && (k0 > qpos - 512); v1 = v1 && (k1 > qpos - 512); }
            p0[i] = v0 ? p0[i] * SCL : NEGB; p1[i] = v1 ? p1[i] * SCL : NEGB;
            mt = fmaxf(mt, fmaxf(p0[i], p1[i]));
        }
        mt = fmaxf(mt, __shfl_xor(mt, 32));
        mnew = fmaxf(mrun, mt);
        alpha = __builtin_amdgcn_exp2f(mrun - mnew);
#pragma unroll
        for (int i = 0; i < 16; ++i) {
            p0[i] = __builtin_amdgcn_exp2f(p0[i] - mnew);
            p1[i] = __builtin_amdgcn_exp2f(p1[i] - mnew);
            ls += p0[i] + p1[i];
        }
    }
    lrun = lrun * alpha + ls;
    if (__any(mnew > mrun)) {
#pragma unroll
        for (int db = 0; db < 4; ++db)
#pragma unroll
            for (int i = 0; i < 16; ++i) o[db][i] *= alpha;
    }
    mrun = mnew;
    pv_tile(o, VB, p0, p1, r, hi);
}

DI void nsa_unit(int bg, int qblk, unsigned char* ws, LAS unsigned char* lds) {
    const int tid = otid(), lane = tid & 63, r = lane & 31, hi = lane >> 5, wave = __builtin_amdgcn_readfirstlane(tid >> 6);
    const int b = bg >> 2, g = bg & 3, head = g * 4 + (wave >> 1), q0 = qblk * 64, qw0 = q0 + 32 * (wave & 1), qpos = qw0 + r;
    const size_t trow = (size_t)b * SEQ + qpos;
    const bf16_t* Qp = (const bf16_t*)(ws + WS_Q) + trow * DM + head * 128;
    bf16_t* Op = (bf16_t*)(ws + WS_XA) + trow * DM + head * 128;
    bf16x8 qr[8];
#pragma unroll
    for (int d0 = 0; d0 < 8; ++d0) qr[d0] = *(const bf16x8*)(Qp + d0 * 16 + hi * 8);
    const float* ngp = (const float*)(ws + WS_NG) + trow * 48 + head * 3;
    const float g0 = ngp[0], g1 = ngp[1], g2 = ngp[2];
    LAS unsigned char* KB0 = lds + AL_K; LAS unsigned char* VB0 = lds + AL_V;
    LAS float* IMP4 = (LAS float*)(lds + AL_IMP4); LAS float* IMPS = (LAS float*)(lds + AL_IMPS); LAS unsigned* SEL = (LAS unsigned*)(lds + AL_SEL);
    unsigned opk[4][8];
    KVRegs R;
    {
        const bf16_t* kc = (const bf16_t*)(ws + WS_KCC) + (size_t)bg * 128 * 128;
        const bf16_t* vct = (const bf16_t*)(ws + WS_VCT) + (size_t)bg * 128 * 128;
        kv_load(R, kc, vct, 128, tid); kv_store(R, KB0, VB0, tid);
        kv_load(R, kc + 64 * 128, vct + 64, 128, tid); kv_store(R, KB0 + KVBUF, VB0 + KVBUF, tid);
        if (tid < 65) SEL[tid] = 0u;
        __syncthreads();
        f32x16 pa0, pa1, pb0, pb1;
        qk_tile(pa0, pa1, KB0, qr, r, hi); qk_tile(pb0, pb1, KB0 + KVBUF, qr, r, hi);
        float mt = NEGB;
#pragma unroll
        for (int i = 0; i < 16; ++i) {
            const int n = crow(i, hi);
            pa0[i] = (16 * n + 31 <= qpos) ? pa0[i] * SCL : NEGB; pa1[i] = (16 * (n + 32) + 31 <= qpos) ? pa1[i] * SCL : NEGB;
            pb0[i] = (16 * (n + 64) + 31 <= qpos) ? pb0[i] * SCL : NEGB; pb1[i] = (16 * (n + 96) + 31 <= qpos) ? pb1[i] * SCL : NEGB;
            mt = fmaxf(fmaxf(mt, fmaxf(pa0[i], pa1[i])), fmaxf(pb0[i], pb1[i]));
        }
        mt = fmaxf(mt, __shfl_xor(mt, 32));
        float ls = 0.f;
#pragma unroll
        for (int i = 0; i < 16; ++i) {
            pa0[i] = (pa0[i] > -1e29f) ? __builtin_amdgcn_exp2f(pa0[i] - mt) : 0.f; pa1[i] = (pa1[i] > -1e29f) ? __builtin_amdgcn_exp2f(pa1[i] - mt) : 0.f;
            pb0[i] = (pb0[i] > -1e29f) ? __builtin_amdgcn_exp2f(pb0[i] - mt) : 0.f; pb1[i] = (pb1[i] > -1e29f) ? __builtin_amdgcn_exp2f(pb1[i] - mt) : 0.f;
            ls += (pa0[i] + pa1[i]) + (pb0[i] + pb1[i]);
        }
        ls += __shfl_xor(ls, 32);
        const float inv = ls > 0.f ? 1.f / ls : 0.f;
#pragma unroll
        for (int i = 0; i < 16; ++i) { pa0[i] *= inv; pa1[i] *= inv; pb0[i] *= inv; pb1[i] *= inv; }
        if (qblk >= 16) {
            LAS float* ip = IMP4 + ((wave >> 1) * 64 + 32 * (wave & 1) + r) * 32;
#define IMP_G(P, blk) _Pragma("unroll") for (int g4 = 0; g4 < 4; ++g4) ip[8 * (blk) + 2 * g4 + hi] = (P[4 * g4] + P[4 * g4 + 1]) + (P[4 * g4 + 2] + P[4 * g4 + 3]);
            IMP_G(pa0, 0) IMP_G(pa1, 1) IMP_G(pb0, 2) IMP_G(pb1, 3)
            LDS_WAIT();
#define IMP_L(P, blk) _Pragma("unroll") for (int g4 = 0; g4 < 4; ++g4) { const int j1 = 8 * (blk) + 2 * g4 + hi + 1; if (j1 < 32) ip[j1] += P[4 * g4 + 3]; }
            IMP_L(pa0, 0) IMP_L(pa1, 1) IMP_L(pb0, 2) IMP_L(pb1, 3)
#undef IMP_G
#undef IMP_L
        }
        f32x16 oc[4];
#pragma unroll
        for (int db = 0; db < 4; ++db)
#pragma unroll
            for (int i = 0; i < 16; ++i) oc[db][i] = 0.f;
        pv_tile(oc, VB0, pa0, pa1, r, hi); pv_tile(oc, VB0 + KVBUF, pb0, pb1, r, hi);
#pragma unroll
        for (int db = 0; db < 4; ++db)
#pragma unroll
            for (int i = 0; i < 8; ++i) opk[db][i] = pk2(oc[db][2 * i] * g0, oc[db][2 * i + 1] * g0);
    }
    __syncthreads();
    if (qblk >= 16) {
#pragma unroll
        for (int e = 0; e < 4; ++e) { const int idx = tid + 512 * e; IMPS[idx] = (IMP4[idx] + IMP4[2048 + idx]) + (IMP4[4096 + idx] + IMP4[6144 + idx]); }
        __syncthreads();
        const int q = tid >> 3;
        float val[32];
#pragma unroll
        for (int j4 = 0; j4 < 8; ++j4) { const f32x4 t4 = *(const LAS f32x4*)(IMPS + q * 32 + 4 * j4); val[4 * j4] = t4[0]; val[4 * j4 + 1] = t4[1]; val[4 * j4 + 2] = t4[2]; val[4 * j4 + 3] = t4[3]; }
        unsigned bits = 0u;
#pragma unroll
        for (int e = 0; e < 4; ++e) {
            const int j = (tid & 7) * 4 + e;
            float vj = 0.f;
#pragma unroll
            for (int i = 0; i < 32; ++i) vj = (i == j) ? val[i] : vj;
            int rank = 0;
#pragma unroll
            for (int i = 1; i < 32; ++i) { const bool cand = (i <= qblk - 2); rank += (cand && (val[i] > vj || (val[i] == vj && i < j))) ? 1 : 0; }
            const bool forced = (j == 0) || (j == qblk) || (j == qblk - 1);
            const bool sel = forced || (j >= 1 && j <= qblk - 2 && rank < 13);
            bits |= sel ? (1u << j) : 0u;
        }
        __hip_atomic_fetch_or(SEL + q, bits, __ATOMIC_RELAXED, __HIP_MEMORY_SCOPE_WORKGROUP);
        __syncthreads();
    } else {
        if (tid < 64) SEL[tid] = (2u << qblk) - 1u;
        __syncthreads();
    }
    if (tid < 64) { unsigned v = SEL[tid];
#pragma unroll
        for (int o = 1; o < 64; o <<= 1) v |= __shfl_xor(v, o);
        if (tid == 0) SEL[64] = v; }
    __syncthreads();
    const unsigned mysel = SEL[32 * (wave & 1) + r];
    unsigned uni = (unsigned)__builtin_amdgcn_readfirstlane(SEL[64]) & ((2u << qblk) - 1u);
#pragma unroll 1
    for (int mode = 0; mode < 2; ++mode) {
        const bf16_t* Kg = (const bf16_t*)(ws + (mode ? WS_KW : WS_KS)) + (size_t)bg * SEQ * 128;
        const bf16_t* Vg = (const bf16_t*)(ws + (mode ? WS_VWT : WS_VST)) + (size_t)bg * 128 * SEQ;
        unsigned todo;
        if (mode) { const int jlo = qblk >= 8 ? qblk - 8 : 0; todo = ((2u << qblk) - 1u) & ~((1u << jlo) - 1u); } else todo = uni;
        f32x16 o[4];
#pragma unroll
        for (int db = 0; db < 4; ++db)
#pragma unroll
            for (int i = 0; i < 16; ++i) o[db][i] = 0.f;
        float mrun = -1e20f, lrun = 0.f;
        int cur = __builtin_ctz(todo); todo &= todo - 1u;
        kv_load(R, Kg + (size_t)cur * 64 * 128, Vg + cur * 64, SEQ, tid); kv_store(R, KB0, VB0, tid);
        int bi = 0;
        for (;;) {
            __syncthreads();
            const int nxt = todo ? __builtin_ctz(todo) : -1; todo &= todo - 1u;
            if (nxt >= 0) kv_load(R, Kg + (size_t)nxt * 64 * 128, Vg + nxt * 64, SEQ, tid);
            const int key0 = cur * 64;
            const bool rowok = mode ? true : (((mysel >> cur) & 1u) != 0u);
            const bool need_c = (key0 + 63 > qw0), need_w = mode && (key0 <= qw0 + 31 - 512);
            const bool wave_skip = mode ? (key0 + 63 <= qw0 - 512) : !__any(rowok);
            if (!wave_skip) flash_step(o, mrun, lrun, KB0 + bi * KVBUF, VB0 + bi * KVBUF, qr, r, hi, qpos, key0, rowok, need_c, need_w);
            if (nxt < 0) break;
            kv_store(R, KB0 + (bi ^ 1) * KVBUF, VB0 + (bi ^ 1) * KVBUF, tid);
            bi ^= 1; cur = nxt;
        }
        __syncthreads();
        lrun += __shfl_xor(lrun, 32);
        const float sc = (mode ? g2 : g1) / lrun;
#pragma unroll
        for (int db = 0; db < 4; ++db)
#pragma unroll
            for (int i = 0; i < 8; ++i) opk[db][i] = pk2(bflo(opk[db][i]) + o[db][2 * i] * sc, bfhi(opk[db][i]) + o[db][2 * i + 1] * sc);
    }
#pragma unroll
    for (int db = 0; db < 4; ++db)
#pragma unroll
        for (int g4 = 0; g4 < 4; ++g4) { u32x2 w; w.x = opk[db][2 * g4]; w.y = opk[db][2 * g4 + 1];
            *(u32x2*)(Op + 32 * db + 8 * g4 + 4 * hi) = w; }
}

#define NOINL __forceinline__
#define LDS_PTR() ((LAS unsigned char*)lds_raw)
extern __shared__ __attribute__((aligned(16))) unsigned char lds_raw[];

NOINL __device__ void ph_ffn_up(unsigned char* ws) {
    pg8::Gemm g{(const bf16_t*)(ws + WS_U), (const bf16_t*)(ws + WS_WGU), DM, DM, DM}; pg8::Sched S; S.init(64, 44, gridDim.x, blockIdx.x, 256L * DM * 2, 256L * DM * 2);
    EpiFFN E{(bf16_t*)(ws + WS_H)}; pg8::gemm_phase(LDS_PTR(), g, S, E);
}
NOINL __device__ void ph_ffn_down(unsigned char* ws) {
    pg8::Gemm g{(const bf16_t*)(ws + WS_H), (const bf16_t*)(ws + WS_WD), DFF, DFF, DFF}; pg8::Sched S; S.init(64, 8, gridDim.x, blockIdx.x, 256L * DFF * 2, 256L * DFF * 2);
    EpiBf E{(bf16_t*)(ws + WS_F)}; pg8::gemm_phase(LDS_PTR(), g, S, E);
}
NOINL __device__ void ph_inproj(unsigned char* ws) {
    pg8::Gemm g{(const bf16_t*)(ws + WS_U), (const bf16_t*)(ws + WS_WIN), DM, DM, DM}; pg8::Sched S; S.init(64, 49, gridDim.x, blockIdx.x, 256L * DM * 2, 256L * DM * 2);
    EpiIn E{ws, (const float*)(ws + WS_ROPE)}; pg8::gemm_phase(LDS_PTR(), g, S, E);
}
NOINL __device__ void ph_vt(unsigned char* ws) {
    pg8::Gemm g{(const bf16_t*)(ws + WS_WV), (const bf16_t*)(ws + WS_U), DM, DM, DM}; pg8::Sched S; S.init(4, 64, gridDim.x, blockIdx.x, 256L * DM * 2, 256L * DM * 2);
    EpiVT E{(bf16_t*)(ws + WS_VST), (bf16_t*)(ws + WS_VWT)}; pg8::gemm_phase(LDS_PTR(), g, S, E);
}
NOINL __device__ void ph_cmp1(unsigned char* ws) {
    pg8::Gemm g{(const bf16_t*)(ws + WS_KC), (const bf16_t*)(ws + WS_W1T), 2048, 4096, 512}; pg8::Sched S; S.init(16, 16, gridDim.x, blockIdx.x, 0, 0); S.mode = 1; S.srcstride = (long)(WS_VC - WS_KC);
    EpiPart E{(float*)(ws + WS_PART)}; pg8::gemm_phase(LDS_PTR(), g, S, E);
}
NOINL __device__ void ph_ya(unsigned char* ws) {
    pg8::Gemm g{(const bf16_t*)(ws + WS_HG), (const bf16_t*)(ws + WS_WA), DM, DM, DM}; pg8::Sched S; S.init(64, 8, gridDim.x, blockIdx.x, 256L * DM * 2, 256L * DM * 2);
    EpiGate E{(const bf16_t*)(ws + WS_MG), nullptr, (bf16_t*)(ws + WS_Q), 0}; pg8::gemm_phase(LDS_PTR(), g, S, E);
}
NOINL __device__ void ph_yb(unsigned char* ws) {
    pg8::Gemm g{(const bf16_t*)(ws + WS_XA), (const bf16_t*)(ws + WS_WB), DM, DM, DM}; pg8::Sched S; S.init(64, 8, gridDim.x, blockIdx.x, 256L * DM * 2, 256L * DM * 2);
    EpiGate E{(const bf16_t*)(ws + WS_MG), (const bf16_t*)(ws + WS_Q), (bf16_t*)(ws + WS_U), 1}; pg8::gemm_phase(LDS_PTR(), g, S, E);
}
NOINL __device__ void ph_out(unsigned char* ws) {
    pg8::Gemm g{(const bf16_t*)(ws + WS_U), (const bf16_t*)(ws + WS_WO), DM, DM, DM}; pg8::Sched S; S.init(64, 8, gridDim.x, blockIdx.x, 256L * DM * 2, 256L * DM * 2);
    EpiBf E{(bf16_t*)(ws + WS_FMIX)}; pg8::gemm_phase(LDS_PTR(), g, S, E);
}
NOINL __device__ void ph_cmp2(unsigned char* ws) {
    const int tid = otid(), lane = tid & 63, wave = __builtin_amdgcn_readfirstlane(tid >> 6), bx = blockIdx.x;
    if (wave >= 4 || bx >= 256) return;
    const int src = bx >> 7, rt = bx & 127;
    const int r = lane & 31, hh = lane >> 5;
    const float* P = (const float*)(ws + WS_PART); const float* peb = (const float*)(ws + WS_PEB) + src * 128;
    const bf16_t* w2t = (const bf16_t*)(ws + WS_W2T) + (size_t)src * 128 * 128;
    f32x16 acc;
#pragma unroll
    for (int i = 0; i < 16; ++i) acc[i] = 0.f;
#pragma unroll 1
    for (int st = 0; st < 8; ++st) {
        const int k0 = 16 * st + 8 * hh; float a[8];
#pragma unroll
        for (int e = 0; e < 8; ++e) a[e] = peb[k0 + e];
#pragma unroll
        for (int ks = 0; ks < 8; ++ks) { const float* pp = P + ((size_t)((ks * 2 + src) * 4096 + rt * 32 + r)) * 128 + k0;
            const f32x4 x0 = *(const f32x4*)pp, x1 = *(const f32x4*)(pp + 4); a[0] += x0[0]; a[1] += x0[1]; a[2] += x0[2]; a[3] += x0[3]; a[4] += x1[0]; a[5] += x1[1]; a[6] += x1[2]; a[7] += x1[3]; }
        u32x4 w; w.x = pk2(gelu_t(a[0]), gelu_t(a[1])); w.y = pk2(gelu_t(a[2]), gelu_t(a[3])); w.z = pk2(gelu_t(a[4]), gelu_t(a[5])); w.w = pk2(gelu_t(a[6]), gelu_t(a[7]));
        const bf16x8 af = __builtin_bit_cast(bf16x8, w);
        const bf16x8 bfr = *(const bf16x8*)(w2t + (size_t)(32 * wave + r) * 128 + k0);
        acc = MFMA32(af, bfr, acc);
    }
#pragma unroll
    for (int i = 0; i < 16; ++i) {
        const int R = rt * 32 + crow(i, hh), nrow = R & 127, bgi = R >> 7, d = 32 * wave + r;
        const float v = (nrow == 127) ? 0.f : acc[i];
        const bf16_t o = (bf16_t)(pk2(v, 0.f) & 0xffffu);
        if (src == 0) ((bf16_t*)(ws + WS_KCC))[(size_t)R * 128 + d] = o;
        else ((bf16_t*)(ws + WS_VCT))[((size_t)bgi * 128 + d) * 128 + nrow] = o;
    }
}
NOINL __device__ void ph_lru_gates(unsigned char* ws, const float* conv_w, const float* conv_b, const float* lbr, const float* lbi, const float* llam) {
    const int tid = otid(), lane = tid & 63, wave = __builtin_amdgcn_readfirstlane(tid >> 6), bx = blockIdx.x, G = gridDim.x;
    LAS unsigned char* lds = LDS_PTR();
    const int h = bx & 15, cuh = bx >> 4, nch = G >> 4;
    LAS unsigned char* WL = lds; LAS unsigned char* XS = lds + 69632 + wave * 8704; LAS float* CW = (LAS float*)(lds + 139264);
    const bf16_t* wri = (const bf16_t*)(ws + WS_WRI) + (size_t)h * 256 * 128;
#pragma unroll
    for (int e = 0; e < 8; ++e) { const int c = tid + 512 * e; *(LAS u32x4*)(WL + (c >> 4) * 272 + (c & 15) * 16) = *(const u32x4*)(wri + (c >> 4) * 128 + (c & 15) * 8); }
    if (tid < 128) { const int ch = h * 128 + tid;
        CW[tid] = conv_w[ch]; CW[128 + tid] = conv_w[DM + ch]; CW[256 + tid] = conv_w[2 * DM + ch]; CW[384 + tid] = conv_w[3 * DM + ch];
        CW[512 + tid] = conv_b[ch]; CW[640 + tid] = lbr[ch]; CW[768 + tid] = lbi[ch];
        const float lam = llam[ch], ex = __expf(-lam);
        CW[896 + tid] = (ex < 0.03f) ? ex * (1.f - ex * (0.5f - ex * (0.33333333f - ex * (0.25f - ex * 0.2f)))) : __logf(1.f + ex); }
    __syncthreads();
    const int r = lane & 31, hh = lane >> 5;
    const bf16_t* XA = (const bf16_t*)(ws + WS_XA); bf16_t* LA = (bf16_t*)(ws + WS_U); bf16_t* BBp = (bf16_t*)(ws + WS_BB);
#pragma unroll 1
    for (int rt = cuh * 8 + wave; rt < T / 32; rt += nch * 8) {
        const int t0 = rt * 32, tok = t0 + r, s = tok & 2047;
        bf16x8 af[8];
#pragma unroll
        for (int st = 0; st < 8; ++st) {
            const int ch0 = 16 * st + 8 * hh; float xc[8];
#pragma unroll
            for (int e = 0; e < 8; ++e) xc[e] = CW[512 + ch0 + e];
#pragma unroll
            for (int j = 0; j < 4; ++j) { if (s - 3 + j >= 0) { const u32x4 xv = *(const u32x4*)(XA + ((size_t)(((tok >> 11) * 16 + h) * 2048 + (s - 3 + j))) * 128 + ch0);
                xc[0] += CW[j * 128 + ch0 + 0] * bflo(xv.x); xc[1] += CW[j * 128 + ch0 + 1] * bfhi(xv.x); xc[2] += CW[j * 128 + ch0 + 2] * bflo(xv.y); xc[3] += CW[j * 128 + ch0 + 3] * bfhi(xv.y);
                xc[4] += CW[j * 128 + ch0 + 4] * bflo(xv.z); xc[5] += CW[j * 128 + ch0 + 5] * bfhi(xv.z); xc[6] += CW[j * 128 + ch0 + 6] * bflo(xv.w); xc[7] += CW[j * 128 + ch0 + 7] * bfhi(xv.w); } }
            u32x4 w; w.x = pk2(xc[0], xc[1]); w.y = pk2(xc[2], xc[3]); w.z = pk2(xc[4], xc[5]); w.w = pk2(xc[6], xc[7]);
            af[st] = __builtin_bit_cast(bf16x8, w);
            *(LAS u32x4*)(XS + r * 272 + ch0 * 2) = w;
            if (st & 1) asm volatile("" ::: "memory");
        }
        LDS_WAIT();
#pragma unroll 1
        for (int cb = 0; cb < 4; ++cb) {
            f32x16 aR, aI;
#pragma unroll
            for (int i = 0; i < 16; ++i) { aR[i] = 0.f; aI[i] = 0.f; }
#pragma unroll
            for (int st = 0; st < 8; ++st) {
                const bf16x8 bR = *(const LAS bf16x8*)(WL + (32 * cb + r) * 272 + st * 32 + hh * 16), bI = *(const LAS bf16x8*)(WL + (128 + 32 * cb + r) * 272 + st * 32 + hh * 16);
                aR = MFMA32(af[st], bR, aR); aI = MFMA32(af[st], bI, aI);
            }
            const int ch = 32 * cb + r; const float br_ = CW[640 + ch], bi_ = CW[768 + ch], sp_ = CW[896 + ch];
#pragma unroll
            for (int i = 0; i < 16; ++i) {
                const int tk = crow(i, hh);
                const float rr = sigm(aR[i] + br_), ig = sigm(aI[i] + bi_), la = -8.f * rr * sp_;
                const float xcv = bf2f(*(const LAS bf16_t*)(XS + tk * 272 + ch * 2));
                const float bm = sqrtf(fmaxf(1.f - __expf(2.f * la), 0.f)) * ig * xcv;
                const int tkn = t0 + tk;
                const size_t o = ((size_t)(((tkn >> 11) * 32 + h * 2 + (cb >> 1)) * 2048 + (tkn & 2047))) * 64 + (cb & 1) * 32 + r;
                LA[o] = (bf16_t)(pk2(la, 0.f) & 0xffffu); BBp[o] = (bf16_t)(pk2(bm, 0.f) & 0xffffu);
            }
        }
        LDS_WAIT();
    }
}
NOINL __device__ void ph_scan(unsigned char* ws) {
    const int tid = otid(), lane = tid & 63, wave = __builtin_amdgcn_readfirstlane(tid >> 6), bx = blockIdx.x, G = gridDim.x;
    LAS float* car = (LAS float*)LDS_PTR();
    const bf16_t* LA = (const bf16_t*)(ws + WS_U); const bf16_t* BBp = (const bf16_t*)(ws + WS_BB); const bf16_t* GY = (const bf16_t*)(ws + WS_GY); bf16_t* HG = (bf16_t*)(ws + WS_HG);
    for (int unit = bx; unit < 256; unit += G) {
        const int b = unit >> 5, ch = (unit & 31) * 64 + lane;
        const size_t bbase = (size_t)unit * 2048 * 64 + lane;
        float hcarry = 0.f;
#pragma unroll 1
        for (int rd = 0; rd < 8; ++rd) {
            const size_t base = ((size_t)b * SEQ + rd * 256 + wave * 32) * DM + ch;
            float la[32], bb[32], gy[32];
#pragma unroll
            for (int e = 0; e < 32; ++e) { const size_t o = bbase + (size_t)(rd * 256 + wave * 32 + e) * 64; la[e] = bf2f(LA[o]); bb[e] = bf2f(BBp[o]); gy[e] = bf2f(GY[o]); }
            float hst = 0.f;
#pragma unroll
            for (int e = 0; e < 32; ++e) { la[e] = __expf(la[e]); hst = la[e] * hst + bb[e]; }
            float aprod = 1.f;
#pragma unroll
            for (int e = 0; e < 32; ++e) aprod *= la[e];
            LAS float* cb = car + (rd & 1) * 1024;
            cb[(wave * 2) * 64 + lane] = aprod; cb[(wave * 2 + 1) * 64 + lane] = hst;
            __syncthreads();
            float hin = hcarry, myhin = 0.f;
#pragma unroll
            for (int w = 0; w < 8; ++w) { if (w == wave) myhin = hin; hin = cb[(w * 2) * 64 + lane] * hin + cb[(w * 2 + 1) * 64 + lane]; }
            hcarry = hin; hst = myhin;
#pragma unroll
            for (int e = 0; e < 32; ++e) { hst = la[e] * hst + bb[e]; HG[base + (size_t)e * DM] = (bf16_t)(pk2(hst * gy[e], 0.f) & 0xffffu); }
        }
        __syncthreads();
    }
}
NOINL __device__ void ph_lru_fused(unsigned char* ws, const float* conv_w, const float* conv_b, const float* lbr, const float* lbi, const float* llam) {
    const int tid = otid(), lane = tid & 63, wave = __builtin_amdgcn_readfirstlane(tid >> 6), bx = blockIdx.x, G = gridDim.x;
    LAS unsigned char* lds = LDS_PTR();
    LAS unsigned char* WL = lds; LAS float* CW = (LAS float*)(lds + 34816); LAS unsigned char* XS = lds + 38912 + wave * 8704; LAS float* car = (LAS float*)(lds + 108544);
    const int r = lane & 31, hh = lane >> 5;
    const bf16_t* XA = (const bf16_t*)(ws + WS_XA); const bf16_t* GY = (const bf16_t*)(ws + WS_GY); bf16_t* HG = (bf16_t*)(ws + WS_HG);
#pragma unroll 1
    for (int unit = bx; unit < 256; unit += G) {
        const int b = unit >> 5, cgp = unit & 31, h = cgp >> 1, hf = cgp & 1;
        __syncthreads();
        {
            const bf16_t* wri = (const bf16_t*)(ws + WS_WRI) + (size_t)h * 256 * 128;
#pragma unroll
            for (int e = 0; e < 4; ++e) { const int c = tid + 512 * e, row = c >> 4, srow = (row < 64) ? hf * 64 + row : 128 + hf * 64 + (row - 64);
                *(LAS u32x4*)(WL + row * 272 + (c & 15) * 16) = *(const u32x4*)(wri + srow * 128 + (c & 15) * 8); }
            if (tid < 128) { const int ch = h * 128 + tid; CW[tid] = conv_w[ch]; CW[128 + tid] = conv_w[DM + ch]; CW[256 + tid] = conv_w[2 * DM + ch]; CW[384 + tid] = conv_w[3 * DM + ch]; CW[512 + tid] = conv_b[ch]; }
            if (tid < 64) { const int ch = h * 128 + hf * 64 + tid; CW[640 + tid] = lbr[ch]; CW[704 + tid] = lbi[ch];
                const float lam = llam[ch], ex = __expf(-lam);
                CW[768 + tid] = (ex < 0.03f) ? ex * (1.f - ex * (0.5f - ex * (0.33333333f - ex * (0.25f - ex * 0.2f)))) : __logf(1.f + ex); }
        }
        __syncthreads();
        const bf16_t* XAb = XA + (size_t)(b * 16 + h) * 2048 * 128;
        const bf16_t* GYb = GY + (size_t)unit * 2048 * 64;
        float hcar0 = 0.f, hcar1 = 0.f;
#pragma unroll 1
        for (int rd = 0; rd < 8; ++rd) {
            const int t0 = rd * 256 + wave * 32, s = t0 + r;
            bf16_t gyr[2][16];
#pragma unroll
            for (int cb = 0; cb < 2; ++cb)
#pragma unroll
                for (int i = 0; i < 16; ++i) gyr[cb][i] = GYb[(size_t)(t0 + crow(i, hh)) * 64 + 32 * cb + r];
            bf16x8 af[8];
            {
                u32x4 xv[8][4];
#pragma unroll
                for (int st = 0; st < 8; ++st)
#pragma unroll
                    for (int j = 0; j < 4; ++j) { const int sp = s - 3 + j; xv[st][j] = *(const u32x4*)(XAb + (size_t)(sp < 0 ? 0 : sp) * 128 + 16 * st + 8 * hh); }
#pragma unroll
                for (int st = 0; st < 8; ++st) {
                    const int ch0 = 16 * st + 8 * hh; float xc[8];
#pragma unroll
                    for (int e = 0; e < 8; ++e) xc[e] = CW[512 + ch0 + e];
#pragma unroll
                    for (int j = 0; j < 4; ++j) { const float ok = (s - 3 + j >= 0) ? 1.f : 0.f; const u32x4 x4 = xv[st][j];
                        xc[0] += ok * CW[j * 128 + ch0 + 0] * bflo(x4.x); xc[1] += ok * CW[j * 128 + ch0 + 1] * bfhi(x4.x); xc[2] += ok * CW[j * 128 + ch0 + 2] * bflo(x4.y); xc[3] += ok * CW[j * 128 + ch0 + 3] * bfhi(x4.y);
                        xc[4] += ok * CW[j * 128 + ch0 + 4] * bflo(x4.z); xc[5] += ok * CW[j * 128 + ch0 + 5] * bfhi(x4.z); xc[6] += ok * CW[j * 128 + ch0 + 6] * bflo(x4.w); xc[7] += ok * CW[j * 128 + ch0 + 7] * bfhi(x4.w); }
                    u32x4 w; w.x = pk2(xc[0], xc[1]); w.y = pk2(xc[2], xc[3]); w.z = pk2(xc[4], xc[5]); w.w = pk2(xc[6], xc[7]);
                    af[st] = __builtin_bit_cast(bf16x8, w);
                    *(LAS u32x4*)(XS + r * 272 + ch0 * 2) = w;
                }
            }
            LDS_WAIT();
            float av[2][16], bv[2][16];
#pragma unroll
            for (int cb = 0; cb < 2; ++cb) {
                f32x16 aR, aI;
#pragma unroll
                for (int i = 0; i < 16; ++i) { aR[i] = 0.f; aI[i] = 0.f; }
#pragma unroll
                for (int st = 0; st < 8; ++st) {
                    const bf16x8 bR = *(const LAS bf16x8*)(WL + (32 * cb + r) * 272 + st * 32 + hh * 16), bI = *(const LAS bf16x8*)(WL + (64 + 32 * cb + r) * 272 + st * 32 + hh * 16);
                    aR = MFMA32(af[st], bR, aR); aI = MFMA32(af[st], bI, aI);
                }
                const int chl = 32 * cb + r; const float br_ = CW[640 + chl], bi_ = CW[704 + chl], sp_ = CW[768 + chl];
#pragma unroll
                for (int i = 0; i < 16; ++i) {
                    const float rr = sigm(aR[i] + br_), ig = sigm(aI[i] + bi_), a = __expf(-8.f * rr * sp_);
                    const float xcv = bf2f(*(const LAS bf16_t*)(XS + crow(i, hh) * 272 + (hf * 64 + chl) * 2));
                    av[cb][i] = a; bv[cb][i] = sqrtf(fmaxf(1.f - a * a, 0.f)) * ig * xcv;
                }
            }
            float GA[2][4], GB[2][4], PA[2][4], PB[2][4];
#pragma unroll
            for (int cb = 0; cb < 2; ++cb)
#pragma unroll
                for (int g = 0; g < 4; ++g) {
                    float A = av[cb][4 * g], B = bv[cb][4 * g];
#pragma unroll
                    for (int e = 1; e < 4; ++e) { B = av[cb][4 * g + e] * B + bv[cb][4 * g + e]; A *= av[cb][4 * g + e]; }
                    GA[cb][g] = A; GB[cb][g] = B; PA[cb][g] = __shfl_xor(A, 32); PB[cb][g] = __shfl_xor(B, 32);
                }
            LAS float* cbuf = car + (rd & 1) * 1024;
#pragma unroll
            for (int cb = 0; cb < 2; ++cb) {
                float A = 1.f, B = 0.f;
#pragma unroll
                for (int g = 0; g < 4; ++g) {
                    const float A0 = hh ? PA[cb][g] : GA[cb][g], B0 = hh ? PB[cb][g] : GB[cb][g], A1 = hh ? GA[cb][g] : PA[cb][g], B1 = hh ? GB[cb][g] : PB[cb][g];
                    B = A0 * B + B0; A *= A0; B = A1 * B + B1; A *= A1;
                }
                if (hh == 0) { cbuf[(wave * 2) * 64 + 32 * cb + r] = A; cbuf[(wave * 2 + 1) * 64 + 32 * cb + r] = B; }
            }
            __syncthreads();
#pragma unroll
            for (int cb = 0; cb < 2; ++cb) {
                float hin = cb ? hcar1 : hcar0, myhin = 0.f;
#pragma unroll
                for (int w = 0; w < 8; ++w) { if (w == wave) myhin = hin; hin = cbuf[(w * 2) * 64 + 32 * cb + r] * hin + cbuf[(w * 2 + 1) * 64 + 32 * cb + r]; }
                if (cb) hcar1 = hin; else hcar0 = hin;
                float hrun = myhin;
#pragma unroll
                for (int g = 0; g < 4; ++g) {
                    if (hh) hrun = PA[cb][g] * hrun + PB[cb][g];
                    float hv = hrun;
#pragma unroll
                    for (int e = 0; e < 4; ++e) { const int i = 4 * g + e; hv = av[cb][i] * hv + bv[cb][i];
                        HG[((size_t)b * SEQ + t0 + crow(i, hh)) * DM + h * 128 + hf * 64 + 32 * cb + r] = (bf16_t)(pk2(hv * bf2f(gyr[cb][i]), 0.f) & 0xffffu); }
                    hrun = hv;
                    if (!hh) hrun = PA[cb][g] * hrun + PB[cb][g];
                }
            }
        }
    }
}
NOINL __device__ void ph_nsa(unsigned char* ws) {
    const int bx = blockIdx.x, G = gridDim.x;
    const int vcu = (G % 8 == 0) ? (bx % 8) * (G / 8) + bx / 8 : bx;
#pragma unroll 1
    for (int uu = vcu; uu < 1024; uu += G) {
        const int pr = uu & 255, it = uu >> 8, bg = pr >> 3, s = pr & 7;
        const int qblk = (it == 0) ? s : (it == 1) ? 15 - s : (it == 2) ? 16 + s : 31 - s;
        nsa_unit(bg, qblk, ws, LDS_PTR());
    }
}

constexpr size_t WS_BAR = 960 * 1024;
constexpr int LDS_BARST = LDS_BYTES - 16;
#define XB_TMO      128
#define XB_XCNT(j)  (256  + 64 * (j))
#define XB_XSUB(j)  (1280 + 64 * (j))
#define XB_XGEN(j)  (2304 + 64 * (j))
#define XB_TOP      3328
#define XB_TOPGEN   3392
#define XCD_BAR_WORDS 3456
#define XB_SPIN_CAP (1u << 18)
DI unsigned xb_ld(unsigned* p)              { return __hip_atomic_load(p, __ATOMIC_RELAXED, __HIP_MEMORY_SCOPE_AGENT); }
DI unsigned xb_add(unsigned* p, unsigned v) { return __hip_atomic_fetch_add(p, v, __ATOMIC_RELAXED, __HIP_MEMORY_SCOPE_AGENT); }
DI unsigned xb_xcc_id() { return (unsigned)__builtin_amdgcn_s_getreg((3 << 11) | 20) & 0xFu; }
#define XB_SPIN(cond, bar) do { unsigned _sp = 0; while (cond) { __builtin_amdgcn_s_sleep(1); \
    if ((++_sp & 255u) == 0u) { if (xb_ld(&(bar)[XB_TMO])) break; if (_sp > XB_SPIN_CAP) { atomicAdd(&(bar)[XB_TMO], 1u); break; } } } } while (0)
DI void xcd_barrier_complete(unsigned* bar, unsigned x, unsigned& nloc, unsigned& nx) {
    const unsigned G = gridDim.x * gridDim.y * gridDim.z;
    unsigned sum, cnt, mine, sp = 0u;
    for (;;) {
        sum = 0u; cnt = 0u; mine = 0u;
#pragma unroll
        for (unsigned j = 0; j < 16; ++j) { const unsigned c = xb_ld(&bar[XB_XCNT(j)]); sum += c; cnt += (c > 0u) ? 1u : 0u; mine = (j == x) ? c : mine; }
        if (sum == G) break;
        __builtin_amdgcn_s_sleep(1);
        if ((++sp & 255u) == 0u) { if (xb_ld(&bar[XB_TMO])) break; if (sp > XB_SPIN_CAP) { atomicAdd(&bar[XB_TMO], 1u); break; } }
    }
    nloc = mine > 0u ? mine : 1u; nx = cnt > 0u ? cnt : 1u;
}
DI void xcd_barrier(unsigned* bar) {
    asm volatile("s_waitcnt vmcnt(0)" ::: "memory");
    __syncthreads();
    if (threadIdx.x == 0) {
        volatile LAS unsigned* st = (volatile LAS unsigned*)(LDS_PTR() + LDS_BARST);
        const unsigned x = xb_xcc_id();
        __builtin_amdgcn_s_waitcnt(0);
        unsigned nloc = st[0], nx = st[1];
        if (nloc == 0u) { xcd_barrier_complete(bar, x, nloc, nx); st[0] = nloc; st[1] = nx; }
        const unsigned old = xb_add(&bar[XB_XSUB(x)], 1u);
        const unsigned gen = old / nloc;
        if (old + 1u == (gen + 1u) * nloc) {
            __builtin_amdgcn_fence(__ATOMIC_RELEASE, "agent");
            asm volatile("s_waitcnt vmcnt(0)" ::: "memory");
            const unsigned og = xb_add(&bar[XB_TOP], 1u);
            const unsigned tg = og / nx;
            if (og + 1u == (tg + 1u) * nx) xb_add(&bar[XB_TOPGEN], 1u);
            else XB_SPIN(xb_ld(&bar[XB_TOPGEN]) == tg, bar);
            __builtin_amdgcn_fence(__ATOMIC_ACQUIRE, "agent");
            xb_add(&bar[XB_XGEN(x)], 1u);
            asm volatile("s_waitcnt vmcnt(0)" ::: "memory");
        } else {
            XB_SPIN(xb_ld(&bar[XB_XGEN(x)]) == gen, bar);
            __builtin_amdgcn_fence(__ATOMIC_ACQUIRE, "agent");
            asm volatile("s_waitcnt vmcnt(0)" ::: "memory");
        }
    }
    __syncthreads();
}

DI KArgs oargs() { auto p = __builtin_amdgcn_kernarg_segment_ptr(); asm volatile("" : "+s"(p)); return (KArgs)p; }

DI void ph_prologue() {
    KArgs ka = oargs();
    LAS unsigned char* lds = LDS_PTR(); unsigned char* ws = ka->ws; float* mod = (float*)(ws + WS_MOD);
    const int tid = otid(), lane = tid & 63, wave = __builtin_amdgcn_readfirstlane(tid >> 6), G = gridDim.x, bx = blockIdx.x, gw = bx * NWV + wave, ngw = G * NWV;
#ifdef PROBE_ADA
    const unsigned long long tp0 = __builtin_amdgcn_s_memrealtime();
#endif
    if (bx < 72) {
        LAS float* cact = (LAS float*)lds;
        LAS float* red = (LAS float*)(lds + 65536);
        const float* c = ka->in[1]; const float* wada = ka->in[2]; const float* bada = ka->in[3];
        for (int i = tid; i < NB * DM; i += NTHR) { const float v = c[i]; cact[i] = v * sigm(v); }
        __syncthreads();
        const int col = bx * 256 + 4 * lane;
        f32x4 acc[8];
#pragma unroll
        for (int b = 0; b < 8; ++b) acc[b] = (f32x4){0.f, 0.f, 0.f, 0.f};
        const float* wp = wada + (size_t)(wave * 256) * (NADA * DM) + col;
#pragma unroll 1
        for (int k = 0; k < 256; k += 8) {
            f32x4 w[8];
#pragma unroll
            for (int e = 0; e < 8; ++e) w[e] = *(const f32x4*)(wp + (size_t)(k + e) * (NADA * DM));
#pragma unroll
            for (int e = 0; e < 8; ++e)
#pragma unroll
                for (int b = 0; b < 8; ++b) acc[b] += w[e] * cact[b * DM + wave * 256 + k + e];
        }
#pragma unroll
        for (int b = 0; b < 8; ++b) *(LAS f32x4*)(red + (wave * 8 + b) * 256 + 4 * lane) = acc[b];
        __syncthreads();
#pragma unroll
        for (int e = 0; e < 4; ++e) { const int idx = tid + 512 * e, b = idx >> 8, cc = idx & 255; float sum = bada[bx * 256 + cc];
#pragma unroll
            for (int w = 0; w < 8; ++w) sum += red[(w * 8 + b) * 256 + cc];
            mod[b * (NADA * DM) + bx * 256 + cc] = sum; }
        __syncthreads();
    }
#ifdef PROBE_ADA
    { const unsigned long long tp1 = __builtin_amdgcn_s_memrealtime(); while (__builtin_amdgcn_s_memrealtime() - tp1 < tp1 - tp0) __builtin_amdgcn_s_sleep(8); }
#endif
    {
        const int nada = (G > 72) ? 72 : 0, nslots = (G - nada) * NWV * 2 + nada * NWV;
        const int slot0 = (bx >= nada) ? ((bx - nada) * NWV + wave) * 2 : (G - nada) * NWV * 2 + bx * NWV + wave, nslot = (bx >= nada) ? 2 : 1;
        conv_jobs_w(0, 9, ka, lds, slot0, nslot, nslots, wave, lane);
        conv_jobs_w(11, 12, ka, lds, slot0, nslot, nslots, wave, lane);
    }
    {
        const int idx = bx * NTHR + tid;
        if (idx < SEQ * 16) { const int pos = idx >> 4, i = idx & 15;
            const float invf = __builtin_amdgcn_exp2f(-(float)i * 1.1832230356f); const float ang = (float)pos * invf;
            const float rev = ang * 0.15915494309189535f, fr = rev - floorf(rev);
            float* rp = (float*)(ws + WS_ROPE) + pos * 32; rp[i] = __builtin_amdgcn_cosf(fr); rp[16 + i] = __builtin_amdgcn_sinf(fr); }
    }
    __syncthreads();
}
DI void ph_rows(int which) {
    KArgs ka = oargs(); unsigned char* ws = ka->ws; float* out = ka->out; const float* mod = (const float*)(ws + WS_MOD);
    const int tid = otid(), lane = tid & 63, wave = __builtin_amdgcn_readfirstlane(tid >> 6), G = gridDim.x, bx = blockIdx.x, gw = bx * NWV + wave, ngw = G * NWV;
    if (which == 0) {
        const float* x = ka->in[0]; const float* g = ka->in[4];
        for (int row = gw; row < T; row += ngw) { const int b = row >> 11; f32x4 v[8]; row_load(v, x + (size_t)row * DM, lane); const float rs = row_rstd(v);
            row_modulate_store(v, rs, g, mod + b * (NADA * DM) + 0 * DM, mod + b * (NADA * DM) + 1 * DM, (bf16_t*)(ws + WS_U) + (size_t)row * DM, lane); }
    } else if (which == 1) {
        const float* x = ka->in[0]; const float* pg = ka->in[5]; const float* g = ka->in[9];
        for (int row = gw; row < T; row += ngw) { const int b = row >> 11; const float* mb = mod + b * (NADA * DM); f32x4 v[8];
            row_residual(v, (const bf16_t*)(ws + WS_F) + (size_t)row * DM, x + (size_t)row * DM, mb + 2 * DM, pg, 0.5f, out + (size_t)row * DM, lane);
            const float rs = row_rstd(v); row_modulate_store(v, rs, g, mb + 3 * DM, mb + 4 * DM, (bf16_t*)(ws + WS_U) + (size_t)row * DM, lane); }
    } else if (which == 2) {
        const float* pg = ka->in[10]; const float* g = ka->in[28];
        for (int row = gw; row < T; row += ngw) { const int b = row >> 11; const float* mb = mod + b * (NADA * DM); f32x4 v[8];
            row_residual(v, (const bf16_t*)(ws + WS_FMIX) + (size_t)row * DM, out + (size_t)row * DM, mb + 5 * DM, pg, 1.0f, out + (size_t)row * DM, lane);
            const float rs = row_rstd(v); row_modulate_store(v, rs, g, mb + 6 * DM, mb + 7 * DM, (bf16_t*)(ws + WS_U) + (size_t)row * DM, lane); }
        conv_jobs_w(9, 11, ka, LDS_PTR(), gw, 1, ngw, wave, lane);
    } else {
        const float* pg = ka->in[29];
        for (int row = gw; row < T; row += ngw) { const int b = row >> 11; const float* mb = mod + b * (NADA * DM); f32x4 v[8];
            row_residual(v, (const bf16_t*)(ws + WS_F) + (size_t)row * DM, out + (size_t)row * DM, mb + 8 * DM, pg, 0.5f, out + (size_t)row * DM, lane); }
    }
}

DI void ph_pebias() {
    const int G = gridDim.x, bx = blockIdx.x;
    if (bx < G - 2) return;
    KArgs ka = oargs(); unsigned char* ws = ka->ws;
    const int tid = otid(), src = bx - (G - 2); const float* pe = ka->in[src ? 22 : 19]; const float* w1 = ka->in[src ? 23 : 20];
    LAS f32x4* red = (LAS f32x4*)LDS_PTR();
    const int d4 = tid & 31, kq = tid >> 5;
    f32x4 acc = {0.f, 0.f, 0.f, 0.f};
#pragma unroll 1
    for (int k = kq * 256; k < kq * 256 + 256; k += 16) {
        f32x4 w[16]; float pv[16];
#pragma unroll
        for (int e = 0; e < 16; ++e) { w[e] = *(const f32x4*)(w1 + (size_t)(k + e) * 128 + 4 * d4); pv[e] = pe[k + e]; }
#pragma unroll
        for (int e = 0; e < 16; ++e) acc += w[e] * pv[e];
    }
    __syncthreads();
    red[tid] = acc; __syncthreads();
    if (tid < 32) { f32x4 sum = red[tid];
#pragma unroll
        for (int q = 1; q < 16; ++q) sum += red[q * 32 + tid];
        *(f32x4*)((float*)(ws + WS_PEB) + src * 128 + 4 * tid) = sum; }
    __syncthreads();
}

__global__ void __launch_bounds__(NTHR) fwd_kernel(Args args_unused) {
    cg::grid_group grid = cg::this_grid();
    {
        volatile LAS unsigned* st = (volatile LAS unsigned*)(LDS_PTR() + LDS_BARST);
        if (threadIdx.x < 2) st[threadIdx.x] = 0u;
        __syncthreads();
        if (threadIdx.x == 0) (void)xb_add((unsigned*)(oargs()->ws + WS_BAR) + XB_XCNT(xb_xcc_id()), 1u);
    }
#ifndef PH_MASK
#define PH_MASK 0xffff
#endif
#define WSP() (oargs()->ws)
#ifndef PROBE_DUP
#define PROBE_DUP 0
#endif
#ifndef PROBE_SPIN
#define PROBE_SPIN 0
#endif
#define RUN(k, bit, body) if (oargs()->ph_lo <= (k) && (k) < oargs()->ph_hi) { unsigned long long _t0 = 0; if (((PROBE_SPIN) >> (k)) & 1) _t0 = __builtin_amdgcn_s_memrealtime(); \
    for (int _rep = 0; _rep < 1 + (((PROBE_DUP) >> (bit)) & 1); ++_rep) if (((PH_MASK) >> (bit)) & 1) { body; } \
    if (((PROBE_SPIN) >> (k)) & 1) { __syncthreads(); const unsigned long long _t1 = __builtin_amdgcn_s_memrealtime(); while (__builtin_amdgcn_s_memrealtime() - _t1 < _t1 - _t0) __builtin_amdgcn_s_sleep(8); } }
#define SEAMX(k) if (oargs()->ph_lo <= (k) && (k) + 1 < oargs()->ph_hi) { if (oargs()->ph_hi > 1000) grid.sync(); else xcd_barrier((unsigned*)(oargs()->ws + WS_BAR)); }
    RUN(0, 0, ph_prologue()) SEAMX(0)
    RUN(1, 1, ph_rows(0)) SEAMX(1)
    RUN(2, 2, ph_ffn_up(WSP())) SEAMX(2)
    RUN(3, 3, ph_ffn_down(WSP())) SEAMX(3)
    RUN(4, 4, ph_rows(1)) SEAMX(4)
    RUN(5, 5, ph_inproj(WSP()); ph_vt(WSP()); ph_pebias()) SEAMX(5)
    RUN(6, 6, ph_cmp1(WSP())) SEAMX(6)
    RUN(7, 7, ph_cmp2(WSP()); __syncthreads(); ph_lru_fused(oargs()->ws, oargs()->in[12], oargs()->in[13], oargs()->in[15], oargs()->in[17], oargs()->in[18]))
    SEAMX(7)
    RUN(8, 8, ph_nsa(WSP())) SEAMX(8)
    RUN(9, 9, ph_ya(WSP()))
    RUN(10, 10, ph_yb(WSP())) SEAMX(10)
    RUN(11, 11, ph_out(WSP())) SEAMX(11)
    RUN(12, 12, ph_rows(2)) SEAMX(12)
    RUN(13, 2, ph_ffn_up(WSP())) SEAMX(13)
    RUN(14, 3, ph_ffn_down(WSP())) SEAMX(14)
    RUN(15, 15, ph_rows(3))
}

extern "C" void kernel_launch(void* const* d_in, const int* in_sizes, int n_in, void* d_out, int out_size, void* d_ws, size_t ws_size, hipStream_t stream) {
    static int grid = 0;
    if (grid == 0) {
        if (n_in != 33 || out_size != T * DM || ws_size < WS_END) { fprintf(stderr, "kernel_launch: unexpected problem (n_in %d out %d ws %zu)\n", n_in, out_size, ws_size); grid = -1; return; }
        int dev = 0, cus = 0, per_cu = 0;
        hipGetDevice(&dev); hipDeviceGetAttribute(&cus, hipDeviceAttributeMultiprocessorCount, dev);
        if (hipFuncSetAttribute((const void*)fwd_kernel, hipFuncAttributeMaxDynamicSharedMemorySize, LDS_BYTES) != hipSuccess) { fprintf(stderr, "kernel_launch: hipFuncSetAttribute failed\n"); grid = -1; return; }
        if (hipOccupancyMaxActiveBlocksPerMultiprocessor(&per_cu, (const void*)fwd_kernel, NTHR, LDS_BYTES) != hipSuccess || per_cu < 1) { fprintf(stderr, "kernel_launch: occupancy query gives %d\n", per_cu); per_cu = 1; }
        (void)hipGetLastError();
        grid = cus;
    }
    if (grid < 0) return;
    if (hipMemsetAsync((char*)d_ws + WS_BAR, 0, 16384, stream) != hipSuccess) { fprintf(stderr, "kernel_launch: memset of the barrier words failed\n"); return; }
    Args a{};
    for (int i = 0; i < 33; ++i) a.in[i] = (const float*)d_in[i];
    a.out = (float*)d_out; a.ws = (unsigned char*)d_ws;
#if ONE_LAUNCH
    a.ph_lo = 0; a.ph_hi = 16;
    void* params[] = {&a};
    hipError_t e = hipLaunchCooperativeKernel((const void*)fwd_kernel, dim3(grid), dim3(NTHR), params, LDS_BYTES, stream);
    if (e != hipSuccess) fprintf(stderr, "cooperative launch failed: %s (grid %d)\n", hipGetErrorString(e), grid);
#else
    for (int p = 0; p < 16; ++p) { a.ph_lo = p; a.ph_hi = p + 1; hipLaunchKernelGGL(fwd_kernel, dim3(grid), dim3(NTHR), LDS_BYTES, stream, a); }
#endif
}
```

```cpp
#include <hip/hip_runtime.h>
#include <hip/hip_cooperative_groups.h>
#include <cstdio>
#include <cstdint>
namespace cg = cooperative_groups;


#ifndef ONE_LAUNCH
#define ONE_LAUNCH 1
#endif

#define LAS __attribute__((address_space(3)))
#define DI __device__ __forceinline__
typedef unsigned short bf16_t;
typedef short bf16x8 __attribute__((ext_vector_type(8)));
typedef short s16x4 __attribute__((ext_vector_type(4)));
typedef float f32x2 __attribute__((ext_vector_type(2)));
typedef float f32x4 __attribute__((ext_vector_type(4)));
typedef float f32x16 __attribute__((ext_vector_type(16)));
typedef unsigned u32x2 __attribute__((ext_vector_type(2)));
typedef unsigned u32x4 __attribute__((ext_vector_type(4)));
typedef __bf16 bf16x2_t __attribute__((ext_vector_type(2)));

constexpr int DM = 2048, NB = 8, SEQ = 2048, T = NB * SEQ, DFF = 5632, NADA = 9;
constexpr int INW = 13360;
constexpr int NTHR = 512, NWV = 8;
constexpr float EPS = 1e-6f;
constexpr size_t MiB = 1u << 20;
constexpr size_t WS_MOD = 0;
constexpr size_t WS_ROPE = 640 * 1024;
constexpr size_t WS_PEB = 900 * 1024;
constexpr size_t WS_W2T = 1 * MiB;
constexpr size_t WS_WGU = 2 * MiB, WS_WD = 46 * MiB;
constexpr size_t WS_BB = 2 * MiB;
constexpr size_t WS_WIN = 68 * MiB, WS_WV = 117 * MiB, WS_WA = 640 * MiB, WS_WB = 648 * MiB, WS_WO = 656 * MiB;
constexpr size_t WS_HG = 68 * MiB;
constexpr size_t WS_PART = 68 * MiB;
constexpr size_t WS_W1T = 145 * MiB, WS_WRI = 147 * MiB, WS_KCC = 152 * MiB, WS_VCT = 153 * MiB, WS_NG = 154 * MiB;
constexpr size_t WS_U = 160 * MiB;
constexpr size_t WS_H = 224 * MiB, WS_F = 400 * MiB;
constexpr size_t WS_XA = 224 * MiB, WS_GY = 288 * MiB, WS_Q = 352 * MiB, WS_KC = 416 * MiB, WS_VC = 432 * MiB, WS_KS = 448 * MiB, WS_KW = 464 * MiB;
constexpr size_t WS_VST = 480 * MiB, WS_VWT = 496 * MiB, WS_MG = 512 * MiB, WS_FMIX = 512 * MiB;
constexpr size_t WS_END = 664 * MiB;
constexpr int LDS_BYTES = 147456;

struct Args { const float* in[33]; float* out; unsigned char* ws; int ph_lo, ph_hi; };
typedef const Args __attribute__((address_space(4)))* KArgs;

DI unsigned pk2(float lo, float hi) { f32x2 v = {lo, hi}; bf16x2_t b = __builtin_convertvector(v, bf16x2_t); return __builtin_bit_cast(unsigned, b); }
DI float bf2f(bf16_t v) { return __uint_as_float((unsigned)v << 16); }
DI float bflo(unsigned w) { return __uint_as_float(w << 16); }
DI float bfhi(unsigned w) { return __uint_as_float(w & 0xffff0000u); }
DI float sigm(float x) { return __builtin_amdgcn_rcpf(1.f + __builtin_amdgcn_exp2f(-1.4426950408889634f * x)); }
DI float gelu_t(float x) { const float u = 0.7978845608028654f * (x + 0.044715f * x * x * x); return x * __builtin_amdgcn_rcpf(1.f + __builtin_amdgcn_exp2f(-2.8853900817779268f * u)); }
DI float wave_sum(float v) {
#pragma unroll
    for (int o = 1; o < 64; o <<= 1) v += __shfl_xor(v, o);
    return v;
}
#define LDS_WAIT() asm volatile("s_waitcnt lgkmcnt(0)" ::: "memory")
DI int otid() { int t = threadIdx.x; asm volatile("" : "+v"(t)); return t; }

namespace pg8 {
constexpr int BM = 256, BK = 64, HALF = 128, HTB = HALF * BK * 2, STAGE_BYTES = 8 * HTB, NXCD = 8, WGM = 8;
DI int lds_byte(int r, int c) { const int st = (r >> 4) * 2 + (c >> 5), rr = r & 15, cc = c & 31, ob = rr * 64 + cc * 2; return st * 1024 + (ob ^ (((ob >> 9) & 1) << 5)); }
DI void stage_rc(int b, int& R, int& C) { const int st = b / 1024, sb = b % 1024, swz = sb ^ (((sb >> 9) & 1) << 5); R = (st >> 1) * 16 + swz / 64; C = (st & 1) * 32 + (swz % 64) / 2; }
DI int perm32(int rho) { const int n = rho >> 4, i = rho & 15; return 8 * (i >> 2) + 4 * n + (i & 3); }

struct Unit { int pm, pn; long aoff, boff; };
struct Gemm { const bf16_t* A; const bf16_t* Bt; int lda, ldb, K; };
struct Sched {
    int nM, nN, nwg, G, c, mode; long astep, bstep, srcstride;
    DI void init(int nM_, int nN_, int G_, int c_, long astep_, long bstep_) { nM = nM_; nN = nN_; nwg = nM * nN; G = G_; c = c_; mode = 0; astep = astep_; bstep = bstep_; srcstride = 0; }
    DI bool next(int i, Unit& u) const {
        const long L = (long)i * G + c; if (L >= nwg) return false;
        int wgid = (int)L;
        if (mode == 1) {
            const int pm = wgid & 15, ks = (wgid >> 4) & 7, src = wgid >> 7;
            u.pm = pm; u.pn = src + 2 * ks; u.aoff = (long)src * srcstride + (long)pm * 256 * 2048 * 2 + (long)ks * 1024; u.boff = (long)ks * 1024; return true;
        }
        { const int q = nwg / NXCD, r = nwg % NXCD, xcd = wgid % NXCD, off = wgid / NXCD; wgid = (xcd < r ? xcd * (q + 1) : r * (q + 1) + (xcd - r) * q) + off; }
        const int nig = WGM * nN, gid = wgid / nig, fm = gid * WGM, gsz = (nM - fm) < WGM ? (nM - fm) : WGM;
        u.pm = fm + ((wgid % nig) % gsz); u.pn = (wgid % nig) / gsz; u.aoff = (long)u.pm * astep; u.boff = (long)u.pn * bstep; return true;
    }
};

template <class Epi>
DI void gemm_phase(LAS unsigned char* lds, const Gemm g, const Sched& S, const Epi& E) {
    const int tid = otid(), wid = __builtin_amdgcn_readfirstlane(tid >> 6), lane = tid & 63, wr = wid >> 2, wc = wid & 3, fr = lane & 15, fq = lane >> 4;
    const int K = g.K, nt = K / BK;
    unsigned voffA[2], voffB[2];
#pragma unroll
    for (int i = 0; i < 2; ++i) { int R, C; stage_rc(tid * 16 + i * 8192, R, C); const int Rb = Epi::PERM ? ((R & ~31) + perm32(R & 31)) : R;
        voffA[i] = (unsigned)(R * g.lda + C) * 2u; voffB[i] = (unsigned)(Rb * g.ldb + C) * 2u; }
    const size_t kstep = (size_t)(BK * 2);
    const size_t hsA = (size_t)HALF * g.lda * 2, hsB = (size_t)HALF * g.ldb * 2;
    const unsigned ldsw = (unsigned)wid * 1024u;
    const int aoff = lds_byte(wr * 64 + fr, fq * 8), boff = lds_byte(wc * 32 + fr, fq * 8);
#define PG8_SA(b, h) (((b) * 2 + (h)) * HTB)
#define PG8_SB(b, h) ((4 + (b) * 2 + (h)) * HTB)
#define PG8_STAGE(bufoff, gbase, voff) do { _Pragma("unroll") for (int _i = 0; _i < 2; ++_i) \
        __builtin_amdgcn_global_load_lds((const unsigned*)((const char*)(gbase) + (voff)[_i]), (LAS unsigned*)(lds + (bufoff) + ldsw + _i * 8192), 16, 0, 0); } while (0)
#define PG8_LDA(dst, b, h) do { _Pragma("unroll") for (int m = 0; m < 4; ++m) _Pragma("unroll") for (int k = 0; k < 2; ++k) dst[m][k] = *(const LAS bf16x8*)(lds + PG8_SA(b, h) + aoff + m * 2048 + k * 1024); } while (0)
#define PG8_LDB(dst, b, h) do { _Pragma("unroll") for (int n = 0; n < 2; ++n) _Pragma("unroll") for (int k = 0; k < 2; ++k) dst[n][k] = *(const LAS bf16x8*)(lds + PG8_SB(b, h) + boff + n * 2048 + k * 1024); } while (0)
#define PG8_MMA(ai, bj, At, Bt) do { __builtin_amdgcn_s_setprio(1); _Pragma("unroll") for (int m = 0; m < 4; ++m) _Pragma("unroll") for (int n = 0; n < 2; ++n) _Pragma("unroll") for (int k = 0; k < 2; ++k) \
        acc[ai][bj][m][n] = __builtin_amdgcn_mfma_f32_16x16x32_bf16(Bt[n][k], At[m][k], acc[ai][bj][m][n], 0, 0, 0); __builtin_amdgcn_s_setprio(0); } while (0)
#define PG8_WAIT_V(n) asm volatile("s_waitcnt vmcnt(" #n ")" ::: "memory")
#define PG8_WAIT_L(n) asm volatile("s_waitcnt lgkmcnt(" #n ")" ::: "memory")
#define PG8_BAR __builtin_amdgcn_s_barrier()
#define PG8_SCHED __builtin_amdgcn_sched_barrier(0)
    Unit cur, nxt; int ui = 0;
    if (!S.next(0, cur)) return;
    f32x4 acc[2][2][4][2];
#pragma unroll
    for (int a = 0; a < 2; ++a)
#pragma unroll
        for (int b = 0; b < 2; ++b)
#pragma unroll
            for (int m = 0; m < 4; ++m)
#pragma unroll
                for (int n = 0; n < 2; ++n) acc[a][b][m][n] = (f32x4){0.f, 0.f, 0.f, 0.f};
    bf16x8 At[4][2], B0[2][2], B1[2][2];
    const char* cA = (const char*)g.A + cur.aoff; const char* cB = (const char*)g.Bt + cur.boff;
    PG8_STAGE(PG8_SB(0, 0), cB, voffB); PG8_STAGE(PG8_SB(0, 1), cB + hsB, voffB); PG8_STAGE(PG8_SA(0, 0), cA, voffA); PG8_STAGE(PG8_SA(0, 1), cA + hsA, voffA);
    if (wr == 1) PG8_BAR;
    PG8_WAIT_V(2); PG8_BAR;
    PG8_STAGE(PG8_SB(1, 0), cB + kstep, voffB); PG8_STAGE(PG8_SA(1, 0), cA + kstep, voffA); PG8_STAGE(PG8_SB(1, 1), cB + hsB + kstep, voffB);
    PG8_WAIT_V(6); PG8_BAR;
    for (;;) {
        const bool has_next = S.next(ui + 1, nxt);
        const char* nA = has_next ? (const char*)g.A + nxt.aoff : cA; const char* nB = has_next ? (const char*)g.Bt + nxt.boff : cB;
        for (int t = 0; t < nt; t += 2) {
            const bool last = (t == nt - 2);
            const char* a1 = cA + (size_t)(t + 1) * kstep;
            const char* a2 = last ? nA : cA + (size_t)(t + 2) * kstep; const char* b2 = last ? nB : cB + (size_t)(t + 2) * kstep;
            const char* a3 = a2 + kstep; const char* b3 = b2 + kstep;
            PG8_LDB(B0, 0, 0); PG8_LDB(B1, 0, 1); PG8_SCHED; PG8_LDA(At, 0, 0); PG8_STAGE(PG8_SA(1, 1), a1 + hsA, voffA);
            PG8_WAIT_V(8); PG8_WAIT_L(0); PG8_BAR; PG8_MMA(0, 0, At, B0); PG8_MMA(0, 1, At, B1); PG8_BAR; PG8_SCHED;
            PG8_LDA(At, 0, 1); PG8_STAGE(PG8_SB(0, 0), b2, voffB); PG8_STAGE(PG8_SB(0, 1), b2 + hsB, voffB); PG8_STAGE(PG8_SA(0, 0), a2, voffA);
            PG8_WAIT_V(8); PG8_WAIT_L(0); PG8_BAR; PG8_MMA(1, 0, At, B0); PG8_MMA(1, 1, At, B1); PG8_BAR; PG8_SCHED;
            PG8_LDB(B0, 1, 0); PG8_LDB(B1, 1, 1); PG8_SCHED; PG8_LDA(At, 1, 0); PG8_STAGE(PG8_SA(0, 1), a2 + hsA, voffA);
            PG8_WAIT_V(8); PG8_WAIT_L(0); PG8_BAR; PG8_MMA(0, 0, At, B0); PG8_MMA(0, 1, At, B1); PG8_BAR; PG8_SCHED;
            PG8_LDA(At, 1, 1); PG8_STAGE(PG8_SB(1, 0), b3, voffB); PG8_STAGE(PG8_SB(1, 1), b3 + hsB, voffB); PG8_STAGE(PG8_SA(1, 0), a3, voffA);
            PG8_WAIT_V(8); PG8_WAIT_L(0); PG8_BAR; PG8_MMA(1, 0, At, B0); PG8_MMA(1, 1, At, B1); PG8_BAR; PG8_SCHED;
        }
        if (wr == 0) PG8_BAR;
        E(acc, cur, wr, wc, fr, fq);
        if (!has_next) break;
#pragma unroll
        for (int a = 0; a < 2; ++a)
#pragma unroll
            for (int b = 0; b < 2; ++b)
#pragma unroll
                for (int m = 0; m < 4; ++m)
#pragma unroll
                    for (int n = 0; n < 2; ++n) acc[a][b][m][n] = (f32x4){0.f, 0.f, 0.f, 0.f};
        cur = nxt; cA = nA; cB = nB; ++ui;
        if (wr == 1) PG8_BAR;
    }
    PG8_WAIT_V(0);
    PG8_BAR;
#undef PG8_SA
#undef PG8_SB
#undef PG8_STAGE
#undef PG8_LDA
#undef PG8_LDB
#undef PG8_MMA
#undef PG8_WAIT_V
#undef PG8_WAIT_L
#undef PG8_BAR
#undef PG8_SCHED
}
}
using pg8::Unit;
typedef f32x4 AccT[2][2][4][2];

struct EpiFFN {
    static constexpr bool PERM = true; bf16_t* H;
    DI void operator()(const AccT& acc, const Unit& u, int wr, int wc, int fr, int fq) const {
        const int col = u.pn * 128 + wc * 32 + fq * 8;
#pragma unroll
        for (int ai = 0; ai < 2; ++ai)
#pragma unroll
            for (int m = 0; m < 4; ++m) {
                const int row = u.pm * 256 + ai * 128 + wr * 64 + m * 16 + fr;
                float v[8];
#pragma unroll
                for (int n = 0; n < 2; ++n)
#pragma unroll
                    for (int e = 0; e < 4; ++e) { const float gt = acc[ai][0][m][n][e], up = acc[ai][1][m][n][e]; v[n * 4 + e] = gt * sigm(gt) * up; }
                u32x4 w; w.x = pk2(v[0], v[1]); w.y = pk2(v[2], v[3]); w.z = pk2(v[4], v[5]); w.w = pk2(v[6], v[7]);
                *(u32x4*)(H + (size_t)row * DFF + col) = w;
            }
    }
};
struct EpiBf {
    static constexpr bool PERM = true; bf16_t* O;
    DI void operator()(const AccT& acc, const Unit& u, int wr, int wc, int fr, int fq) const {
#pragma unroll
        for (int ai = 0; ai < 2; ++ai)
#pragma unroll
            for (int m = 0; m < 4; ++m) {
                const int row = u.pm * 256 + ai * 128 + wr * 64 + m * 16 + fr;
#pragma unroll
                for (int bj = 0; bj < 2; ++bj) { const f32x4 v0 = acc[ai][bj][m][0], v1 = acc[ai][bj][m][1];
                    u32x4 w; w.x = pk2(v0[0], v0[1]); w.y = pk2(v0[2], v0[3]); w.z = pk2(v1[0], v1[1]); w.w = pk2(v1[2], v1[3]);
                    *(u32x4*)(O + (size_t)row * DM + u.pn * 256 + bj * 128 + wc * 32 + fq * 8) = w; }
            }
    }
};
struct EpiPart {
    static constexpr bool PERM = false; float* P;
    DI void operator()(const AccT& acc, const Unit& u, int wr, int wc, int fr, int fq) const {
        const int src = u.pn & 1, ks = u.pn >> 1;
        float* base = P + ((size_t)(ks * 2 + src) * 4096) * 128;
#pragma unroll
        for (int ai = 0; ai < 2; ++ai)
#pragma unroll
            for (int m = 0; m < 4; ++m) {
                const int row = u.pm * 256 + ai * 128 + wr * 64 + m * 16 + fr;
#pragma unroll
                for (int n = 0; n < 2; ++n) { const f32x4 v = src ? acc[ai][1][m][n] : acc[ai][0][m][n]; *(f32x4*)(base + (size_t)row * 128 + wc * 32 + n * 16 + fq * 4) = v; }
            }
    }
};
struct EpiVT {
    static constexpr bool PERM = true; bf16_t* VT0; bf16_t* VT1;
    DI void operator()(const AccT& acc, const Unit& u, int wr, int wc, int fr, int fq) const {
#pragma unroll
        for (int ai = 0; ai < 2; ++ai)
#pragma unroll
            for (int m = 0; m < 4; ++m) {
                const int r = u.pm * 256 + ai * 128 + wr * 64 + m * 16 + fr;
                const int piece = r >> 9, gg = (r >> 7) & 3, d = r & 127;
                bf16_t* base = piece ? VT1 : VT0;
#pragma unroll
                for (int bj = 0; bj < 2; ++bj) {
                    const int t = u.pn * 256 + bj * 128 + wc * 32 + fq * 8, b = t >> 11, s = t & 2047;
                    const f32x4 v0 = acc[ai][bj][m][0], v1 = acc[ai][bj][m][1];
                    u32x4 w; w.x = pk2(v0[0], v0[1]); w.y = pk2(v0[2], v0[3]); w.z = pk2(v1[0], v1[1]); w.w = pk2(v1[2], v1[3]);
                    *(u32x4*)(base + ((size_t)((b * 4 + gg) * 128 + d)) * 2048 + s) = w;
                }
            }
    }
};
struct EpiGate {
    static constexpr bool PERM = true; const bf16_t* MG; const bf16_t* YAG; bf16_t* O; int mode;
    DI void operator()(const AccT& acc, const Unit& u, int wr, int wc, int fr, int fq) const {
#pragma unroll
        for (int ai = 0; ai < 2; ++ai)
#pragma unroll
            for (int m = 0; m < 4; ++m) {
                const int row = u.pm * 256 + ai * 128 + wr * 64 + m * 16 + fr;
#pragma unroll
                for (int bj = 0; bj < 2; ++bj) {
                    const int col = u.pn * 256 + bj * 128 + wc * 32 + fq * 8;
                    const u32x4 gw = *(const u32x4*)(MG + (size_t)row * 4096 + (mode ? 2048 : 0) + col);
                    const f32x4 v0 = acc[ai][bj][m][0], v1 = acc[ai][bj][m][1];
                    float o[8] = {v0[0] * bflo(gw.x), v0[1] * bfhi(gw.x), v0[2] * bflo(gw.y), v0[3] * bfhi(gw.y), v1[0] * bflo(gw.z), v1[1] * bfhi(gw.z), v1[2] * bflo(gw.w), v1[3] * bfhi(gw.w)};
                    if (mode) { const u32x4 yw = *(const u32x4*)(YAG + (size_t)row * DM + col);
                        o[0] += bflo(yw.x); o[1] += bfhi(yw.x); o[2] += bflo(yw.y); o[3] += bfhi(yw.y); o[4] += bflo(yw.z); o[5] += bfhi(yw.z); o[6] += bflo(yw.w); o[7] += bfhi(yw.w); }
                    u32x4 w; w.x = pk2(o[0], o[1]); w.y = pk2(o[2], o[3]); w.z = pk2(o[4], o[5]); w.w = pk2(o[6], o[7]);
                    *(u32x4*)(O + (size_t)row * DM + col) = w;
                }
            }
    }
};
struct EpiIn {
    static constexpr bool PERM = true; unsigned char* ws; const float* rope;
    DI void operator()(const AccT& acc, const Unit& u, int wr, int wc, int fr, int fq) const {
#pragma unroll
        for (int bj = 0; bj < 2; ++bj) {
            const int c0 = u.pn * 256 + bj * 128 + wc * 32;
            const int col = c0 + fq * 8;
#pragma unroll
            for (int ai = 0; ai < 2; ++ai)
#pragma unroll
                for (int m = 0; m < 4; ++m) {
                    const int row = u.pm * 256 + ai * 128 + wr * 64 + m * 16 + fr;
                    const int b = row >> 11, s = row & 2047;
                    float v[8];
#pragma unroll
                    for (int n = 0; n < 2; ++n)
#pragma unroll
                        for (int e = 0; e < 4; ++e) v[n * 4 + e] = acc[ai][bj][m][n][e];
                    bf16_t* dst = nullptr;
                    if (c0 < 2048) { dst = (bf16_t*)(ws + WS_XA) + ((size_t)((b * 16 + (col >> 7)) * 2048 + s)) * 128 + (col & 127); }
                    else if (c0 < 4096) {
#pragma unroll
                        for (int e = 0; e < 8; ++e) v[e] = gelu_t(v[e]);
                        { const int chn = col - 2048; dst = (bf16_t*)(ws + WS_GY) + ((size_t)((b * 32 + (chn >> 6)) * 2048 + s)) * 64 + (chn & 63); } }
                    else if (c0 < 8192) {
                        const bool isq = c0 < 6144;
                        const int pc = (c0 - 6144) >> 9;
                        if ((c0 & 127) == 0 && (isq || pc != 1)) {
#pragma unroll
                            for (int e = 0; e < 8; ++e) {
                                const float invf = __builtin_amdgcn_exp2f(-(float)(8 * (fq & 1) + e) * 1.1832230356f), ang = (float)s * invf;
                                const float rev = ang * 0.15915494309189535f, fr = rev - floorf(rev);
                                const float cs = __builtin_amdgcn_cosf(fr), sn = __builtin_amdgcn_sinf(fr);
                                const float mine = v[e], other = __shfl_xor(mine, 32); v[e] = (fq < 2) ? mine * cs - other * sn : mine * cs + other * sn; }
                        }
                        if (isq) dst = (bf16_t*)(ws + WS_Q) + (size_t)row * DM + (col - 4096);
                        else { const int gg = ((c0 - 6144) >> 7) & 3, d = col & 127; dst = (bf16_t*)(ws + WS_KC + (size_t)pc * 16 * MiB) + ((size_t)((b * 4 + gg) * 2048 + s)) * 128 + d; }
                    }
                    else if (c0 < 12288) {
#pragma unroll
                        for (int e = 0; e < 8; ++e) v[e] = sigm(v[e]);
                        dst = (bf16_t*)(ws + WS_MG) + (size_t)row * 4096 + (col - 8192); }
                    else {
                        const int cc = col - 12288;
                        if (cc < 48) { float* ng = (float*)(ws + WS_NG) + (size_t)row * 48 + cc;
                            *(f32x4*)ng = (f32x4){sigm(v[0]), sigm(v[1]), sigm(v[2]), sigm(v[3])}; *(f32x4*)(ng + 4) = (f32x4){sigm(v[4]), sigm(v[5]), sigm(v[6]), sigm(v[7])}; }
                    }
                    if (dst) { u32x4 w; w.x = pk2(v[0], v[1]); w.y = pk2(v[2], v[3]); w.z = pk2(v[4], v[5]); w.w = pk2(v[6], v[7]); *(u32x4*)dst = w; }
                }
        }
    }
};

struct ConvJob { int K, Nd; };
DI const float* conv_src(int job, int d, KArgs a, int& ld) {
    switch (job) {
    case 0: case 9: { const int pn = d >> 8, half = (d >> 7) & 1, j = d & 127; ld = DFF; const int base = job == 0 ? 6 : 30; return a->in[base + half] + 128 * pn + j; }
    case 1: ld = DM; return a->in[8] + d;
    case 10: ld = DM; return a->in[32] + d;
    case 2: { ld = INW; int col;
        if (d < 7680) col = d; else if (d < 8192) col = d + 512; else if (d < 12288) col = d - 8192 + 9264; else if (d < 12336) col = d - 12288 + 9216; else return nullptr;
        return a->in[11] + col; }
    case 3: ld = INW; return a->in[11] + (d < 512 ? 7680 + d : 8704 + (d - 512));
    case 4: ld = DM; return a->in[25] + d;
    case 5: ld = DM; return a->in[26] + d;
    case 6: ld = DM; return a->in[27] + d;
    case 7: ld = 128; return (d < 128) ? a->in[20] + d : a->in[23] + (d - 128);
    case 8: { const int h = d >> 8, half = (d >> 7) & 1, j = d & 127; ld = 128; return (half ? a->in[16] : a->in[14]) + h * 16384 + j; }
    default: ld = 128; return (d < 128) ? a->in[21] + d : a->in[24] + (d - 128);
    }
}
DI bf16_t* conv_dst(int job, unsigned char* ws) {
    switch (job) {
    case 0: case 9: return (bf16_t*)(ws + WS_WGU);
    case 1: case 10: return (bf16_t*)(ws + WS_WD);
    case 2: return (bf16_t*)(ws + WS_WIN);
    case 3: return (bf16_t*)(ws + WS_WV);
    case 4: return (bf16_t*)(ws + WS_WA);
    case 5: return (bf16_t*)(ws + WS_WB);
    case 6: return (bf16_t*)(ws + WS_WO);
    case 7: return (bf16_t*)(ws + WS_W1T);
    case 8: return (bf16_t*)(ws + WS_WRI);
    default: return (bf16_t*)(ws + WS_W2T);
    }
}
DI void conv_dims(int job, int& K, int& Nd) {
    switch (job) {
    case 0: case 9: K = DM; Nd = 11264; break;
    case 1: case 10: K = DFF; Nd = DM; break;
    case 2: K = DM; Nd = 12544; break;
    case 3: K = DM; Nd = 1024; break;
    case 4: case 5: case 6: K = DM; Nd = DM; break;
    case 7: K = 4096; Nd = 256; break;
    case 8: K = 128; Nd = 4096; break;
    default: K = 128; Nd = 256; break;
    }
}
DI void conv_item(int job, int item, KArgs a, LAS float* scr, int lane) {
    int K, Nd; conv_dims(job, K, Nd);
    const int nkb = K / 64, kb = item % nkb, nb = item / nkb, k0 = 64 * kb, n0 = 64 * nb;
    const int kk = lane >> 4, n4 = lane & 15;
    int ld; const float* src = conv_src(job, n0 + 4 * n4, a, ld);
    f32x4 v[16];
#pragma unroll
    for (int i = 0; i < 16; ++i) v[i] = src ? *(const f32x4*)(src + (size_t)(k0 + 4 * i + kk) * ld) : (f32x4){0.f, 0.f, 0.f, 0.f};
#pragma unroll
    for (int i = 0; i < 16; ++i) { LAS float* q = scr + (4 * i + kk) * 65 + 4 * n4; q[0] = v[i][0]; q[1] = v[i][1]; q[2] = v[i][2]; q[3] = v[i][3]; }
    LDS_WAIT();
    bf16_t* WT = conv_dst(job, a->ws);
    const int c = lane & 7, nn = lane >> 3;
#pragma unroll
    for (int j = 0; j < 8; ++j) { const int n = nn + 8 * j; const LAS float* q = scr + (8 * c) * 65 + n;
        u32x4 o; o.x = pk2(q[0 * 65], q[1 * 65]); o.y = pk2(q[2 * 65], q[3 * 65]); o.z = pk2(q[4 * 65], q[5 * 65]); o.w = pk2(q[6 * 65], q[7 * 65]);
        *(u32x4*)(WT + (size_t)(n0 + n) * K + k0 + 8 * c) = o; }
    LDS_WAIT();
}
DI void conv_jobs(int jlo, int jhi, KArgs a, LAS unsigned char* lds, int gw, int ngw, int wave, int lane) {
    LAS float* scr = (LAS float*)(lds + wave * 16640);
    for (int job = jlo; job < jhi; ++job) {
        int K, Nd; conv_dims(job, K, Nd);
        const int nit = (K / 64) * (Nd / 64);
        for (int it = gw; it < nit; it += ngw) conv_item(job, it, a, scr, lane);
    }
}
DI void conv_pair(int job, int itA, int itB, bool hasB, KArgs a, LAS float* scr, int lane) {
    int K, Nd; conv_dims(job, K, Nd);
    const int nkb = K / 64; const int kk = lane >> 4, n4 = lane & 15;
    const int nblk = Nd / 64; (void)nkb;
    const int k0A = 64 * (itA / nblk), n0A = 64 * (itA % nblk), k0B = 64 * (itB / nblk), n0B = 64 * (itB % nblk);
    int ldA, ldB; const float* srcA = conv_src(job, n0A + 4 * n4, a, ldA); const float* srcB = hasB ? conv_src(job, n0B + 4 * n4, a, ldB) : nullptr; if (!hasB) ldB = 0;
    f32x4 vA[16], vB[16];
#pragma unroll
    for (int i = 0; i < 16; ++i) vA[i] = srcA ? *(const f32x4*)(srcA + (size_t)(k0A + 4 * i + kk) * ldA) : (f32x4){0.f, 0.f, 0.f, 0.f};
#pragma unroll
    for (int i = 0; i < 16; ++i) vB[i] = srcB ? *(const f32x4*)(srcB + (size_t)(k0B + 4 * i + kk) * ldB) : (f32x4){0.f, 0.f, 0.f, 0.f};
    bf16_t* WT = conv_dst(job, a->ws);
    const int c = lane & 7, nn = lane >> 3;
#pragma unroll
    for (int half = 0; half < 2; ++half) {
        if (half && !hasB) break;
#pragma unroll
        for (int i = 0; i < 16; ++i) { const f32x4 t = half ? vB[i] : vA[i]; LAS float* q = scr + (4 * i + kk) * 65 + 4 * n4; q[0] = t[0]; q[1] = t[1]; q[2] = t[2]; q[3] = t[3]; }
        LDS_WAIT();
        const int n0 = half ? n0B : n0A, k0 = half ? k0B : k0A;
#pragma unroll
        for (int j = 0; j < 8; ++j) { const int n = nn + 8 * j; const LAS float* q = scr + (8 * c) * 65 + n;
            u32x4 o; o.x = pk2(q[0 * 65], q[1 * 65]); o.y = pk2(q[2 * 65], q[3 * 65]); o.z = pk2(q[4 * 65], q[5 * 65]); o.w = pk2(q[6 * 65], q[7 * 65]);
            *(u32x4*)(WT + (size_t)(n0 + n) * K + k0 + 8 * c) = o; }
        LDS_WAIT();
    }
}
DI void conv_jobs_w(int jlo, int jhi, KArgs a, LAS unsigned char* lds, int pair0, int npair, int npairs, int wave, int lane) {
    LAS float* scr = (LAS float*)(lds + wave * 16640);
    for (int job = jlo; job < jhi; ++job) {
        int K, Nd; conv_dims(job, K, Nd);
        const int nit = (K / 64) * (Nd / 64);
        for (int it0 = 0; it0 < nit; it0 += 2 * npairs)
            for (int sl = 0; sl < npair; ++sl) { const int it = it0 + 2 * (pair0 + sl); if (it < nit) conv_pair(job, it, it + 1, it + 1 < nit, a, scr, lane); }
    }
}

DI int rcol(int q, int lane) { return 512 * (q >> 1) + 8 * lane + 4 * (q & 1); }
DI void row_load(f32x4 (&v)[8], const float* p, int lane) {
#pragma unroll
    for (int q = 0; q < 8; ++q) v[q] = *(const f32x4*)(p + rcol(q, lane));
}
DI void row_load_bf16(f32x4 (&v)[8], const bf16_t* p, int lane) {
#pragma unroll
    for (int j = 0; j < 4; ++j) { const u32x4 w = *(const u32x4*)(p + 512 * j + 8 * lane);
        v[2 * j] = (f32x4){bflo(w.x), bfhi(w.x), bflo(w.y), bfhi(w.y)}; v[2 * j + 1] = (f32x4){bflo(w.z), bfhi(w.z), bflo(w.w), bfhi(w.w)}; }
}
DI float row_rstd(const f32x4 (&v)[8]) {
    float s = 0.f;
#pragma unroll
    for (int j = 0; j < 8; ++j) s += (v[j][0] * v[j][0] + v[j][1] * v[j][1]) + (v[j][2] * v[j][2] + v[j][3] * v[j][3]);
    return rsqrtf(wave_sum(s) * (1.f / DM) + EPS);
}
DI void row_modulate_store(const f32x4 (&v)[8], float rstd, const float* g, const float* sh, const float* sc, bf16_t* o, int lane) {
#pragma unroll
    for (int j = 0; j < 4; ++j) { f32x4 r[2];
#pragma unroll
        for (int e = 0; e < 2; ++e) { const int c = rcol(2 * j + e, lane); const f32x4 gg = *(const f32x4*)(g + c), s1 = *(const f32x4*)(sh + c), s2 = *(const f32x4*)(sc + c);
            r[e] = (v[2 * j + e] * rstd * gg) * (s2 + 1.f) + s1; }
        u32x4 w; w.x = pk2(r[0][0], r[0][1]); w.y = pk2(r[0][2], r[0][3]); w.z = pk2(r[1][0], r[1][1]); w.w = pk2(r[1][2], r[1][3]);
        *(u32x4*)(o + 512 * j + 8 * lane) = w; }
}
DI void row_residual(f32x4 (&v)[8], const bf16_t* f, const float* xres, const float* gate, const float* pg, float wgt, float* xo, int lane) {
    f32x4 fv[8]; row_load_bf16(fv, f, lane); const float rs = row_rstd(fv);
#pragma unroll
    for (int j = 0; j < 8; ++j) { const int c = rcol(j, lane); const f32x4 xr = *(const f32x4*)(xres + c), gt = *(const f32x4*)(gate + c), pp = *(const f32x4*)(pg + c);
        v[j] = xr + (gt * wgt) * (fv[j] * rs * pp); *(f32x4*)(xo + c) = v[j]; }
}

#define MFMA32(a, b, c) __builtin_amdgcn_mfma_f32_32x32x16_bf16((a), (b), (c), 0, 0, 0)
DI int crow(int r, int hi) { return (r & 3) + 8 * (r >> 2) + 4 * hi; }
constexpr int KPITCH = 272, VPITCH = 136, KVBUF = 17408;
constexpr int AL_K = 0, AL_V = 2 * KVBUF, AL_IMP4 = 4 * KVBUF, AL_IMPS = AL_IMP4 + 32768, AL_SEL = AL_IMPS + 8192;
constexpr float NEGB = -1e30f;
struct KVRegs { u32x4 k0, k1, v0, v1; };
DI void kv_load(KVRegs& R, const bf16_t* Kt, const bf16_t* Vt, int vpitch, int tid) {
    const int c = tid, c2 = tid + 512;
    R.k0 = *(const u32x4*)(Kt + (c >> 4) * 128 + (c & 15) * 8); R.k1 = *(const u32x4*)(Kt + (c2 >> 4) * 128 + (c2 & 15) * 8);
    R.v0 = *(const u32x4*)(Vt + (size_t)(c >> 3) * vpitch + (c & 7) * 8); R.v1 = *(const u32x4*)(Vt + (size_t)(c2 >> 3) * vpitch + (c2 & 7) * 8);
}
DI void kv_store(const KVRegs& R, LAS unsigned char* KB, LAS unsigned char* VB, int tid) {
    const int c = tid, c2 = tid + 512;
    *(LAS u32x4*)(KB + (c >> 4) * KPITCH + (c & 15) * 16) = R.k0; *(LAS u32x4*)(KB + (c2 >> 4) * KPITCH + (c2 & 15) * 16) = R.k1;
    LAS unsigned char* p = VB + (c >> 3) * VPITCH + (c & 7) * 16; *(LAS u32x2*)p = (u32x2){R.v0.x, R.v0.y}; *(LAS u32x2*)(p + 8) = (u32x2){R.v0.z, R.v0.w};
    p = VB + (c2 >> 3) * VPITCH + (c2 & 7) * 16; *(LAS u32x2*)p = (u32x2){R.v1.x, R.v1.y}; *(LAS u32x2*)(p + 8) = (u32x2){R.v1.z, R.v1.w};
}
DI void qk_tile(f32x16& p0, f32x16& p1, const LAS unsigned char* KB, const bf16x8 (&qr)[8], int r, int hi) {
#pragma unroll
    for (int i = 0; i < 16; ++i) { p0[i] = 0.f; p1[i] = 0.f; }
#pragma unroll
    for (int d0 = 0; d0 < 8; ++d0) {
        const bf16x8 a0 = *(const LAS bf16x8*)(KB + r * KPITCH + d0 * 32 + hi * 16), a1 = *(const LAS bf16x8*)(KB + (32 + r) * KPITCH + d0 * 32 + hi * 16);
        p0 = MFMA32(a0, qr[d0], p0); p1 = MFMA32(a1, qr[d0], p1);
    }
}
DI bf16x8 pack8(const f32x16& p, int s2) {
    u32x4 w; w.x = pk2(p[8 * s2], p[8 * s2 + 1]); w.y = pk2(p[8 * s2 + 2], p[8 * s2 + 3]); w.z = pk2(p[8 * s2 + 4], p[8 * s2 + 5]); w.w = pk2(p[8 * s2 + 6], p[8 * s2 + 7]);
    return __builtin_bit_cast(bf16x8, w);
}
DI void pv_tile(f32x16 (&o)[4], const LAS unsigned char* VB, const f32x16& p0, const f32x16& p1, int r, int hi) {
#pragma unroll
    for (int kb = 0; kb < 2; ++kb)
#pragma unroll
        for (int s2 = 0; s2 < 2; ++s2) {
            const bf16x8 pf = pack8(kb ? p1 : p0, s2);
#pragma unroll
            for (int db = 0; db < 4; ++db) {
                const LAS unsigned char* base = VB + (32 * db + r) * VPITCH + (32 * kb + 16 * s2 + 4 * hi) * 2;
                const s16x4 lo = *(const LAS s16x4*)base, hh = *(const LAS s16x4*)(base + 16);
                const bf16x8 af = __builtin_shufflevector(lo, hh, 0, 1, 2, 3, 4, 5, 6, 7);
                o[db] = MFMA32(af, pf, o[db]);
            }
        }
}
constexpr float SCL = 0.08838834764831845f * 1.4426950408889634f;

DI void flash_step(f32x16 (&o)[4], float& mrun, float& lrun, const LAS unsigned char* KB, const LAS unsigned char* VB, const bf16x8 (&qr)[8],
                   int r, int hi, int qpos, int key0, bool rowok, bool need_c, bool need_w) {
    f32x16 p0, p1; qk_tile(p0, p1, KB, qr, r, hi);
    float mnew, alpha, ls = 0.f;
    if (!need_c && !need_w) {
        float mt = fmaxf(p0[0], p1[0]);
#pragma unroll
        for (int i = 1; i < 16; ++i) mt = fmaxf(mt, fmaxf(p0[i], p1[i]));
        mt = rowok ? mt * SCL : NEGB;
        mt = fmaxf(mt, __shfl_xor(mt, 32));
        mnew = fmaxf(mrun, mt);
        alpha = __builtin_amdgcn_exp2f(mrun - mnew);
        const float nb = rowok ? -mnew : NEGB;
#pragma unroll
        for (int i = 0; i < 16; ++i) {
            p0[i] = __builtin_amdgcn_exp2f(__builtin_fmaf(p0[i], SCL, nb));
            p1[i] = __builtin_amdgcn_exp2f(__builtin_fmaf(p1[i], SCL, nb));
            ls += p0[i] + p1[i];
        }
    } else {
        float mt = NEGB;
#pragma unroll
        for (int i = 0; i < 16; ++i) {
            const int k0 = key0 + crow(i, hi), k1 = k0 + 32;
            bool v0 = rowok, v1 = rowok;
            if (need_c) { v0 = v0 && (k0 <= qpos); v1 = v1 && (k1 <= qpos); }
            if (need_w) { v0 = v0 && (k0 > qpos - 512); v1 = v1 && (k1 > qpos - 512); }
            p0[i] = v0 ? p0[i] * SCL : NEGB; p1[i] = v1 ? p1[i] * SCL : NEGB;
            mt = fmaxf(mt, fmaxf(p0[i], p1[i]));
        }
        mt = fmaxf(mt, __shfl_xor(mt, 32));
        mnew = fmaxf(mrun, mt);
        alpha = __builtin_amdgcn_exp2f(mrun - mnew);
#pragma unroll
        for (int i = 0; i < 16; ++i) {
            p0[i] = __builtin_amdgcn_exp2f(p0[i] - mnew);
            p1[i] = __builtin_amdgcn_exp2f(p1[i] - mnew);
            ls += p0[i] + p1[i];
        }
    }
    lrun = lrun * alpha + ls;
    if (__any(mnew > mrun)) {
#pragma unroll
        for (int db = 0; db < 4; ++db)
#pragma unroll
            for (int i = 0; i < 16; ++i) o[db][i] *= alpha;
    }
    mrun = mnew;
    pv_tile(o, VB, p0, p1, r, hi);
}

DI void nsa_unit(int bg, int qblk, unsigned char* ws, LAS unsigned char* lds) {
    const int tid = otid(), lane = tid & 63, r = lane & 31, hi = lane >> 5, wave = __builtin_amdgcn_readfirstlane(tid >> 6);
    const int b = bg >> 2, g = bg & 3, head = g * 4 + (wave >> 1), q0 = qblk * 64, qw0 = q0 + 32 * (wave & 1), qpos = qw0 + r;
    const size_t trow = (size_t)b * SEQ + qpos;
    const bf16_t* Qp = (const bf16_t*)(ws + WS_Q) + trow * DM + head * 128;
    bf16_t* Op = (bf16_t*)(ws + WS_XA) + trow * DM + head * 128;
    bf16x8 qr[8];
#pragma unroll
    for (int d0 = 0; d0 < 8; ++d0) qr[d0] = *(const bf16x8*)(Qp + d0 * 16 + hi * 8);
    const float* ngp = (const float*)(ws + WS_NG) + trow * 48 + head * 3;
    const float g0 = ngp[0], g1 = ngp[1], g2 = ngp[2];
    LAS unsigned char* KB0 = lds + AL_K; LAS unsigned char* VB0 = lds + AL_V;
    LAS float* IMP4 = (LAS float*)(lds + AL_IMP4); LAS float* IMPS = (LAS float*)(lds + AL_IMPS); LAS unsigned* SEL = (LAS unsigned*)(lds + AL_SEL);
    unsigned opk[4][8];
    KVRegs R;
    {
        const bf16_t* kc = (const bf16_t*)(ws + WS_KCC) + (size_t)bg * 128 * 128;
        const bf16_t* vct = (const bf16_t*)(ws + WS_VCT) + (size_t)bg * 128 * 128;
        { KVRegs R2; kv_load(R, kc, vct, 128, tid); kv_load(R2, kc + 64 * 128, vct + 64, 128, tid);
          kv_store(R, KB0, VB0, tid); kv_store(R2, KB0 + KVBUF, VB0 + KVBUF, tid); }
        if (tid < 65) SEL[tid] = 0u;
        __syncthreads();
        f32x16 pa0, pa1, pb0, pb1;
        qk_tile(pa0, pa1, KB0, qr, r, hi); qk_tile(pb0, pb1, KB0 + KVBUF, qr, r, hi);
        float mt = NEGB;
#pragma unroll
        for (int i = 0; i < 16; ++i) {
            const int n = crow(i, hi);
            pa0[i] = (16 * n + 31 <= qpos) ? pa0[i] * SCL : NEGB; pa1[i] = (16 * (n + 32) + 31 <= qpos) ? pa1[i] * SCL : NEGB;
            pb0[i] = (16 * (n + 64) + 31 <= qpos) ? pb0[i] * SCL : NEGB; pb1[i] = (16 * (n + 96) + 31 <= qpos) ? pb1[i] * SCL : NEGB;
            mt = fmaxf(fmaxf(mt, fmaxf(pa0[i], pa1[i])), fmaxf(pb0[i], pb1[i]));
        }
        mt = fmaxf(mt, __shfl_xor(mt, 32));
        float ls = 0.f;
#pragma unroll
        for (int i = 0; i < 16; ++i) {
            pa0[i] = (pa0[i] > -1e29f) ? __builtin_amdgcn_exp2f(pa0[i] - mt) : 0.f; pa1[i] = (pa1[i] > -1e29f) ? __builtin_amdgcn_exp2f(pa1[i] - mt) : 0.f;
            pb0[i] = (pb0[i] > -1e29f) ? __builtin_amdgcn_exp2f(pb0[i] - mt) : 0.f; pb1[i] = (pb1[i] > -1e29f) ? __builtin_amdgcn_exp2f(pb1[i] - mt) : 0.f;
            ls += (pa0[i] + pa1[i]) + (pb0[i] + pb1[i]);
        }
        ls += __shfl_xor(ls, 32);
        const float inv = ls > 0.f ? 1.f / ls : 0.f;
#pragma unroll
        for (int i = 0; i < 16; ++i) { pa0[i] *= inv; pa1[i] *= inv; pb0[i] *= inv; pb1[i] *= inv; }
        if (qblk >= 16) {
            LAS float* ip = IMP4 + ((wave >> 1) * 64 + 32 * (wave & 1) + r) * 32;
#define IMP_G(P, blk) _Pragma("unroll") for (int g4 = 0; g4 < 4; ++g4) ip[8 * (blk) + 2 * g4 + hi] = (P[4 * g4] + P[4 * g4 + 1]) + (P[4 * g4 + 2] + P[4 * g4 + 3]);
            IMP_G(pa0, 0) IMP_G(pa1, 1) IMP_G(pb0, 2) IMP_G(pb1, 3)
            LDS_WAIT();
#define IMP_L(P, blk) _Pragma("unroll") for (int g4 = 0; g4 < 4; ++g4) { const int j1 = 8 * (blk) + 2 * g4 + hi + 1; if (j1 < 32) ip[j1] += P[4 * g4 + 3]; }
            IMP_L(pa0, 0) IMP_L(pa1, 1) IMP_L(pb0, 2) IMP_L(pb1, 3)
#undef IMP_G
#undef IMP_L
        }
        f32x16 oc[4];
#pragma unroll
        for (int db = 0; db < 4; ++db)
#pragma unroll
            for (int i = 0; i < 16; ++i) oc[db][i] = 0.f;
        pv_tile(oc, VB0, pa0, pa1, r, hi); pv_tile(oc, VB0 + KVBUF, pb0, pb1, r, hi);
#pragma unroll
        for (int db = 0; db < 4; ++db)
#pragma unroll
            for (int i = 0; i < 8; ++i) opk[db][i] = pk2(oc[db][2 * i] * g0, oc[db][2 * i + 1] * g0);
    }
    __syncthreads();
    if (qblk >= 16) {
#pragma unroll
        for (int e = 0; e < 4; ++e) { const int idx = tid + 512 * e; IMPS[idx] = (IMP4[idx] + IMP4[2048 + idx]) + (IMP4[4096 + idx] + IMP4[6144 + idx]); }
        __syncthreads();
        const int q = tid >> 3;
        float val[32];
#pragma unroll
        for (int j4 = 0; j4 < 8; ++j4) { const f32x4 t4 = *(const LAS f32x4*)(IMPS + q * 32 + 4 * j4); val[4 * j4] = t4[0]; val[4 * j4 + 1] = t4[1]; val[4 * j4 + 2] = t4[2]; val[4 * j4 + 3] = t4[3]; }
        unsigned bits = 0u;
#pragma unroll
        for (int e = 0; e < 4; ++e) {
            const int j = (tid & 7) * 4 + e;
            float vj = 0.f;
#pragma unroll
            for (int i = 0; i < 32; ++i) vj = (i == j) ? val[i] : vj;
            int rank = 0;
#pragma unroll
            for (int i = 1; i < 32; ++i) { const bool cand = (i <= qblk - 2); rank += (cand && (val[i] > vj || (val[i] == vj && i < j))) ? 1 : 0; }
            const bool forced = (j == 0) || (j == qblk) || (j == qblk - 1);
            const bool sel = forced || (j >= 1 && j <= qblk - 2 && rank < 13);
            bits |= sel ? (1u << j) : 0u;
        }
        __hip_atomic_fetch_or(SEL + q, bits, __ATOMIC_RELAXED, __HIP_MEMORY_SCOPE_WORKGROUP);
        __syncthreads();
    } else {
        if (tid < 64) SEL[tid] = (2u << qblk) - 1u;
        __syncthreads();
    }
    if (tid < 64) { unsigned v = SEL[tid];
#pragma unroll
        for (int o = 1; o < 64; o <<= 1) v |= __shfl_xor(v, o);
        if (tid == 0) SEL[64] = v; }
    __syncthreads();
    const unsigned mysel = SEL[32 * (wave & 1) + r];
    unsigned uni = (unsigned)__builtin_amdgcn_readfirstlane(SEL[64]) & ((2u << qblk) - 1u);
#pragma unroll 1
    for (int mode = 0; mode < 2; ++mode) {
        const bf16_t* Kg = (const bf16_t*)(ws + (mode ? WS_KW : WS_KS)) + (size_t)bg * SEQ * 128;
        const bf16_t* Vg = (const bf16_t*)(ws + (mode ? WS_VWT : WS_VST)) + (size_t)bg * 128 * SEQ;
        unsigned todo;
        if (mode) { const int jlo = qblk >= 8 ? qblk - 8 : 0; todo = ((2u << qblk) - 1u) & ~((1u << jlo) - 1u); } else todo = uni;
        f32x16 o[4];
#pragma unroll
        for (int db = 0; db < 4; ++db)
#pragma unroll
            for (int i = 0; i < 16; ++i) o[db][i] = 0.f;
        float mrun = -1e20f, lrun = 0.f;
        int cur = __builtin_ctz(todo); todo &= todo - 1u;
        kv_load(R, Kg + (size_t)cur * 64 * 128, Vg + cur * 64, SEQ, tid); kv_store(R, KB0, VB0, tid);
        int bi = 0;
        for (;;) {
            __syncthreads();
            const int nxt = todo ? __builtin_ctz(todo) : -1; todo &= todo - 1u;
            if (nxt >= 0) kv_load(R, Kg + (size_t)nxt * 64 * 128, Vg + nxt * 64, SEQ, tid);
            const int key0 = cur * 64;
            const bool rowok = mode ? true : (((mysel >> cur) & 1u) != 0u);
            const bool need_c = (key0 + 63 > qw0), need_w = mode && (key0 <= qw0 + 31 - 512);
            const bool wave_skip = mode ? (key0 + 63 <= qw0 - 512) : !__any(rowok);
            if (!wave_skip) flash_step(o, mrun, lrun, KB0 + bi * KVBUF, VB0 + bi * KVBUF, qr, r, hi, qpos, key0, rowok, need_c, need_w);
            if (nxt < 0) break;
            kv_store(R, KB0 + (bi ^ 1) * KVBUF, VB0 + (bi ^ 1) * KVBUF, tid);
            bi ^= 1; cur = nxt;
        }
        __syncthreads();
        lrun += __shfl_xor(lrun, 32);
        const float sc = (mode ? g2 : g1) / lrun;
#pragma unroll
        for (int db = 0; db < 4; ++db)
#pragma unroll
            for (int i = 0; i < 8; ++i) opk[db][i] = pk2(bflo(opk[db][i]) + o[db][2 * i] * sc, bfhi(opk[db][i]) + o[db][2 * i + 1] * sc);
    }
#pragma unroll
    for (int db = 0; db < 4; ++db)
#pragma unroll
        for (int g4 = 0; g4 < 4; ++g4) { u32x2 w; w.x = opk[db][2 * g4]; w.y = opk[db][2 * g4 + 1];
            *(u32x2*)(Op + 32 * db + 8 * g4 + 4 * hi) = w; }
}

#define NOINL __forceinline__
#define LDS_PTR() ((LAS unsigned char*)lds_raw)
extern __shared__ __attribute__((aligned(16))) unsigned char lds_raw[];

NOINL __device__ void ph_ffn_up(unsigned char* ws) {
    pg8::Gemm g{(const bf16_t*)(ws + WS_U), (const bf16_t*)(ws + WS_WGU), DM, DM, DM}; pg8::Sched S; S.init(64, 44, gridDim.x, blockIdx.x, 256L * DM * 2, 256L * DM * 2);
    EpiFFN E{(bf16_t*)(ws + WS_H)}; pg8::gemm_phase(LDS_PTR(), g, S, E);
}
NOINL __device__ void ph_ffn_down(unsigned char* ws) {
    pg8::Gemm g{(const bf16_t*)(ws + WS_H), (const bf16_t*)(ws + WS_WD), DFF, DFF, DFF}; pg8::Sched S; S.init(64, 8, gridDim.x, blockIdx.x, 256L * DFF * 2, 256L * DFF * 2);
    EpiBf E{(bf16_t*)(ws + WS_F)}; pg8::gemm_phase(LDS_PTR(), g, S, E);
}
NOINL __device__ void ph_inproj(unsigned char* ws) {
    pg8::Gemm g{(const bf16_t*)(ws + WS_U), (const bf16_t*)(ws + WS_WIN), DM, DM, DM}; pg8::Sched S; S.init(64, 49, gridDim.x, blockIdx.x, 256L * DM * 2, 256L * DM * 2);
    EpiIn E{ws, (const float*)(ws + WS_ROPE)}; pg8::gemm_phase(LDS_PTR(), g, S, E);
}
NOINL __device__ void ph_vt(unsigned char* ws) {
    pg8::Gemm g{(const bf16_t*)(ws + WS_WV), (const bf16_t*)(ws + WS_U), DM, DM, DM}; pg8::Sched S; S.init(4, 64, gridDim.x, blockIdx.x, 256L * DM * 2, 256L * DM * 2);
    EpiVT E{(bf16_t*)(ws + WS_VST), (bf16_t*)(ws + WS_VWT)}; pg8::gemm_phase(LDS_PTR(), g, S, E);
}
NOINL __device__ void ph_cmp1(unsigned char* ws) {
    pg8::Gemm g{(const bf16_t*)(ws + WS_KC), (const bf16_t*)(ws + WS_W1T), 2048, 4096, 512}; pg8::Sched S; S.init(16, 16, gridDim.x, blockIdx.x, 0, 0); S.mode = 1; S.srcstride = (long)(WS_VC - WS_KC);
    EpiPart E{(float*)(ws + WS_PART)}; pg8::gemm_phase(LDS_PTR(), g, S, E);
}
NOINL __device__ void ph_ya(unsigned char* ws) {
    pg8::Gemm g{(const bf16_t*)(ws + WS_HG), (const bf16_t*)(ws + WS_WA), DM, DM, DM}; pg8::Sched S; S.init(64, 8, gridDim.x, blockIdx.x, 256L * DM * 2, 256L * DM * 2);
    EpiGate E{(const bf16_t*)(ws + WS_MG), nullptr, (bf16_t*)(ws + WS_Q), 0}; pg8::gemm_phase(LDS_PTR(), g, S, E);
}
NOINL __device__ void ph_yb(unsigned char* ws) {
    pg8::Gemm g{(const bf16_t*)(ws + WS_XA), (const bf16_t*)(ws + WS_WB), DM, DM, DM}; pg8::Sched S; S.init(64, 8, gridDim.x, blockIdx.x, 256L * DM * 2, 256L * DM * 2);
    EpiGate E{(const bf16_t*)(ws + WS_MG), (const bf16_t*)(ws + WS_Q), (bf16_t*)(ws + WS_U), 1}; pg8::gemm_phase(LDS_PTR(), g, S, E);
}
NOINL __device__ void ph_out(unsigned char* ws) {
    pg8::Gemm g{(const bf16_t*)(ws + WS_U), (const bf16_t*)(ws + WS_WO), DM, DM, DM}; pg8::Sched S; S.init(64, 8, gridDim.x, blockIdx.x, 256L * DM * 2, 256L * DM * 2);
    EpiBf E{(bf16_t*)(ws + WS_FMIX)}; pg8::gemm_phase(LDS_PTR(), g, S, E);
}
NOINL __device__ void ph_cmp2(unsigned char* ws) {
    const int tid = otid(), lane = tid & 63, wave = __builtin_amdgcn_readfirstlane(tid >> 6), bx = blockIdx.x;
    if (wave >= 4 || bx >= 256) return;
    const int src = bx >> 7, rt = bx & 127;
    const int r = lane & 31, hh = lane >> 5;
    const float* P = (const float*)(ws + WS_PART); const float* peb = (const float*)(ws + WS_PEB) + src * 128;
    const bf16_t* w2t = (const bf16_t*)(ws + WS_W2T) + (size_t)src * 128 * 128;
    f32x16 acc;
#pragma unroll
    for (int i = 0; i < 16; ++i) acc[i] = 0.f;
#pragma unroll 2
    for (int st = 0; st < 8; ++st) {
        const int k0 = 16 * st + 8 * hh; float a[8];
#pragma unroll
        for (int e = 0; e < 8; ++e) a[e] = peb[k0 + e];
#pragma unroll
        for (int ks = 0; ks < 8; ++ks) { const float* pp = P + ((size_t)((ks * 2 + src) * 4096 + rt * 32 + r)) * 128 + k0;
            const f32x4 x0 = *(const f32x4*)pp, x1 = *(const f32x4*)(pp + 4); a[0] += x0[0]; a[1] += x0[1]; a[2] += x0[2]; a[3] += x0[3]; a[4] += x1[0]; a[5] += x1[1]; a[6] += x1[2]; a[7] += x1[3]; }
        u32x4 w; w.x = pk2(gelu_t(a[0]), gelu_t(a[1])); w.y = pk2(gelu_t(a[2]), gelu_t(a[3])); w.z = pk2(gelu_t(a[4]), gelu_t(a[5])); w.w = pk2(gelu_t(a[6]), gelu_t(a[7]));
        const bf16x8 af = __builtin_bit_cast(bf16x8, w);
        const bf16x8 bfr = *(const bf16x8*)(w2t + (size_t)(32 * wave + r) * 128 + k0);
        acc = MFMA32(af, bfr, acc);
    }
#pragma unroll
    for (int i = 0; i < 16; ++i) {
        const int R = rt * 32 + crow(i, hh), nrow = R & 127, bgi = R >> 7, d = 32 * wave + r;
        const float v = (nrow == 127) ? 0.f : acc[i];
        const bf16_t o = (bf16_t)(pk2(v, 0.f) & 0xffffu);
        if (src == 0) ((bf16_t*)(ws + WS_KCC))[(size_t)R * 128 + d] = o;
        else ((bf16_t*)(ws + WS_VCT))[((size_t)bgi * 128 + d) * 128 + nrow] = o;
    }
}
NOINL __device__ void ph_lru_gates(unsigned char* ws, const float* conv_w, const float* conv_b, const float* lbr, const float* lbi, const float* llam) {
    const int tid = otid(), lane = tid & 63, wave = __builtin_amdgcn_readfirstlane(tid >> 6), bx = blockIdx.x, G = gridDim.x;
    LAS unsigned char* lds = LDS_PTR();
    const int h = bx & 15, cuh = bx >> 4, nch = G >> 4;
    LAS unsigned char* WL = lds; LAS unsigned char* XS = lds + 69632 + wave * 8704; LAS float* CW = (LAS float*)(lds + 139264);
    const bf16_t* wri = (const bf16_t*)(ws + WS_WRI) + (size_t)h * 256 * 128;
#pragma unroll
    for (int e = 0; e < 8; ++e) { const int c = tid + 512 * e; *(LAS u32x4*)(WL + (c >> 4) * 272 + (c & 15) * 16) = *(const u32x4*)(wri + (c >> 4) * 128 + (c & 15) * 8); }
    if (tid < 128) { const int ch = h * 128 + tid;
        CW[tid] = conv_w[ch]; CW[128 + tid] = conv_w[DM + ch]; CW[256 + tid] = conv_w[2 * DM + ch]; CW[384 + tid] = conv_w[3 * DM + ch];
        CW[512 + tid] = conv_b[ch]; CW[640 + tid] = lbr[ch]; CW[768 + tid] = lbi[ch];
        const float lam = llam[ch], ex = __expf(-lam);
        CW[896 + tid] = (ex < 0.03f) ? ex * (1.f - ex * (0.5f - ex * (0.33333333f - ex * (0.25f - ex * 0.2f)))) : __logf(1.f + ex); }
    __syncthreads();
    const int r = lane & 31, hh = lane >> 5;
    const bf16_t* XA = (const bf16_t*)(ws + WS_XA); bf16_t* LA = (bf16_t*)(ws + WS_U); bf16_t* BBp = (bf16_t*)(ws + WS_BB);
#pragma unroll 1
    for (int rt = cuh * 8 + wave; rt < T / 32; rt += nch * 8) {
        const int t0 = rt * 32, tok = t0 + r, s = tok & 2047;
        bf16x8 af[8];
#pragma unroll
        for (int st = 0; st < 8; ++st) {
            const int ch0 = 16 * st + 8 * hh; float xc[8];
#pragma unroll
            for (int e = 0; e < 8; ++e) xc[e] = CW[512 + ch0 + e];
#pragma unroll
            for (int j = 0; j < 4; ++j) { if (s - 3 + j >= 0) { const u32x4 xv = *(const u32x4*)(XA + ((size_t)(((tok >> 11) * 16 + h) * 2048 + (s - 3 + j))) * 128 + ch0);
                xc[0] += CW[j * 128 + ch0 + 0] * bflo(xv.x); xc[1] += CW[j * 128 + ch0 + 1] * bfhi(xv.x); xc[2] += CW[j * 128 + ch0 + 2] * bflo(xv.y); xc[3] += CW[j * 128 + ch0 + 3] * bfhi(xv.y);
                xc[4] += CW[j * 128 + ch0 + 4] * bflo(xv.z); xc[5] += CW[j * 128 + ch0 + 5] * bfhi(xv.z); xc[6] += CW[j * 128 + ch0 + 6] * bflo(xv.w); xc[7] += CW[j * 128 + ch0 + 7] * bfhi(xv.w); } }
            u32x4 w; w.x = pk2(xc[0], xc[1]); w.y = pk2(xc[2], xc[3]); w.z = pk2(xc[4], xc[5]); w.w = pk2(xc[6], xc[7]);
            af[st] = __builtin_bit_cast(bf16x8, w);
            *(LAS u32x4*)(XS + r * 272 + ch0 * 2) = w;
            if (st & 1) asm volatile("" ::: "memory");
        }
        LDS_WAIT();
#pragma unroll 1
        for (int cb = 0; cb < 4; ++cb) {
            f32x16 aR, aI;
#pragma unroll
            for (int i = 0; i < 16; ++i) { aR[i] = 0.f; aI[i] = 0.f; }
#pragma unroll
            for (int st = 0; st < 8; ++st) {
                const bf16x8 bR = *(const LAS bf16x8*)(WL + (32 * cb + r) * 272 + st * 32 + hh * 16), bI = *(const LAS bf16x8*)(WL + (128 + 32 * cb + r) * 272 + st * 32 + hh * 16);
                aR = MFMA32(af[st], bR, aR); aI = MFMA32(af[st], bI, aI);
            }
            const int ch = 32 * cb + r; const float br_ = CW[640 + ch], bi_ = CW[768 + ch], sp_ = CW[896 + ch];
#pragma unroll
            for (int i = 0; i < 16; ++i) {
                const int tk = crow(i, hh);
                const float rr = sigm(aR[i] + br_), ig = sigm(aI[i] + bi_), la = -8.f * rr * sp_;
                const float xcv = bf2f(*(const LAS bf16_t*)(XS + tk * 272 + ch * 2));
                const float bm = sqrtf(fmaxf(1.f - __expf(2.f * la), 0.f)) * ig * xcv;
                const int tkn = t0 + tk;
                const size_t o = ((size_t)(((tkn >> 11) * 32 + h * 2 + (cb >> 1)) * 2048 + (tkn & 2047))) * 64 + (cb & 1) * 32 + r;
                LA[o] = (bf16_t)(pk2(la, 0.f) & 0xffffu); BBp[o] = (bf16_t)(pk2(bm, 0.f) & 0xffffu);
            }
        }
        LDS_WAIT();
    }
}
NOINL __device__ void ph_scan(unsigned char* ws) {
    const int tid = otid(), lane = tid & 63, wave = __builtin_amdgcn_readfirstlane(tid >> 6), bx = blockIdx.x, G = gridDim.x;
    LAS float* car = (LAS float*)LDS_PTR();
    const bf16_t* LA = (const bf16_t*)(ws + WS_U); const bf16_t* BBp = (const bf16_t*)(ws + WS_BB); const bf16_t* GY = (const bf16_t*)(ws + WS_GY); bf16_t* HG = (bf16_t*)(ws + WS_HG);
    for (int unit = bx; unit < 256; unit += G) {
        const int b = unit >> 5, ch = (unit & 31) * 64 + lane;
        const size_t bbase = (size_t)unit * 2048 * 64 + lane;
        float hcarry = 0.f;
#pragma unroll 1
        for (int rd = 0; rd < 8; ++rd) {
            const size_t base = ((size_t)b * SEQ + rd * 256 + wave * 32) * DM + ch;
            float la[32], bb[32], gy[32];
#pragma unroll
            for (int e = 0; e < 32; ++e) { const size_t o = bbase + (size_t)(rd * 256 + wave * 32 + e) * 64; la[e] = bf2f(LA[o]); bb[e] = bf2f(BBp[o]); gy[e] = bf2f(GY[o]); }
            float hst = 0.f;
#pragma unroll
            for (int e = 0; e < 32; ++e) { la[e] = __expf(la[e]); hst = la[e] * hst + bb[e]; }
            float aprod = 1.f;
#pragma unroll
            for (int e = 0; e < 32; ++e) aprod *= la[e];
            LAS float* cb = car + (rd & 1) * 1024;
            cb[(wave * 2) * 64 + lane] = aprod; cb[(wave * 2 + 1) * 64 + lane] = hst;
            __syncthreads();
            float hin = hcarry, myhin = 0.f;
#pragma unroll
            for (int w = 0; w < 8; ++w) { if (w == wave) myhin = hin; hin = cb[(w * 2) * 64 + lane] * hin + cb[(w * 2 + 1) * 64 + lane]; }
            hcarry = hin; hst = myhin;
#pragma unroll
            for (int e = 0; e < 32; ++e) { hst = la[e] * hst + bb[e]; HG[base + (size_t)e * DM] = (bf16_t)(pk2(hst * gy[e], 0.f) & 0xffffu); }
        }
        __syncthreads();
    }
}
NOINL __device__ void ph_lru_fused(unsigned char* ws, const float* conv_w, const float* conv_b, const float* lbr, const float* lbi, const float* llam) {
    const int tid = otid(), lane = tid & 63, wave = __builtin_amdgcn_readfirstlane(tid >> 6), bx = blockIdx.x, G = gridDim.x;
    LAS unsigned char* lds = LDS_PTR();
    LAS unsigned char* WL = lds; LAS float* CW = (LAS float*)(lds + 34816); LAS unsigned char* XS = lds + 38912 + wave * 8704; LAS float* car = (LAS float*)(lds + 108544);
    const int r = lane & 31, hh = lane >> 5;
    const bf16_t* XA = (const bf16_t*)(ws + WS_XA); const bf16_t* GY = (const bf16_t*)(ws + WS_GY); bf16_t* HG = (bf16_t*)(ws + WS_HG);
#pragma unroll 1
    for (int unit = bx; unit < 256; unit += G) {
        const int b = unit >> 5, cgp = unit & 31, h = cgp >> 1, hf = cgp & 1;
        __syncthreads();
        {
            const bf16_t* wri = (const bf16_t*)(ws + WS_WRI) + (size_t)h * 256 * 128;
#pragma unroll
            for (int e = 0; e < 4; ++e) { const int c = tid + 512 * e, row = c >> 4, srow = (row < 64) ? hf * 64 + row : 128 + hf * 64 + (row - 64);
                *(LAS u32x4*)(WL + row * 272 + (c & 15) * 16) = *(const u32x4*)(wri + srow * 128 + (c & 15) * 8); }
            if (tid < 128) { const int ch = h * 128 + tid; CW[tid] = conv_w[ch]; CW[128 + tid] = conv_w[DM + ch]; CW[256 + tid] = conv_w[2 * DM + ch]; CW[384 + tid] = conv_w[3 * DM + ch]; CW[512 + tid] = conv_b[ch]; }
            if (tid < 64) { const int ch = h * 128 + hf * 64 + tid; CW[640 + tid] = lbr[ch]; CW[704 + tid] = lbi[ch];
                const float lam = llam[ch], ex = __expf(-lam);
                CW[768 + tid] = (ex < 0.03f) ? ex * (1.f - ex * (0.5f - ex * (0.33333333f - ex * (0.25f - ex * 0.2f)))) : __logf(1.f + ex); }
        }
        __syncthreads();
        const bf16_t* XAb = XA + (size_t)(b * 16 + h) * 2048 * 128;
        const bf16_t* GYb = GY + (size_t)unit * 2048 * 64;
        float hcar0 = 0.f, hcar1 = 0.f;
#pragma unroll 1
        for (int rd = 0; rd < 8; ++rd) {
            const int t0 = rd * 256 + wave * 32, s = t0 + r;
            bf16_t gyr[2][16];
#pragma unroll
            for (int cb = 0; cb < 2; ++cb)
#pragma unroll
                for (int i = 0; i < 16; ++i) gyr[cb][i] = GYb[(size_t)(t0 + crow(i, hh)) * 64 + 32 * cb + r];
            bf16x8 af[8];
            {
                u32x4 xv[8][4];
#pragma unroll
                for (int st = 0; st < 8; ++st)
#pragma unroll
                    for (int j = 0; j < 4; ++j) { const int sp = s - 3 + j; xv[st][j] = *(const u32x4*)(XAb + (size_t)(sp < 0 ? 0 : sp) * 128 + 16 * st + 8 * hh); }
#pragma unroll
                for (int st = 0; st < 8; ++st) {
                    const int ch0 = 16 * st + 8 * hh; float xc[8];
#pragma unroll
                    for (int e = 0; e < 8; ++e) xc[e] = CW[512 + ch0 + e];
#pragma unroll
                    for (int j = 0; j < 4; ++j) { const float ok = (s - 3 + j >= 0) ? 1.f : 0.f; const u32x4 x4 = xv[st][j];
                        xc[0] += ok * CW[j * 128 + ch0 + 0] * bflo(x4.x); xc[1] += ok * CW[j * 128 + ch0 + 1] * bfhi(x4.x); xc[2] += ok * CW[j * 128 + ch0 + 2] * bflo(x4.y); xc[3] += ok * CW[j * 128 + ch0 + 3] * bfhi(x4.y);
                        xc[4] += ok * CW[j * 128 + ch0 + 4] * bflo(x4.z); xc[5] += ok * CW[j * 128 + ch0 + 5] * bfhi(x4.z); xc[6] += ok * CW[j * 128 + ch0 + 6] * bflo(x4.w); xc[7] += ok * CW[j * 128 + ch0 + 7] * bfhi(x4.w); }
                    u32x4 w; w.x = pk2(xc[0], xc[1]); w.y = pk2(xc[2], xc[3]); w.z = pk2(xc[4], xc[5]); w.w = pk2(xc[6], xc[7]);
                    af[st] = __builtin_bit_cast(bf16x8, w);
                    *(LAS u32x4*)(XS + r * 272 + ch0 * 2) = w;
                }
            }
            LDS_WAIT();
            float av[2][16], bv[2][16];
#pragma unroll
            for (int cb = 0; cb < 2; ++cb) {
                f32x16 aR, aI;
#pragma unroll
                for (int i = 0; i < 16; ++i) { aR[i] = 0.f; aI[i] = 0.f; }
#pragma unroll
                for (int st = 0; st < 8; ++st) {
                    const bf16x8 bR = *(const LAS bf16x8*)(WL + (32 * cb + r) * 272 + st * 32 + hh * 16), bI = *(const LAS bf16x8*)(WL + (64 + 32 * cb + r) * 272 + st * 32 + hh * 16);
                    aR = MFMA32(af[st], bR, aR); aI = MFMA32(af[st], bI, aI);
                }
                const int chl = 32 * cb + r; const float br_ = CW[640 + chl], bi_ = CW[704 + chl], sp_ = CW[768 + chl];
#pragma unroll
                for (int i = 0; i < 16; ++i) {
                    const float rr = sigm(aR[i] + br_), ig = sigm(aI[i] + bi_), a = __expf(-8.f * rr * sp_);
                    const float xcv = bf2f(*(const LAS bf16_t*)(XS + crow(i, hh) * 272 + (hf * 64 + chl) * 2));
                    av[cb][i] = a; bv[cb][i] = __builtin_amdgcn_sqrtf(fmaxf(1.f - a * a, 0.f)) * ig * xcv;
                }
            }
            float GA[2][4], GB[2][4], PA[2][4], PB[2][4];
#pragma unroll
            for (int cb = 0; cb < 2; ++cb)
#pragma unroll
                for (int g = 0; g < 4; ++g) {
                    float A = av[cb][4 * g], B = bv[cb][4 * g];
#pragma unroll
                    for (int e = 1; e < 4; ++e) { B = av[cb][4 * g + e] * B + bv[cb][4 * g + e]; A *= av[cb][4 * g + e]; }
                    GA[cb][g] = A; GB[cb][g] = B; PA[cb][g] = __shfl_xor(A, 32); PB[cb][g] = __shfl_xor(B, 32);
                }
            LAS float* cbuf = car + (rd & 1) * 1024;
#pragma unroll
            for (int cb = 0; cb < 2; ++cb) {
                float A = 1.f, B = 0.f;
#pragma unroll
                for (int g = 0; g < 4; ++g) {
                    const float A0 = hh ? PA[cb][g] : GA[cb][g], B0 = hh ? PB[cb][g] : GB[cb][g], A1 = hh ? GA[cb][g] : PA[cb][g], B1 = hh ? GB[cb][g] : PB[cb][g];
                    B = A0 * B + B0; A *= A0; B = A1 * B + B1; A *= A1;
                }
                if (hh == 0) { cbuf[(wave * 2) * 64 + 32 * cb + r] = A; cbuf[(wave * 2 + 1) * 64 + 32 * cb + r] = B; }
            }
            __syncthreads();
#pragma unroll
            for (int cb = 0; cb < 2; ++cb) {
                float hin = cb ? hcar1 : hcar0, myhin = 0.f;
#pragma unroll
                for (int w = 0; w < 8; ++w) { if (w == wave) myhin = hin; hin = cbuf[(w * 2) * 64 + 32 * cb + r] * hin + cbuf[(w * 2 + 1) * 64 + 32 * cb + r]; }
                if (cb) hcar1 = hin; else hcar0 = hin;
                float hrun = myhin;
#pragma unroll
                for (int g = 0; g < 4; ++g) {
                    if (hh) hrun = PA[cb][g] * hrun + PB[cb][g];
                    float hv = hrun;
#pragma unroll
                    for (int e = 0; e < 4; ++e) { const int i = 4 * g + e; hv = av[cb][i] * hv + bv[cb][i];
                        HG[((size_t)b * SEQ + t0 + crow(i, hh)) * DM + h * 128 + hf * 64 + 32 * cb + r] = (bf16_t)(pk2(hv * bf2f(gyr[cb][i]), 0.f) & 0xffffu); }
                    hrun = hv;
                    if (!hh) hrun = PA[cb][g] * hrun + PB[cb][g];
                }
            }
        }
    }
}
NOINL __device__ void ph_nsa(unsigned char* ws) {
    const int bx = blockIdx.x, G = gridDim.x;
    const int vcu = (G % 8 == 0) ? (bx % 8) * (G / 8) + bx / 8 : bx;
#pragma unroll 1
    for (int uu = vcu; uu < 1024; uu += G) {
        const int pr = uu & 255, it = uu >> 8, bg = pr >> 3, s = pr & 7;
        const int qblk = (it == 0) ? s : (it == 1) ? 15 - s : (it == 2) ? 16 + s : 31 - s;
        nsa_unit(bg, qblk, ws, LDS_PTR());
    }
}

constexpr size_t WS_BAR = 960 * 1024;
constexpr int LDS_BARST = LDS_BYTES - 16;
#define XB_TMO      128
#define XB_XCNT(j)  (256  + 64 * (j))
#define XB_XSUB(j)  (1280 + 64 * (j))
#define XB_XGEN(j)  (2304 + 64 * (j))
#define XB_TOP      3328
#define XB_TOPGEN   3392
#define XCD_BAR_WORDS 3456
#define XB_SPIN_CAP (1u << 18)
DI unsigned xb_ld(unsigned* p)              { return __hip_atomic_load(p, __ATOMIC_RELAXED, __HIP_MEMORY_SCOPE_AGENT); }
DI unsigned xb_add(unsigned* p, unsigned v) { return __hip_atomic_fetch_add(p, v, __ATOMIC_RELAXED, __HIP_MEMORY_SCOPE_AGENT); }
DI unsigned xb_xcc_id() { return (unsigned)__builtin_amdgcn_s_getreg((3 << 11) | 20) & 0xFu; }
#define XB_SPIN(cond, bar) do { unsigned _sp = 0; while (cond) { __builtin_amdgcn_s_sleep(1); \
    if ((++_sp & 255u) == 0u) { if (xb_ld(&(bar)[XB_TMO])) break; if (_sp > XB_SPIN_CAP) { atomicAdd(&(bar)[XB_TMO], 1u); break; } } } } while (0)
DI void xcd_barrier_complete(unsigned* bar, unsigned x, unsigned& nloc, unsigned& nx) {
    const unsigned G = gridDim.x * gridDim.y * gridDim.z;
    unsigned sum, cnt, mine, sp = 0u;
    for (;;) {
        sum = 0u; cnt = 0u; mine = 0u;
#pragma unroll
        for (unsigned j = 0; j < 16; ++j) { const unsigned c = xb_ld(&bar[XB_XCNT(j)]); sum += c; cnt += (c > 0u) ? 1u : 0u; mine = (j == x) ? c : mine; }
        if (sum == G) break;
        __builtin_amdgcn_s_sleep(1);
        if ((++sp & 255u) == 0u) { if (xb_ld(&bar[XB_TMO])) break; if (sp > XB_SPIN_CAP) { atomicAdd(&bar[XB_TMO], 1u); break; } }
    }
    nloc = mine > 0u ? mine : 1u; nx = cnt > 0u ? cnt : 1u;
}
DI void xcd_barrier(unsigned* bar) {
    asm volatile("s_waitcnt vmcnt(0)" ::: "memory");
    __syncthreads();
    if (threadIdx.x == 0) {
        volatile LAS unsigned* st = (volatile LAS unsigned*)(LDS_PTR() + LDS_BARST);
        const unsigned x = xb_xcc_id();
        __builtin_amdgcn_s_waitcnt(0);
        unsigned nloc = st[0], nx = st[1];
        if (nloc == 0u) { xcd_barrier_complete(bar, x, nloc, nx); st[0] = nloc; st[1] = nx; }
        const unsigned old = xb_add(&bar[XB_XSUB(x)], 1u);
        const unsigned gen = old / nloc;
        if (old + 1u == (gen + 1u) * nloc) {
            __builtin_amdgcn_fence(__ATOMIC_RELEASE, "agent");
            asm volatile("s_waitcnt vmcnt(0)" ::: "memory");
            const unsigned og = xb_add(&bar[XB_TOP], 1u);
            const unsigned tg = og / nx;
            if (og + 1u == (tg + 1u) * nx) xb_add(&bar[XB_TOPGEN], 1u);
            else XB_SPIN(xb_ld(&bar[XB_TOPGEN]) == tg, bar);
            __builtin_amdgcn_fence(__ATOMIC_ACQUIRE, "agent");
            xb_add(&bar[XB_XGEN(x)], 1u);
            asm volatile("s_waitcnt vmcnt(0)" ::: "memory");
        } else {
            XB_SPIN(xb_ld(&bar[XB_XGEN(x)]) == gen, bar);
            __builtin_amdgcn_fence(__ATOMIC_ACQUIRE, "agent");
            asm volatile("s_waitcnt vmcnt(0)" ::: "memory");
        }
    }
    __syncthreads();
}

DI KArgs oargs() { auto p = __builtin_amdgcn_kernarg_segment_ptr(); asm volatile("" : "+s"(p)); return (KArgs)p; }

DI void ph_prologue() {
    KArgs ka = oargs();
    LAS unsigned char* lds = LDS_PTR(); unsigned char* ws = ka->ws; float* mod = (float*)(ws + WS_MOD);
    const int tid = otid(), lane = tid & 63, wave = __builtin_amdgcn_readfirstlane(tid >> 6), G = gridDim.x, bx = blockIdx.x, gw = bx * NWV + wave, ngw = G * NWV;
#ifdef PROBE_ADA
    const unsigned long long tp0 = __builtin_amdgcn_s_memrealtime();
#endif
    if (bx < 72) {
        LAS float* cact = (LAS float*)lds;
        LAS float* red = (LAS float*)(lds + 65536);
        const float* c = ka->in[1]; const float* wada = ka->in[2]; const float* bada = ka->in[3];
        for (int i = tid; i < NB * DM; i += NTHR) { const float v = c[i]; cact[i] = v * sigm(v); }
        __syncthreads();
        const int col = bx * 256 + 4 * lane;
        f32x4 acc[8];
#pragma unroll
        for (int b = 0; b < 8; ++b) acc[b] = (f32x4){0.f, 0.f, 0.f, 0.f};
        const float* wp = wada + (size_t)(wave * 256) * (NADA * DM) + col;
#pragma unroll 1
        for (int k = 0; k < 256; k += 8) {
            f32x4 w[8];
#pragma unroll
            for (int e = 0; e < 8; ++e) w[e] = *(const f32x4*)(wp + (size_t)(k + e) * (NADA * DM));
#pragma unroll
            for (int e = 0; e < 8; ++e)
#pragma unroll
                for (int b = 0; b < 8; ++b) acc[b] += w[e] * cact[b * DM + wave * 256 + k + e];
        }
#pragma unroll
        for (int b = 0; b < 8; ++b) *(LAS f32x4*)(red + (wave * 8 + b) * 256 + 4 * lane) = acc[b];
        __syncthreads();
#pragma unroll
        for (int e = 0; e < 4; ++e) { const int idx = tid + 512 * e, b = idx >> 8, cc = idx & 255; float sum = bada[bx * 256 + cc];
#pragma unroll
            for (int w = 0; w < 8; ++w) sum += red[(w * 8 + b) * 256 + cc];
            mod[b * (NADA * DM) + bx * 256 + cc] = sum; }
        __syncthreads();
    }
#ifdef PROBE_ADA
    { const unsigned long long tp1 = __builtin_amdgcn_s_memrealtime(); while (__builtin_amdgcn_s_memrealtime() - tp1 < tp1 - tp0) __builtin_amdgcn_s_sleep(8); }
#endif
    {
        const int nada = (G > 72) ? 72 : 0, nslots = (G - nada) * NWV * 2 + nada * NWV;
        const int slot0 = (bx >= nada) ? ((bx - nada) * NWV + wave) * 2 : (G - nada) * NWV * 2 + bx * NWV + wave, nslot = (bx >= nada) ? 2 : 1;
        conv_jobs_w(0, 9, ka, lds, slot0, nslot, nslots, wave, lane);
        conv_jobs_w(11, 12, ka, lds, slot0, nslot, nslots, wave, lane);
    }
    {
        const int idx = bx * NTHR + tid;
        if (idx < SEQ * 16) { const int pos = idx >> 4, i = idx & 15;
            const float invf = __builtin_amdgcn_exp2f(-(float)i * 1.1832230356f); const float ang = (float)pos * invf;
            const float rev = ang * 0.15915494309189535f, fr = rev - floorf(rev);
            float* rp = (float*)(ws + WS_ROPE) + pos * 32; rp[i] = __builtin_amdgcn_cosf(fr); rp[16 + i] = __builtin_amdgcn_sinf(fr); }
    }
    __syncthreads();
}
DI void ph_rows(int which) {
    KArgs ka = oargs(); unsigned char* ws = ka->ws; float* out = ka->out; const float* mod = (const float*)(ws + WS_MOD);
    const int tid = otid(), lane = tid & 63, wave = __builtin_amdgcn_readfirstlane(tid >> 6), G = gridDim.x, bx = blockIdx.x, gw = bx * NWV + wave, ngw = G * NWV;
    if (which == 0) {
        const float* x = ka->in[0]; const float* g = ka->in[4];
        for (int row = gw; row < T; row += ngw) { const int b = row >> 11; f32x4 v[8]; row_load(v, x + (size_t)row * DM, lane); const float rs = row_rstd(v);
            row_modulate_store(v, rs, g, mod + b * (NADA * DM) + 0 * DM, mod + b * (NADA * DM) + 1 * DM, (bf16_t*)(ws + WS_U) + (size_t)row * DM, lane); }
    } else if (which == 1) {
        const float* x = ka->in[0]; const float* pg = ka->in[5]; const float* g = ka->in[9];
        for (int row = gw; row < T; row += ngw) { const int b = row >> 11; const float* mb = mod + b * (NADA * DM); f32x4 v[8];
            row_residual(v, (const bf16_t*)(ws + WS_F) + (size_t)row * DM, x + (size_t)row * DM, mb + 2 * DM, pg, 0.5f, out + (size_t)row * DM, lane);
            const float rs = row_rstd(v); row_modulate_store(v, rs, g, mb + 3 * DM, mb + 4 * DM, (bf16_t*)(ws + WS_U) + (size_t)row * DM, lane); }
    } else if (which == 2) {
        const float* pg = ka->in[10]; const float* g = ka->in[28];
        for (int row = gw; row < T; row += ngw) { const int b = row >> 11; const float* mb = mod + b * (NADA * DM); f32x4 v[8];
            row_residual(v, (const bf16_t*)(ws + WS_FMIX) + (size_t)row * DM, out + (size_t)row * DM, mb + 5 * DM, pg, 1.0f, out + (size_t)row * DM, lane);
            const float rs = row_rstd(v); row_modulate_store(v, rs, g, mb + 6 * DM, mb + 7 * DM, (bf16_t*)(ws + WS_U) + (size_t)row * DM, lane); }
    } else {
        const float* pg = ka->in[29];
        for (int row = gw; row < T; row += ngw) { const int b = row >> 11; const float* mb = mod + b * (NADA * DM); f32x4 v[8];
            row_residual(v, (const bf16_t*)(ws + WS_F) + (size_t)row * DM, out + (size_t)row * DM, mb + 8 * DM, pg, 0.5f, out + (size_t)row * DM, lane); }
    }
}

DI void ph_pebias() {
    const int G = gridDim.x, bx = blockIdx.x;
    if (bx < G - 2) return;
    KArgs ka = oargs(); unsigned char* ws = ka->ws;
    const int tid = otid(), src = bx - (G - 2); const float* pe = ka->in[src ? 22 : 19]; const float* w1 = ka->in[src ? 23 : 20];
    LAS f32x4* red = (LAS f32x4*)LDS_PTR();
    const int d4 = tid & 31, kq = tid >> 5;
    f32x4 acc = {0.f, 0.f, 0.f, 0.f};
#pragma unroll 1
    for (int k = kq * 256; k < kq * 256 + 256; k += 16) {
        f32x4 w[16]; float pv[16];
#pragma unroll
        for (int e = 0; e < 16; ++e) { w[e] = *(const f32x4*)(w1 + (size_t)(k + e) * 128 + 4 * d4); pv[e] = pe[k + e]; }
#pragma unroll
        for (int e = 0; e < 16; ++e) acc += w[e] * pv[e];
    }
    __syncthreads();
    red[tid] = acc; __syncthreads();
    if (tid < 32) { f32x4 sum = red[tid];
#pragma unroll
        for (int q = 1; q < 16; ++q) sum += red[q * 32 + tid];
        *(f32x4*)((float*)(ws + WS_PEB) + src * 128 + 4 * tid) = sum; }
    __syncthreads();
}

DI void ph_conv_ffn2() {
    const int G = gridDim.x, bx = blockIdx.x, nlong = (3136 % G);
    if (G <= nlong || bx < nlong) return;
    KArgs ka = oargs();
    const int tid = otid(), lane = tid & 63, wave = __builtin_amdgcn_readfirstlane(tid >> 6);
    __syncthreads();
    conv_jobs_w(9, 11, ka, LDS_PTR(), (bx - nlong) * NWV + wave, 1, (G - nlong) * NWV, wave, lane);
    __syncthreads();
}

__global__ void __launch_bounds__(NTHR) fwd_kernel(Args args_unused) {
    cg::grid_group grid = cg::this_grid();
    {
        volatile LAS unsigned* st = (volatile LAS unsigned*)(LDS_PTR() + LDS_BARST);
        if (threadIdx.x < 2) st[threadIdx.x] = 0u;
        __syncthreads();
        if (threadIdx.x == 0) (void)xb_add((unsigned*)(oargs()->ws + WS_BAR) + XB_XCNT(xb_xcc_id()), 1u);
    }
#ifndef PH_MASK
#define PH_MASK 0xffff
#endif
#define WSP() (oargs()->ws)
#ifndef PROBE_DUP
#define PROBE_DUP 0
#endif
#ifndef PROBE_SPIN
#define PROBE_SPIN 0
#endif
#define RUN(k, bit, body) if (oargs()->ph_lo <= (k) && (k) < oargs()->ph_hi) { unsigned long long _t0 = 0; if (((PROBE_SPIN) >> (k)) & 1) _t0 = __builtin_amdgcn_s_memrealtime(); \
    for (int _rep = 0; _rep < 1 + (((PROBE_DUP) >> (bit)) & 1); ++_rep) if (((PH_MASK) >> (bit)) & 1) { body; } \
    if (((PROBE_SPIN) >> (k)) & 1) { __syncthreads(); const unsigned long long _t1 = __builtin_amdgcn_s_memrealtime(); while (__builtin_amdgcn_s_memrealtime() - _t1 < _t1 - _t0) __builtin_amdgcn_s_sleep(8); } }
#define SEAMX(k) if (oargs()->ph_lo <= (k) && (k) + 1 < oargs()->ph_hi) { if (oargs()->ph_hi > 1000) grid.sync(); else xcd_barrier((unsigned*)(oargs()->ws + WS_BAR)); }
    RUN(0, 0, ph_prologue()) SEAMX(0)
    RUN(1, 1, ph_rows(0)) SEAMX(1)
    RUN(2, 2, ph_ffn_up(WSP())) SEAMX(2)
    RUN(3, 3, ph_ffn_down(WSP())) SEAMX(3)
    RUN(4, 4, ph_rows(1)) SEAMX(4)
    RUN(5, 5, ph_inproj(WSP()); ph_vt(WSP()); ph_pebias(); ph_conv_ffn2()) SEAMX(5)
    RUN(6, 6, ph_cmp1(WSP())) SEAMX(6)
    RUN(7, 7, ph_cmp2(WSP()); __syncthreads(); ph_lru_fused(oargs()->ws, oargs()->in[12], oargs()->in[13], oargs()->in[15], oargs()->in[17], oargs()->in[18]))
    SEAMX(7)
    RUN(8, 8, ph_nsa(WSP())) SEAMX(8)
    RUN(9, 9, ph_ya(WSP()))
    RUN(10, 10, ph_yb(WSP())) SEAMX(10)
    RUN(11, 11, ph_out(WSP())) SEAMX(11)
    RUN(12, 12, ph_rows(2)) SEAMX(12)
    RUN(13, 2, ph_ffn_up(WSP())) SEAMX(13)
    RUN(14, 3, ph_ffn_down(WSP())) SEAMX(14)
    RUN(15, 15, ph_rows(3))
}

extern "C" void kernel_launch(void* const* d_in, const int* in_sizes, int n_in, void* d_out, int out_size, void* d_ws, size_t ws_size, hipStream_t stream) {
    static int grid = 0;
    if (grid == 0) {
        if (n_in != 33 || out_size != T * DM || ws_size < WS_END) { fprintf(stderr, "kernel_launch: unexpected problem (n_in %d out %d ws %zu)\n", n_in, out_size, ws_size); grid = -1; return; }
        int dev = 0, cus = 0, per_cu = 0;
        hipGetDevice(&dev); hipDeviceGetAttribute(&cus, hipDeviceAttributeMultiprocessorCount, dev);
        if (hipFuncSetAttribute((const void*)fwd_kernel, hipFuncAttributeMaxDynamicSharedMemorySize, LDS_BYTES) != hipSuccess) { fprintf(stderr, "kernel_launch: hipFuncSetAttribute failed\n"); grid = -1; return; }
        if (hipOccupancyMaxActiveBlocksPerMultiprocessor(&per_cu, (const void*)fwd_kernel, NTHR, LDS_BYTES) != hipSuccess || per_cu < 1) { fprintf(stderr, "kernel_launch: occupancy query gives %d\n", per_cu); per_cu = 1; }
        (void)hipGetLastError();
        grid = cus;
    }
    if (grid < 0) return;
    if (hipMemsetAsync((char*)d_ws + WS_BAR, 0, 16384, stream) != hipSuccess) { fprintf(stderr, "kernel_launch: memset of the barrier words failed\n"); return; }
    Args a{};
    for (int i = 0; i < 33; ++i) a.in[i] = (const float*)d_in[i];
    a.out = (float*)d_out; a.ws = (unsigned char*)d_ws;
#if ONE_LAUNCH
    a.ph_lo = 0; a.ph_hi = 16;
    void* params[] = {&a};
    hipError_t e = hipLaunchCooperativeKernel((const void*)fwd_kernel, dim3(grid), dim3(NTHR), params, LDS_BYTES, stream);
    if (e != hipSuccess) fprintf(stderr, "cooperative launch failed: %s (grid %d)\n", hipGetErrorString(e), grid);
#else
    for (int p = 0; p < 16; ++p) { a.ph_lo = p; a.ph_hi = p + 1; hipLaunchKernelGGL(fwd_kernel, dim3(grid), dim3(NTHR), LDS_BYTES, stream, a); }
#endif
}
```

```cpp
#include <hip/hip_runtime.h>
#include <hip/hip_cooperative_groups.h>
#include <cstdio>
#include <cstdint>
namespace cg = cooperative_groups;


#ifndef ONE_LAUNCH
#define ONE_LAUNCH 1
#endif

#define LAS __attribute__((address_space(3)))
#define DI __device__ __forceinline__
typedef unsigned short bf16_t;
typedef short bf16x8 __attribute__((ext_vector_type(8)));
typedef short s16x4 __attribute__((ext_vector_type(4)));
typedef float f32x2 __attribute__((ext_vector_type(2)));
typedef float f32x4 __attribute__((ext_vector_type(4)));
typedef float f32x16 __attribute__((ext_vector_type(16)));
typedef unsigned u32x2 __attribute__((ext_vector_type(2)));
typedef unsigned u32x4 __attribute__((ext_vector_type(4)));
typedef __bf16 bf16x2_t __attribute__((ext_vector_type(2)));

constexpr int DM = 2048, NB = 8, SEQ = 2048, T = NB * SEQ, DFF = 5632, NADA = 9;
constexpr int INW = 13360;
constexpr int NTHR = 512, NWV = 8;
constexpr float EPS = 1e-6f;
constexpr size_t MiB = 1u << 20;
constexpr size_t WS_MOD = 0;
constexpr size_t WS_ROPE = 640 * 1024;
constexpr size_t WS_PEB = 900 * 1024;
constexpr size_t WS_W2T = 1 * MiB;
constexpr size_t WS_WGU = 2 * MiB, WS_WD = 46 * MiB;
constexpr size_t WS_BB = 2 * MiB;
constexpr size_t WS_WIN = 68 * MiB, WS_WV = 117 * MiB, WS_WA = 640 * MiB, WS_WB = 648 * MiB, WS_WO = 656 * MiB;
constexpr size_t WS_HG = 68 * MiB;
constexpr size_t WS_PART = 68 * MiB;
constexpr size_t WS_W1T = 145 * MiB, WS_WRI = 147 * MiB, WS_KCC = 152 * MiB, WS_VCT = 153 * MiB, WS_NG = 154 * MiB;
constexpr size_t WS_U = 160 * MiB;
constexpr size_t WS_H = 224 * MiB, WS_F = 400 * MiB;
constexpr size_t WS_XA = 224 * MiB, WS_GY = 288 * MiB, WS_Q = 352 * MiB, WS_KC = 416 * MiB, WS_VC = 432 * MiB, WS_KS = 448 * MiB, WS_KW = 464 * MiB;
constexpr size_t WS_VST = 480 * MiB, WS_VWT = 496 * MiB, WS_MG = 512 * MiB, WS_FMIX = 512 * MiB;
constexpr size_t WS_END = 664 * MiB;
constexpr int LDS_BYTES = 147456;

struct Args { const float* in[33]; float* out; unsigned char* ws; int ph_lo, ph_hi; };
typedef const Args __attribute__((address_space(4)))* KArgs;

DI unsigned pk2(float lo, float hi) { f32x2 v = {lo, hi}; bf16x2_t b = __builtin_convertvector(v, bf16x2_t); return __builtin_bit_cast(unsigned, b); }
DI float bf2f(bf16_t v) { return __uint_as_float((unsigned)v << 16); }
DI float bflo(unsigned w) { return __uint_as_float(w << 16); }
DI float bfhi(unsigned w) { return __uint_as_float(w & 0xffff0000u); }
DI float sigm(float x) { return __builtin_amdgcn_rcpf(1.f + __builtin_amdgcn_exp2f(-1.4426950408889634f * x)); }
DI float gelu_t(float x) { const float u = 0.7978845608028654f * (x + 0.044715f * x * x * x); return x * __builtin_amdgcn_rcpf(1.f + __builtin_amdgcn_exp2f(-2.8853900817779268f * u)); }
DI float wave_sum(float v) {
#pragma unroll
    for (int o = 1; o < 64; o <<= 1) v += __shfl_xor(v, o);
    return v;
}
#define LDS_WAIT() asm volatile("s_waitcnt lgkmcnt(0)" ::: "memory")
DI int otid() { int t = threadIdx.x; asm volatile("" : "+v"(t)); return t; }

namespace pg8 {
constexpr int BM = 256, BK = 64, HALF = 128, HTB = HALF * BK * 2, STAGE_BYTES = 8 * HTB, NXCD = 8, WGM = 8;
DI int lds_byte(int r, int c) { const int st = (r >> 4) * 2 + (c >> 5), rr = r & 15, cc = c & 31, ob = rr * 64 + cc * 2; return st * 1024 + (ob ^ (((ob >> 9) & 1) << 5)); }
DI void stage_rc(int b, int& R, int& C) { const int st = b / 1024, sb = b % 1024, swz = sb ^ (((sb >> 9) & 1) << 5); R = (st >> 1) * 16 + swz / 64; C = (st & 1) * 32 + (swz % 64) / 2; }
DI int perm32(int rho) { const int n = rho >> 4, i = rho & 15; return 8 * (i >> 2) + 4 * n + (i & 3); }

struct Unit { int pm, pn; long aoff, boff; };
struct Gemm { const bf16_t* A; const bf16_t* Bt; int lda, ldb, K; };
struct Sched {
    int nM, nN, nwg, G, c, mode; long astep, bstep, srcstride;
    DI void init(int nM_, int nN_, int G_, int c_, long astep_, long bstep_) { nM = nM_; nN = nN_; nwg = nM * nN; G = G_; c = c_; mode = 0; astep = astep_; bstep = bstep_; srcstride = 0; }
    DI bool next(int i, Unit& u) const {
        const long L = (long)i * G + c; if (L >= nwg) return false;
        int wgid = (int)L;
        if (mode == 1) {
            const int pm = wgid & 15, ks = (wgid >> 4) & 7, src = wgid >> 7;
            u.pm = pm; u.pn = src + 2 * ks; u.aoff = (long)src * srcstride + (long)pm * 256 * 2048 * 2 + (long)ks * 1024; u.boff = (long)ks * 1024; return true;
        }
        { const int q = nwg / NXCD, r = nwg % NXCD, xcd = wgid % NXCD, off = wgid / NXCD; wgid = (xcd < r ? xcd * (q + 1) : r * (q + 1) + (xcd - r) * q) + off; }
        const int nig = WGM * nN, gid = wgid / nig, fm = gid * WGM, gsz = (nM - fm) < WGM ? (nM - fm) : WGM;
        u.pm = fm + ((wgid % nig) % gsz); u.pn = (wgid % nig) / gsz; u.aoff = (long)u.pm * astep; u.boff = (long)u.pn * bstep; return true;
    }
};

template <class Epi>
DI void gemm_phase(LAS unsigned char* lds, const Gemm g, const Sched& S, const Epi& E) {
    const int tid = otid(), wid = __builtin_amdgcn_readfirstlane(tid >> 6), lane = tid & 63, wr = wid >> 2, wc = wid & 3, fr = lane & 15, fq = lane >> 4;
    const int K = g.K, nt = K / BK;
    unsigned voffA[2], voffB[2];
#pragma unroll
    for (int i = 0; i < 2; ++i) { int R, C; stage_rc(tid * 16 + i * 8192, R, C); const int Rb = Epi::PERM ? ((R & ~31) + perm32(R & 31)) : R;
        voffA[i] = (unsigned)(R * g.lda + C) * 2u; voffB[i] = (unsigned)(Rb * g.ldb + C) * 2u; }
    const size_t kstep = (size_t)(BK * 2);
    const size_t hsA = (size_t)HALF * g.lda * 2, hsB = (size_t)HALF * g.ldb * 2;
    const unsigned ldsw = (unsigned)wid * 1024u;
    const int aoff = lds_byte(wr * 64 + fr, fq * 8), boff = lds_byte(wc * 32 + fr, fq * 8);
#define PG8_SA(b, h) (((b) * 2 + (h)) * HTB)
#define PG8_SB(b, h) ((4 + (b) * 2 + (h)) * HTB)
#define PG8_STAGE(bufoff, gbase, voff) do { _Pragma("unroll") for (int _i = 0; _i < 2; ++_i) \
        __builtin_amdgcn_global_load_lds((const unsigned*)((const char*)(gbase) + (voff)[_i]), (LAS unsigned*)(lds + (bufoff) + ldsw + _i * 8192), 16, 0, 0); } while (0)
#define PG8_LDA(dst, b, h) do { _Pragma("unroll") for (int m = 0; m < 4; ++m) _Pragma("unroll") for (int k = 0; k < 2; ++k) dst[m][k] = *(const LAS bf16x8*)(lds + PG8_SA(b, h) + aoff + m * 2048 + k * 1024); } while (0)
#define PG8_LDB(dst, b, h) do { _Pragma("unroll") for (int n = 0; n < 2; ++n) _Pragma("unroll") for (int k = 0; k < 2; ++k) dst[n][k] = *(const LAS bf16x8*)(lds + PG8_SB(b, h) + boff + n * 2048 + k * 1024); } while (0)
#define PG8_MMA(ai, bj, At, Bt) do { __builtin_amdgcn_s_setprio(1); _Pragma("unroll") for (int m = 0; m < 4; ++m) _Pragma("unroll") for (int n = 0; n < 2; ++n) _Pragma("unroll") for (int k = 0; k < 2; ++k) \
        acc[ai][bj][m][n] = __builtin_amdgcn_mfma_f32_16x16x32_bf16(Bt[n][k], At[m][k], acc[ai][bj][m][n], 0, 0, 0); __builtin_amdgcn_s_setprio(0); } while (0)
#define PG8_WAIT_V(n) asm volatile("s_waitcnt vmcnt(" #n ")" ::: "memory")
#define PG8_WAIT_L(n) asm volatile("s_waitcnt lgkmcnt(" #n ")" ::: "memory")
#define PG8_BAR __builtin_amdgcn_s_barrier()
#define PG8_SCHED __builtin_amdgcn_sched_barrier(0)
    Unit cur, nxt; int ui = 0;
    if (!S.next(0, cur)) return;
    f32x4 acc[2][2][4][2];
#pragma unroll
    for (int a = 0; a < 2; ++a)
#pragma unroll
        for (int b = 0; b < 2; ++b)
#pragma unroll
            for (int m = 0; m < 4; ++m)
#pragma unroll
                for (int n = 0; n < 2; ++n) acc[a][b][m][n] = (f32x4){0.f, 0.f, 0.f, 0.f};
    bf16x8 At[4][2], B0[2][2], B1[2][2];
    const char* cA = (const char*)g.A + cur.aoff; const char* cB = (const char*)g.Bt + cur.boff;
    PG8_STAGE(PG8_SB(0, 0), cB, voffB); PG8_STAGE(PG8_SB(0, 1), cB + hsB, voffB); PG8_STAGE(PG8_SA(0, 0), cA, voffA); PG8_STAGE(PG8_SA(0, 1), cA + hsA, voffA);
    if (wr == 1) PG8_BAR;
    PG8_WAIT_V(2); PG8_BAR;
    PG8_STAGE(PG8_SB(1, 0), cB + kstep, voffB); PG8_STAGE(PG8_SA(1, 0), cA + kstep, voffA); PG8_STAGE(PG8_SB(1, 1), cB + hsB + kstep, voffB);
    PG8_WAIT_V(6); PG8_BAR;
    for (;;) {
        const bool has_next = S.next(ui + 1, nxt);
        const char* nA = has_next ? (const char*)g.A + nxt.aoff : cA; const char* nB = has_next ? (const char*)g.Bt + nxt.boff : cB;
        for (int t = 0; t < nt; t += 2) {
            const bool last = (t == nt - 2);
            const char* a1 = cA + (size_t)(t + 1) * kstep;
            const char* a2 = last ? nA : cA + (size_t)(t + 2) * kstep; const char* b2 = last ? nB : cB + (size_t)(t + 2) * kstep;
            const char* a3 = a2 + kstep; const char* b3 = b2 + kstep;
            PG8_LDB(B0, 0, 0); PG8_LDB(B1, 0, 1); PG8_SCHED; PG8_LDA(At, 0, 0); PG8_STAGE(PG8_SA(1, 1), a1 + hsA, voffA);
            PG8_WAIT_V(8); PG8_WAIT_L(0); PG8_BAR; PG8_MMA(0, 0, At, B0); PG8_MMA(0, 1, At, B1); PG8_BAR; PG8_SCHED;
            PG8_LDA(At, 0, 1); PG8_STAGE(PG8_SB(0, 0), b2, voffB); PG8_STAGE(PG8_SB(0, 1), b2 + hsB, voffB); PG8_STAGE(PG8_SA(0, 0), a2, voffA);
            PG8_WAIT_V(8); PG8_WAIT_L(0); PG8_BAR; PG8_MMA(1, 0, At, B0); PG8_MMA(1, 1, At, B1); PG8_BAR; PG8_SCHED;
            PG8_LDB(B0, 1, 0); PG8_LDB(B1, 1, 1); PG8_SCHED; PG8_LDA(At, 1, 0); PG8_STAGE(PG8_SA(0, 1), a2 + hsA, voffA);
            PG8_WAIT_V(8); PG8_WAIT_L(0); PG8_BAR; PG8_MMA(0, 0, At, B0); PG8_MMA(0, 1, At, B1); PG8_BAR; PG8_SCHED;
            PG8_LDA(At, 1, 1); PG8_STAGE(PG8_SB(1, 0), b3, voffB); PG8_STAGE(PG8_SB(1, 1), b3 + hsB, voffB); PG8_STAGE(PG8_SA(1, 0), a3, voffA);
            PG8_WAIT_V(8); PG8_WAIT_L(0); PG8_BAR; PG8_MMA(1, 0, At, B0); PG8_MMA(1, 1, At, B1); PG8_BAR; PG8_SCHED;
        }
        if (wr == 0) PG8_BAR;
        E(acc, cur, wr, wc, fr, fq);
        if (!has_next) break;
#pragma unroll
        for (int a = 0; a < 2; ++a)
#pragma unroll
            for (int b = 0; b < 2; ++b)
#pragma unroll
                for (int m = 0; m < 4; ++m)
#pragma unroll
                    for (int n = 0; n < 2; ++n) acc[a][b][m][n] = (f32x4){0.f, 0.f, 0.f, 0.f};
        cur = nxt; cA = nA; cB = nB; ++ui;
        if (wr == 1) PG8_BAR;
    }
    PG8_WAIT_V(0);
    PG8_BAR;
#undef PG8_SA
#undef PG8_SB
#undef PG8_STAGE
#undef PG8_LDA
#undef PG8_LDB
#undef PG8_MMA
#undef PG8_WAIT_V
#undef PG8_WAIT_L
#undef PG8_BAR
#undef PG8_SCHED
}
}
using pg8::Unit;
typedef f32x4 AccT[2][2][4][2];

struct EpiFFN {
    static constexpr bool PERM = true; bf16_t* H;
    DI void operator()(const AccT& acc, const Unit& u, int wr, int wc, int fr, int fq) const {
        const int col = u.pn * 128 + wc * 32 + fq * 8;
#pragma unroll
        for (int ai = 0; ai < 2; ++ai)
#pragma unroll
            for (int m = 0; m < 4; ++m) {
                const int row = u.pm * 256 + ai * 128 + wr * 64 + m * 16 + fr;
                float v[8];
#pragma unroll
                for (int n = 0; n < 2; ++n)
#pragma unroll
                    for (int e = 0; e < 4; ++e) { const float gt = acc[ai][0][m][n][e], up = acc[ai][1][m][n][e]; v[n * 4 + e] = gt * sigm(gt) * up; }
                u32x4 w; w.x = pk2(v[0], v[1]); w.y = pk2(v[2], v[3]); w.z = pk2(v[4], v[5]); w.w = pk2(v[6], v[7]);
                *(u32x4*)(H + (size_t)row * DFF + col) = w;
            }
    }
};
struct EpiBf {
    static constexpr bool PERM = true; bf16_t* O;
    DI void operator()(const AccT& acc, const Unit& u, int wr, int wc, int fr, int fq) const {
#pragma unroll
        for (int ai = 0; ai < 2; ++ai)
#pragma unroll
            for (int m = 0; m < 4; ++m) {
                const int row = u.pm * 256 + ai * 128 + wr * 64 + m * 16 + fr;
#pragma unroll
                for (int bj = 0; bj < 2; ++bj) { const f32x4 v0 = acc[ai][bj][m][0], v1 = acc[ai][bj][m][1];
                    u32x4 w; w.x = pk2(v0[0], v0[1]); w.y = pk2(v0[2], v0[3]); w.z = pk2(v1[0], v1[1]); w.w = pk2(v1[2], v1[3]);
                    *(u32x4*)(O + (size_t)row * DM + u.pn * 256 + bj * 128 + wc * 32 + fq * 8) = w; }
            }
    }
};
struct EpiPart {
    static constexpr bool PERM = false; float* P;
    DI void operator()(const AccT& acc, const Unit& u, int wr, int wc, int fr, int fq) const {
        const int src = u.pn & 1, ks = u.pn >> 1;
        float* base = P + ((size_t)(ks * 2 + src) * 4096) * 128;
#pragma unroll
        for (int ai = 0; ai < 2; ++ai)
#pragma unroll
            for (int m = 0; m < 4; ++m) {
                const int row = u.pm * 256 + ai * 128 + wr * 64 + m * 16 + fr;
#pragma unroll
                for (int n = 0; n < 2; ++n) { const f32x4 v = src ? acc[ai][1][m][n] : acc[ai][0][m][n]; *(f32x4*)(base + (size_t)row * 128 + wc * 32 + n * 16 + fq * 4) = v; }
            }
    }
};
struct EpiVT {
    static constexpr bool PERM = true; bf16_t* VT0; bf16_t* VT1;
    DI void operator()(const AccT& acc, const Unit& u, int wr, int wc, int fr, int fq) const {
#pragma unroll
        for (int ai = 0; ai < 2; ++ai)
#pragma unroll
            for (int m = 0; m < 4; ++m) {
                const int r = u.pm * 256 + ai * 128 + wr * 64 + m * 16 + fr;
                const int piece = r >> 9, gg = (r >> 7) & 3, d = r & 127;
                bf16_t* base = piece ? VT1 : VT0;
#pragma unroll
                for (int bj = 0; bj < 2; ++bj) {
                    const int t = u.pn * 256 + bj * 128 + wc * 32 + fq * 8, b = t >> 11, s = t & 2047;
                    const f32x4 v0 = acc[ai][bj][m][0], v1 = acc[ai][bj][m][1];
                    u32x4 w; w.x = pk2(v0[0], v0[1]); w.y = pk2(v0[2], v0[3]); w.z = pk2(v1[0], v1[1]); w.w = pk2(v1[2], v1[3]);
                    *(u32x4*)(base + ((size_t)((b * 4 + gg) * 128 + d)) * 2048 + s) = w;
                }
            }
    }
};
struct EpiGate {
    static constexpr bool PERM = true; const bf16_t* MG; const bf16_t* YAG; bf16_t* O; int mode;
    DI void operator()(const AccT& acc, const Unit& u, int wr, int wc, int fr, int fq) const {
#pragma unroll
        for (int ai = 0; ai < 2; ++ai)
#pragma unroll
            for (int m = 0; m < 4; ++m) {
                const int row = u.pm * 256 + ai * 128 + wr * 64 + m * 16 + fr;
#pragma unroll
                for (int bj = 0; bj < 2; ++bj) {
                    const int col = u.pn * 256 + bj * 128 + wc * 32 + fq * 8;
                    const u32x4 gw = *(const u32x4*)(MG + (size_t)row * 4096 + (mode ? 2048 : 0) + col);
                    const f32x4 v0 = acc[ai][bj][m][0], v1 = acc[ai][bj][m][1];
                    float o[8] = {v0[0] * bflo(gw.x), v0[1] * bfhi(gw.x), v0[2] * bflo(gw.y), v0[3] * bfhi(gw.y), v1[0] * bflo(gw.z), v1[1] * bfhi(gw.z), v1[2] * bflo(gw.w), v1[3] * bfhi(gw.w)};
                    if (mode) { const u32x4 yw = *(const u32x4*)(YAG + (size_t)row * DM + col);
                        o[0] += bflo(yw.x); o[1] += bfhi(yw.x); o[2] += bflo(yw.y); o[3] += bfhi(yw.y); o[4] += bflo(yw.z); o[5] += bfhi(yw.z); o[6] += bflo(yw.w); o[7] += bfhi(yw.w); }
                    u32x4 w; w.x = pk2(o[0], o[1]); w.y = pk2(o[2], o[3]); w.z = pk2(o[4], o[5]); w.w = pk2(o[6], o[7]);
                    *(u32x4*)(O + (size_t)row * DM + col) = w;
                }
            }
    }
};
struct EpiIn {
    static constexpr bool PERM = true; unsigned char* ws; const float* rope;
    DI void operator()(const AccT& acc, const Unit& u, int wr, int wc, int fr, int fq) const {
#pragma unroll
        for (int bj = 0; bj < 2; ++bj) {
            const int c0 = u.pn * 256 + bj * 128 + wc * 32;
            const int col = c0 + fq * 8;
#pragma unroll
            for (int ai = 0; ai < 2; ++ai)
#pragma unroll
                for (int m = 0; m < 4; ++m) {
                    const int row = u.pm * 256 + ai * 128 + wr * 64 + m * 16 + fr;
                    const int b = row >> 11, s = row & 2047;
                    float v[8];
#pragma unroll
                    for (int n = 0; n < 2; ++n)
#pragma unroll
                        for (int e = 0; e < 4; ++e) v[n * 4 + e] = acc[ai][bj][m][n][e];
                    bf16_t* dst = nullptr;
                    if (c0 < 2048) { dst = (bf16_t*)(ws + WS_XA) + ((size_t)((b * 16 + (col >> 7)) * 2048 + s)) * 128 + (col & 127); }
                    else if (c0 < 4096) {
#pragma unroll
                        for (int e = 0; e < 8; ++e) v[e] = gelu_t(v[e]);
                        { const int chn = col - 2048; dst = (bf16_t*)(ws + WS_GY) + ((size_t)((b * 32 + (chn >> 6)) * 2048 + s)) * 64 + (chn & 63); } }
                    else if (c0 < 8192) {
                        const bool isq = c0 < 6144;
                        const int pc = (c0 - 6144) >> 9;
                        if ((c0 & 127) == 0 && (isq || pc != 1)) {
#pragma unroll
                            for (int e = 0; e < 8; ++e) {
                                const float invf = __builtin_amdgcn_exp2f(-(float)(8 * (fq & 1) + e) * 1.1832230356f), ang = (float)s * invf;
                                const float rev = ang * 0.15915494309189535f, fr = rev - floorf(rev);
                                const float cs = __builtin_amdgcn_cosf(fr), sn = __builtin_amdgcn_sinf(fr);
                                const float mine = v[e], other = __shfl_xor(mine, 32); v[e] = (fq < 2) ? mine * cs - other * sn : mine * cs + other * sn; }
                        }
                        if (isq) dst = (bf16_t*)(ws + WS_Q) + (size_t)row * DM + (col - 4096);
                        else { const int gg = ((c0 - 6144) >> 7) & 3, d = col & 127; dst = (bf16_t*)(ws + WS_KC + (size_t)pc * 16 * MiB) + ((size_t)((b * 4 + gg) * 2048 + s)) * 128 + d; }
                    }
                    else if (c0 < 12288) {
#pragma unroll
                        for (int e = 0; e < 8; ++e) v[e] = sigm(v[e]);
                        dst = (bf16_t*)(ws + WS_MG) + (size_t)row * 4096 + (col - 8192); }
                    else {
                        const int cc = col - 12288;
                        if (cc < 48) { float* ng = (float*)(ws + WS_NG) + (size_t)row * 48 + cc;
                            *(f32x4*)ng = (f32x4){sigm(v[0]), sigm(v[1]), sigm(v[2]), sigm(v[3])}; *(f32x4*)(ng + 4) = (f32x4){sigm(v[4]), sigm(v[5]), sigm(v[6]), sigm(v[7])}; }
                    }
                    if (dst) { u32x4 w; w.x = pk2(v[0], v[1]); w.y = pk2(v[2], v[3]); w.z = pk2(v[4], v[5]); w.w = pk2(v[6], v[7]); *(u32x4*)dst = w; }
                }
        }
    }
};

struct ConvJob { int K, Nd; };
DI const float* conv_src(int job, int d, KArgs a, int& ld) {
    switch (job) {
    case 0: case 9: { const int pn = d >> 8, half = (d >> 7) & 1, j = d & 127; ld = DFF; const int base = job == 0 ? 6 : 30; return a->in[base + half] + 128 * pn + j; }
    case 1: ld = DM; return a->in[8] + d;
    case 10: ld = DM; return a->in[32] + d;
    case 2: { ld = INW; int col;
        if (d < 7680) col = d; else if (d < 8192) col = d + 512; else if (d < 12288) col = d - 8192 + 9264; else if (d < 12336) col = d - 12288 + 9216; else return nullptr;
        return a->in[11] + col; }
    case 3: ld = INW; return a->in[11] + (d < 512 ? 7680 + d : 8704 + (d - 512));
    case 4: ld = DM; return a->in[25] + d;
    case 5: ld = DM; return a->in[26] + d;
    case 6: ld = DM; return a->in[27] + d;
    case 7: ld = 128; return (d < 128) ? a->in[20] + d : a->in[23] + (d - 128);
    case 8: { const int h = d >> 8, half = (d >> 7) & 1, j = d & 127; ld = 128; return (half ? a->in[16] : a->in[14]) + h * 16384 + j; }
    default: ld = 128; return (d < 128) ? a->in[21] + d : a->in[24] + (d - 128);
    }
}
DI bf16_t* conv_dst(int job, unsigned char* ws) {
    switch (job) {
    case 0: case 9: return (bf16_t*)(ws + WS_WGU);
    case 1: case 10: return (bf16_t*)(ws + WS_WD);
    case 2: return (bf16_t*)(ws + WS_WIN);
    case 3: return (bf16_t*)(ws + WS_WV);
    case 4: return (bf16_t*)(ws + WS_WA);
    case 5: return (bf16_t*)(ws + WS_WB);
    case 6: return (bf16_t*)(ws + WS_WO);
    case 7: return (bf16_t*)(ws + WS_W1T);
    case 8: return (bf16_t*)(ws + WS_WRI);
    default: return (bf16_t*)(ws + WS_W2T);
    }
}
DI void conv_dims(int job, int& K, int& Nd) {
    switch (job) {
    case 0: case 9: K = DM; Nd = 11264; break;
    case 1: case 10: K = DFF; Nd = DM; break;
    case 2: K = DM; Nd = 12544; break;
    case 3: K = DM; Nd = 1024; break;
    case 4: case 5: case 6: K = DM; Nd = DM; break;
    case 7: K = 4096; Nd = 256; break;
    case 8: K = 128; Nd = 4096; break;
    default: K = 128; Nd = 256; break;
    }
}
DI void conv_item(int job, int item, KArgs a, LAS float* scr, int lane) {
    int K, Nd; conv_dims(job, K, Nd);
    const int nkb = K / 64, kb = item % nkb, nb = item / nkb, k0 = 64 * kb, n0 = 64 * nb;
    const int kk = lane >> 4, n4 = lane & 15;
    int ld; const float* src = conv_src(job, n0 + 4 * n4, a, ld);
    f32x4 v[16];
#pragma unroll
    for (int i = 0; i < 16; ++i) v[i] = src ? *(const f32x4*)(src + (size_t)(k0 + 4 * i + kk) * ld) : (f32x4){0.f, 0.f, 0.f, 0.f};
#pragma unroll
    for (int i = 0; i < 16; ++i) { LAS float* q = scr + (4 * i + kk) * 65 + 4 * n4; q[0] = v[i][0]; q[1] = v[i][1]; q[2] = v[i][2]; q[3] = v[i][3]; }
    LDS_WAIT();
    bf16_t* WT = conv_dst(job, a->ws);
    const int c = lane & 7, nn = lane >> 3;
#pragma unroll
    for (int j = 0; j < 8; ++j) { const int n = nn + 8 * j; const LAS float* q = scr + (8 * c) * 65 + n;
        u32x4 o; o.x = pk2(q[0 * 65], q[1 * 65]); o.y = pk2(q[2 * 65], q[3 * 65]); o.z = pk2(q[4 * 65], q[5 * 65]); o.w = pk2(q[6 * 65], q[7 * 65]);
        *(u32x4*)(WT + (size_t)(n0 + n) * K + k0 + 8 * c) = o; }
    LDS_WAIT();
}
DI void conv_jobs(int jlo, int jhi, KArgs a, LAS unsigned char* lds, int gw, int ngw, int wave, int lane) {
    LAS float* scr = (LAS float*)(lds + wave * 16640);
    for (int job = jlo; job < jhi; ++job) {
        int K, Nd; conv_dims(job, K, Nd);
        const int nit = (K / 64) * (Nd / 64);
        for (int it = gw; it < nit; it += ngw) conv_item(job, it, a, scr, lane);
    }
}
DI void conv_pair(int job, int itA, int itB, bool hasB, KArgs a, LAS float* scr, int lane) {
    int K, Nd; conv_dims(job, K, Nd);
    const int nkb = K / 64; const int kk = lane >> 4, n4 = lane & 15;
    const int nblk = Nd / 64; (void)nkb;
    const int k0A = 64 * (itA / nblk), n0A = 64 * (itA % nblk), k0B = 64 * (itB / nblk), n0B = 64 * (itB % nblk);
    int ldA, ldB; const float* srcA = conv_src(job, n0A + 4 * n4, a, ldA); const float* srcB = hasB ? conv_src(job, n0B + 4 * n4, a, ldB) : nullptr; if (!hasB) ldB = 0;
    f32x4 vA[16], vB[16];
#pragma unroll
    for (int i = 0; i < 16; ++i) vA[i] = srcA ? *(const f32x4*)(srcA + (size_t)(k0A + 4 * i + kk) * ldA) : (f32x4){0.f, 0.f, 0.f, 0.f};
#pragma unroll
    for (int i = 0; i < 16; ++i) vB[i] = srcB ? *(const f32x4*)(srcB + (size_t)(k0B + 4 * i + kk) * ldB) : (f32x4){0.f, 0.f, 0.f, 0.f};
    bf16_t* WT = conv_dst(job, a->ws);
    const int c = lane & 7, nn = lane >> 3;
#pragma unroll
    for (int half = 0; half < 2; ++half) {
        if (half && !hasB) break;
#pragma unroll
        for (int i = 0; i < 16; ++i) { const f32x4 t = half ? vB[i] : vA[i]; LAS float* q = scr + (4 * i + kk) * 65 + 4 * n4; q[0] = t[0]; q[1] = t[1]; q[2] = t[2]; q[3] = t[3]; }
        LDS_WAIT();
        const int n0 = half ? n0B : n0A, k0 = half ? k0B : k0A;
#pragma unroll
        for (int j = 0; j < 8; ++j) { const int n = nn + 8 * j; const LAS float* q = scr + (8 * c) * 65 + n;
            u32x4 o; o.x = pk2(q[0 * 65], q[1 * 65]); o.y = pk2(q[2 * 65], q[3 * 65]); o.z = pk2(q[4 * 65], q[5 * 65]); o.w = pk2(q[6 * 65], q[7 * 65]);
            *(u32x4*)(WT + (size_t)(n0 + n) * K + k0 + 8 * c) = o; }
        LDS_WAIT();
    }
}
DI void conv_jobs_w(int jlo, int jhi, KArgs a, LAS unsigned char* lds, int pair0, int npair, int npairs, int wave, int lane) {
    LAS float* scr = (LAS float*)(lds + wave * 16640);
    for (int job = jlo; job < jhi; ++job) {
        int K, Nd; conv_dims(job, K, Nd);
        const int nit = (K / 64) * (Nd / 64);
        for (int it0 = 0; it0 < nit; it0 += 2 * npairs)
            for (int sl = 0; sl < npair; ++sl) { const int it = it0 + 2 * (pair0 + sl); if (it < nit) conv_pair(job, it, it + 1, it + 1 < nit, a, scr, lane); }
    }
}

DI int rcol(int q, int lane) { return 512 * (q >> 1) + 8 * lane + 4 * (q & 1); }
DI void row_load(f32x4 (&v)[8], const float* p, int lane) {
#pragma unroll
    for (int q = 0; q < 8; ++q) v[q] = *(const f32x4*)(p + rcol(q, lane));
}
DI void row_load_bf16(f32x4 (&v)[8], const bf16_t* p, int lane) {
#pragma unroll
    for (int j = 0; j < 4; ++j) { const u32x4 w = *(const u32x4*)(p + 512 * j + 8 * lane);
        v[2 * j] = (f32x4){bflo(w.x), bfhi(w.x), bflo(w.y), bfhi(w.y)}; v[2 * j + 1] = (f32x4){bflo(w.z), bfhi(w.z), bflo(w.w), bfhi(w.w)}; }
}
DI float row_rstd(const f32x4 (&v)[8]) {
    float s = 0.f;
#pragma unroll
    for (int j = 0; j < 8; ++j) s += (v[j][0] * v[j][0] + v[j][1] * v[j][1]) + (v[j][2] * v[j][2] + v[j][3] * v[j][3]);
    return rsqrtf(wave_sum(s) * (1.f / DM) + EPS);
}
DI void row_modulate_store(const f32x4 (&v)[8], float rstd, const float* g, const float* sh, const float* sc, bf16_t* o, int lane) {
#pragma unroll
    for (int j = 0; j < 4; ++j) { f32x4 r[2];
#pragma unroll
        for (int e = 0; e < 2; ++e) { const int c = rcol(2 * j + e, lane); const f32x4 gg = *(const f32x4*)(g + c), s1 = *(const f32x4*)(sh + c), s2 = *(const f32x4*)(sc + c);
            r[e] = (v[2 * j + e] * rstd * gg) * (s2 + 1.f) + s1; }
        u32x4 w; w.x = pk2(r[0][0], r[0][1]); w.y = pk2(r[0][2], r[0][3]); w.z = pk2(r[1][0], r[1][1]); w.w = pk2(r[1][2], r[1][3]);
        *(u32x4*)(o + 512 * j + 8 * lane) = w; }
}
DI void row_residual(f32x4 (&v)[8], const bf16_t* f, const float* xres, const float* gate, const float* pg, float wgt, float* xo, int lane) {
    f32x4 fv[8]; row_load_bf16(fv, f, lane); const float rs = row_rstd(fv);
#pragma unroll
    for (int j = 0; j < 8; ++j) { const int c = rcol(j, lane); const f32x4 xr = *(const f32x4*)(xres + c), gt = *(const f32x4*)(gate + c), pp = *(const f32x4*)(pg + c);
        v[j] = xr + (gt * wgt) * (fv[j] * rs * pp); *(f32x4*)(xo + c) = v[j]; }
}

#define MFMA32(a, b, c) __builtin_amdgcn_mfma_f32_32x32x16_bf16((a), (b), (c), 0, 0, 0)
DI int crow(int r, int hi) { return (r & 3) + 8 * (r >> 2) + 4 * hi; }
constexpr int KPITCH = 272, VPITCH = 136, KVBUF = 17408;
constexpr int AL_K = 0, AL_V = 2 * KVBUF, AL_IMP4 = 4 * KVBUF, AL_IMPS = AL_IMP4 + 32768, AL_SEL = AL_IMPS + 8192;
constexpr float NEGB = -1e30f;
struct KVRegs { u32x4 k0, k1, v0, v1; };
DI void kv_load(KVRegs& R, const bf16_t* Kt, const bf16_t* Vt, int vpitch, int tid) {
    const int c = tid, c2 = tid + 512;
    R.k0 = *(const u32x4*)(Kt + (c >> 4) * 128 + (c & 15) * 8); R.k1 = *(const u32x4*)(Kt + (c2 >> 4) * 128 + (c2 & 15) * 8);
    R.v0 = *(const u32x4*)(Vt + (size_t)(c >> 3) * vpitch + (c & 7) * 8); R.v1 = *(const u32x4*)(Vt + (size_t)(c2 >> 3) * vpitch + (c2 & 7) * 8);
}
DI void kv_store(const KVRegs& R, LAS unsigned char* KB, LAS unsigned char* VB, int tid) {
    const int c = tid, c2 = tid + 512;
    *(LAS u32x4*)(KB + (c >> 4) * KPITCH + (c & 15) * 16) = R.k0; *(LAS u32x4*)(KB + (c2 >> 4) * KPITCH + (c2 & 15) * 16) = R.k1;
    LAS unsigned char* p = VB + (c >> 3) * VPITCH + (c & 7) * 16; *(LAS u32x2*)p = (u32x2){R.v0.x, R.v0.y}; *(LAS u32x2*)(p + 8) = (u32x2){R.v0.z, R.v0.w};
    p = VB + (c2 >> 3) * VPITCH + (c2 & 7) * 16; *(LAS u32x2*)p = (u32x2){R.v1.x, R.v1.y}; *(LAS u32x2*)(p + 8) = (u32x2){R.v1.z, R.v1.w};
}
DI void qk_tile(f32x16& p0, f32x16& p1, const LAS unsigned char* KB, const bf16x8 (&qr)[8], int r, int hi) {
#pragma unroll
    for (int i = 0; i < 16; ++i) { p0[i] = 0.f; p1[i] = 0.f; }
#pragma unroll
    for (int d0 = 0; d0 < 8; ++d0) {
        const bf16x8 a0 = *(const LAS bf16x8*)(KB + r * KPITCH + d0 * 32 + hi * 16), a1 = *(const LAS bf16x8*)(KB + (32 + r) * KPITCH + d0 * 32 + hi * 16);
        p0 = MFMA32(a0, qr[d0], p0); p1 = MFMA32(a1, qr[d0], p1);
    }
}
DI bf16x8 pack8(const f32x16& p, int s2) {
    u32x4 w; w.x = pk2(p[8 * s2], p[8 * s2 + 1]); w.y = pk2(p[8 * s2 + 2], p[8 * s2 + 3]); w.z = pk2(p[8 * s2 + 4], p[8 * s2 + 5]); w.w = pk2(p[8 * s2 + 6], p[8 * s2 + 7]);
    return __builtin_bit_cast(bf16x8, w);
}
DI void pv_tile(f32x16 (&o)[4], const LAS unsigned char* VB, const f32x16& p0, const f32x16& p1, int r, int hi) {
#pragma unroll
    for (int kb = 0; kb < 2; ++kb)
#pragma unroll
        for (int s2 = 0; s2 < 2; ++s2) {
            const bf16x8 pf = pack8(kb ? p1 : p0, s2);
#pragma unroll
            for (int db = 0; db < 4; ++db) {
                const LAS unsigned char* base = VB + (32 * db + r) * VPITCH + (32 * kb + 16 * s2 + 4 * hi) * 2;
                const s16x4 lo = *(const LAS s16x4*)base, hh = *(const LAS s16x4*)(base + 16);
                const bf16x8 af = __builtin_shufflevector(lo, hh, 0, 1, 2, 3, 4, 5, 6, 7);
                o[db] = MFMA32(af, pf, o[db]);
            }
        }
}
constexpr float SCL = 0.08838834764831845f * 1.4426950408889634f;

DI void flash_step(f32x16 (&o)[4], float& mrun, float& lrun, const LAS unsigned char* KB, const LAS unsigned char* VB, const bf16x8 (&qr)[8],
                   int r, int hi, int qpos, int key0, bool rowok, bool need_c, bool need_w) {
    f32x16 p0, p1; qk_tile(p0, p1, KB, qr, r, hi);
    float mnew, alpha, ls = 0.f;
    if (!need_c && !need_w) {
        float mt = fmaxf(p0[0], p1[0]);
#pragma unroll
        for (int i = 1; i < 16; ++i) mt = fmaxf(mt, fmaxf(p0[i], p1[i]));
        mt = rowok ? mt * SCL : NEGB;
        mt = fmaxf(mt, __shfl_xor(mt, 32));
        mnew = fmaxf(mrun, mt);
        alpha = __builtin_amdgcn_exp2f(mrun - mnew);
        const float nb = rowok ? -mnew : NEGB;
#pragma unroll
        for (int i = 0; i < 16; ++i) {
            p0[i] = __builtin_amdgcn_exp2f(__builtin_fmaf(p0[i], SCL, nb));
            p1[i] = __builtin_amdgcn_exp2f(__builtin_fmaf(p1[i], SCL, nb));
            ls += p0[i] + p1[i];
        }
    } else {
        float mt = NEGB;
#pragma unroll
        for (int i = 0; i < 16; ++i) {
            const int k0 = key0 + crow(i, hi), k1 = k0 + 32;
            bool v0 = rowok, v1 = rowok;
            if (need_c) { v0 = v0 && (k0 <= qpos); v1 = v1 && (k1 <= qpos); }
            if (need_w) { v0 = v0 && (k0 > qpos - 512); v1 = v1 && (k1 > qpos - 512); }
            p0[i] = v0 ? p0[i] * SCL : NEGB; p1[i] = v1 ? p1[i] * SCL : NEGB;
            mt = fmaxf(mt, fmaxf(p0[i], p1[i]));
        }
        mt = fmaxf(mt, __shfl_xor(mt, 32));
        mnew = fmaxf(mrun, mt);
        alpha = __builtin_amdgcn_exp2f(mrun - mnew);
#pragma unroll
        for (int i = 0; i < 16; ++i) {
            p0[i] = __builtin_amdgcn_exp2f(p0[i] - mnew);
            p1[i] = __builtin_amdgcn_exp2f(p1[i] - mnew);
            ls += p0[i] + p1[i];
        }
    }
    lrun = lrun * alpha + ls;
    if (__any(mnew > mrun)) {
#pragma unroll
        for (int db = 0; db < 4; ++db)
#pragma unroll
            for (int i = 0; i < 16; ++i) o[db][i] *= alpha;
    }
    mrun = mnew;
    pv_tile(o, VB, p0, p1, r, hi);
}

DI void nsa_unit(int bg, int qblk, unsigned char* ws, LAS unsigned char* lds) {
    const int tid = otid(), lane = tid & 63, r = lane & 31, hi = lane >> 5, wave = __builtin_amdgcn_readfirstlane(tid >> 6);
    const int b = bg >> 2, g = bg & 3, head = g * 4 + (wave >> 1), q0 = qblk * 64, qw0 = q0 + 32 * (wave & 1), qpos = qw0 + r;
    const size_t trow = (size_t)b * SEQ + qpos;
    const bf16_t* Qp = (const bf16_t*)(ws + WS_Q) + trow * DM + head * 128;
    bf16_t* Op = (bf16_t*)(ws + WS_XA) + trow * DM + head * 128;
    bf16x8 qr[8];
#pragma unroll
    for (int d0 = 0; d0 < 8; ++d0) qr[d0] = *(const bf16x8*)(Qp + d0 * 16 + hi * 8);
    const float* ngp = (const float*)(ws + WS_NG) + trow * 48 + head * 3;
    const float g0 = ngp[0], g1 = ngp[1], g2 = ngp[2];
    LAS unsigned char* KB0 = lds + AL_K; LAS unsigned char* VB0 = lds + AL_V;
    LAS float* IMP4 = (LAS float*)(lds + AL_IMP4); LAS float* IMPS = (LAS float*)(lds + AL_IMPS); LAS unsigned* SEL = (LAS unsigned*)(lds + AL_SEL);
    unsigned opk[4][8];
    KVRegs R;
    {
        const bf16_t* kc = (const bf16_t*)(ws + WS_KCC) + (size_t)bg * 128 * 128;
        const bf16_t* vct = (const bf16_t*)(ws + WS_VCT) + (size_t)bg * 128 * 128;
        { KVRegs R2; kv_load(R, kc, vct, 128, tid); kv_load(R2, kc + 64 * 128, vct + 64, 128, tid);
          kv_store(R, KB0, VB0, tid); kv_store(R2, KB0 + KVBUF, VB0 + KVBUF, tid); }
        if (tid < 65) SEL[tid] = 0u;
        __syncthreads();
        f32x16 pa0, pa1, pb0, pb1;
        qk_tile(pa0, pa1, KB0, qr, r, hi); qk_tile(pb0, pb1, KB0 + KVBUF, qr, r, hi);
        float mt = NEGB;
#pragma unroll
        for (int i = 0; i < 16; ++i) {
            const int n = crow(i, hi);
            pa0[i] = (16 * n + 31 <= qpos) ? pa0[i] * SCL : NEGB; pa1[i] = (16 * (n + 32) + 31 <= qpos) ? pa1[i] * SCL : NEGB;
            pb0[i] = (16 * (n + 64) + 31 <= qpos) ? pb0[i] * SCL : NEGB; pb1[i] = (16 * (n + 96) + 31 <= qpos) ? pb1[i] * SCL : NEGB;
            mt = fmaxf(fmaxf(mt, fmaxf(pa0[i], pa1[i])), fmaxf(pb0[i], pb1[i]));
        }
        mt = fmaxf(mt, __shfl_xor(mt, 32));
        float ls = 0.f;
#pragma unroll
        for (int i = 0; i < 16; ++i) {
            pa0[i] = (pa0[i] > -1e29f) ? __builtin_amdgcn_exp2f(pa0[i] - mt) : 0.f; pa1[i] = (pa1[i] > -1e29f) ? __builtin_amdgcn_exp2f(pa1[i] - mt) : 0.f;
            pb0[i] = (pb0[i] > -1e29f) ? __builtin_amdgcn_exp2f(pb0[i] - mt) : 0.f; pb1[i] = (pb1[i] > -1e29f) ? __builtin_amdgcn_exp2f(pb1[i] - mt) : 0.f;
            ls += (pa0[i] + pa1[i]) + (pb0[i] + pb1[i]);
        }
        ls += __shfl_xor(ls, 32);
        const float inv = ls > 0.f ? 1.f / ls : 0.f;
#pragma unroll
        for (int i = 0; i < 16; ++i) { pa0[i] *= inv; pa1[i] *= inv; pb0[i] *= inv; pb1[i] *= inv; }
        if (qblk >= 16) {
            LAS float* ip = IMP4 + ((wave >> 1) * 64 + 32 * (wave & 1) + r) * 32;
#define IMP_G(P, blk) _Pragma("unroll") for (int g4 = 0; g4 < 4; ++g4) ip[8 * (blk) + 2 * g4 + hi] = (P[4 * g4] + P[4 * g4 + 1]) + (P[4 * g4 + 2] + P[4 * g4 + 3]);
            IMP_G(pa0, 0) IMP_G(pa1, 1) IMP_G(pb0, 2) IMP_G(pb1, 3)
            LDS_WAIT();
#define IMP_L(P, blk) _Pragma("unroll") for (int g4 = 0; g4 < 4; ++g4) { const int j1 = 8 * (blk) + 2 * g4 + hi + 1; if (j1 < 32) ip[j1] += P[4 * g4 + 3]; }
            IMP_L(pa0, 0) IMP_L(pa1, 1) IMP_L(pb0, 2) IMP_L(pb1, 3)
#undef IMP_G
#undef IMP_L
        }
        f32x16 oc[4];
#pragma unroll
        for (int db = 0; db < 4; ++db)
#pragma unroll
            for (int i = 0; i < 16; ++i) oc[db][i] = 0.f;
        pv_tile(oc, VB0, pa0, pa1, r, hi); pv_tile(oc, VB0 + KVBUF, pb0, pb1, r, hi);
#pragma unroll
        for (int db = 0; db < 4; ++db)
#pragma unroll
            for (int i = 0; i < 8; ++i) opk[db][i] = pk2(oc[db][2 * i] * g0, oc[db][2 * i + 1] * g0);
    }
    __syncthreads();
    if (qblk >= 16) {
#pragma unroll
        for (int e = 0; e < 4; ++e) { const int idx = tid + 512 * e; IMPS[idx] = (IMP4[idx] + IMP4[2048 + idx]) + (IMP4[4096 + idx] + IMP4[6144 + idx]); }
        __syncthreads();
        const int q = tid >> 3;
        float val[32];
#pragma unroll
        for (int j4 = 0; j4 < 8; ++j4) { const f32x4 t4 = *(const LAS f32x4*)(IMPS + q * 32 + 4 * j4); val[4 * j4] = t4[0]; val[4 * j4 + 1] = t4[1]; val[4 * j4 + 2] = t4[2]; val[4 * j4 + 3] = t4[3]; }
        unsigned bits = 0u;
#pragma unroll
        for (int e = 0; e < 4; ++e) {
            const int j = (tid & 7) * 4 + e;
            float vj = 0.f;
#pragma unroll
            for (int i = 0; i < 32; ++i) vj = (i == j) ? val[i] : vj;
            int rank = 0;
#pragma unroll
            for (int i = 1; i < 32; ++i) { const bool cand = (i <= qblk - 2); rank += (cand && (val[i] > vj || (val[i] == vj && i < j))) ? 1 : 0; }
            const bool forced = (j == 0) || (j == qblk) || (j == qblk - 1);
            const bool sel = forced || (j >= 1 && j <= qblk - 2 && rank < 13);
            bits |= sel ? (1u << j) : 0u;
        }
        __hip_atomic_fetch_or(SEL + q, bits, __ATOMIC_RELAXED, __HIP_MEMORY_SCOPE_WORKGROUP);
        __syncthreads();
    } else {
        if (tid < 64) SEL[tid] = (2u << qblk) - 1u;
        __syncthreads();
    }
    if (tid < 64) { unsigned v = SEL[tid];
#pragma unroll
        for (int o = 1; o < 64; o <<= 1) v |= __shfl_xor(v, o);
        if (tid == 0) SEL[64] = v; }
    __syncthreads();
    const unsigned mysel = SEL[32 * (wave & 1) + r];
    unsigned uni = (unsigned)__builtin_amdgcn_readfirstlane(SEL[64]) & ((2u << qblk) - 1u);
#pragma unroll 1
    for (int mode = 0; mode < 2; ++mode) {
        const bf16_t* Kg = (const bf16_t*)(ws + (mode ? WS_KW : WS_KS)) + (size_t)bg * SEQ * 128;
        const bf16_t* Vg = (const bf16_t*)(ws + (mode ? WS_VWT : WS_VST)) + (size_t)bg * 128 * SEQ;
        unsigned todo;
        if (mode) { const int jlo = qblk >= 8 ? qblk - 8 : 0; todo = ((2u << qblk) - 1u) & ~((1u << jlo) - 1u); } else todo = uni;
        f32x16 o[4];
#pragma unroll
        for (int db = 0; db < 4; ++db)
#pragma unroll
            for (int i = 0; i < 16; ++i) o[db][i] = 0.f;
        float mrun = -1e20f, lrun = 0.f;
        int cur = __builtin_ctz(todo); todo &= todo - 1u;
        kv_load(R, Kg + (size_t)cur * 64 * 128, Vg + cur * 64, SEQ, tid); kv_store(R, KB0, VB0, tid);
        int bi = 0;
        for (;;) {
            __syncthreads();
            const int nxt = todo ? __builtin_ctz(todo) : -1; todo &= todo - 1u;
            if (nxt >= 0) kv_load(R, Kg + (size_t)nxt * 64 * 128, Vg + nxt * 64, SEQ, tid);
            const int key0 = cur * 64;
            const bool rowok = mode ? true : (((mysel >> cur) & 1u) != 0u);
            const bool need_c = (key0 + 63 > qw0), need_w = mode && (key0 <= qw0 + 31 - 512);
            const bool wave_skip = mode ? (key0 + 63 <= qw0 - 512) : !__any(rowok);
            if (!wave_skip) flash_step(o, mrun, lrun, KB0 + bi * KVBUF, VB0 + bi * KVBUF, qr, r, hi, qpos, key0, rowok, need_c, need_w);
            if (nxt < 0) break;
            kv_store(R, KB0 + (bi ^ 1) * KVBUF, VB0 + (bi ^ 1) * KVBUF, tid);
            bi ^= 1; cur = nxt;
        }
        __syncthreads();
        lrun += __shfl_xor(lrun, 32);
        const float sc = (mode ? g2 : g1) / lrun;
#pragma unroll
        for (int db = 0; db < 4; ++db)
#pragma unroll
            for (int i = 0; i < 8; ++i) opk[db][i] = pk2(bflo(opk[db][i]) + o[db][2 * i] * sc, bfhi(opk[db][i]) + o[db][2 * i + 1] * sc);
    }
#pragma unroll
    for (int db = 0; db < 4; ++db)
#pragma unroll
        for (int g4 = 0; g4 < 4; ++g4) { u32x2 w; w.x = opk[db][2 * g4]; w.y = opk[db][2 * g4 + 1];
            *(u32x2*)(Op + 32 * db + 8 * g4 + 4 * hi) = w; }
}

#define NOINL __forceinline__
#define LDS_PTR() ((LAS unsigned char*)lds_raw)
extern __shared__ __attribute__((aligned(16))) unsigned char lds_raw[];

NOINL __device__ void ph_ffn_up(unsigned char* ws) {
    pg8::Gemm g{(const bf16_t*)(ws + WS_U), (const bf16_t*)(ws + WS_WGU), DM, DM, DM}; pg8::Sched S; S.init(64, 44, gridDim.x, blockIdx.x, 256L * DM * 2, 256L * DM * 2);
    EpiFFN E{(bf16_t*)(ws + WS_H)}; pg8::gemm_phase(LDS_PTR(), g, S, E);
}
NOINL __device__ void ph_ffn_down(unsigned char* ws) {
    pg8::Gemm g{(const bf16_t*)(ws + WS_H), (const bf16_t*)(ws + WS_WD), DFF, DFF, DFF}; pg8::Sched S; S.init(64, 8, gridDim.x, blockIdx.x, 256L * DFF * 2, 256L * DFF * 2);
    EpiBf E{(bf16_t*)(ws + WS_F)}; pg8::gemm_phase(LDS_PTR(), g, S, E);
}
NOINL __device__ void ph_inproj(unsigned char* ws) {
    pg8::Gemm g{(const bf16_t*)(ws + WS_U), (const bf16_t*)(ws + WS_WIN), DM, DM, DM}; pg8::Sched S; S.init(64, 49, gridDim.x, blockIdx.x, 256L * DM * 2, 256L * DM * 2);
    EpiIn E{ws, (const float*)(ws + WS_ROPE)}; pg8::gemm_phase(LDS_PTR(), g, S, E);
}
NOINL __device__ void ph_vt(unsigned char* ws) {
    pg8::Gemm g{(const bf16_t*)(ws + WS_WV), (const bf16_t*)(ws + WS_U), DM, DM, DM}; pg8::Sched S; S.init(4, 64, gridDim.x, blockIdx.x, 256L * DM * 2, 256L * DM * 2);
    EpiVT E{(bf16_t*)(ws + WS_VST), (bf16_t*)(ws + WS_VWT)}; pg8::gemm_phase(LDS_PTR(), g, S, E);
}
NOINL __device__ void ph_cmp1(unsigned char* ws) {
    pg8::Gemm g{(const bf16_t*)(ws + WS_KC), (const bf16_t*)(ws + WS_W1T), 2048, 4096, 512}; pg8::Sched S; S.init(16, 16, gridDim.x, blockIdx.x, 0, 0); S.mode = 1; S.srcstride = (long)(WS_VC - WS_KC);
    EpiPart E{(float*)(ws + WS_PART)}; pg8::gemm_phase(LDS_PTR(), g, S, E);
}
NOINL __device__ void ph_ya(unsigned char* ws) {
    pg8::Gemm g{(const bf16_t*)(ws + WS_HG), (const bf16_t*)(ws + WS_WA), DM, DM, DM}; pg8::Sched S; S.init(64, 8, gridDim.x, blockIdx.x, 256L * DM * 2, 256L * DM * 2);
    EpiGate E{(const bf16_t*)(ws + WS_MG), nullptr, (bf16_t*)(ws + WS_Q), 0}; pg8::gemm_phase(LDS_PTR(), g, S, E);
}
NOINL __device__ void ph_yb(unsigned char* ws) {
    pg8::Gemm g{(const bf16_t*)(ws + WS_XA), (const bf16_t*)(ws + WS_WB), DM, DM, DM}; pg8::Sched S; S.init(64, 8, gridDim.x, blockIdx.x, 256L * DM * 2, 256L * DM * 2);
    EpiGate E{(const bf16_t*)(ws + WS_MG), (const bf16_t*)(ws + WS_Q), (bf16_t*)(ws + WS_U), 1}; pg8::gemm_phase(LDS_PTR(), g, S, E);
}
NOINL __device__ void ph_out(unsigned char* ws) {
    pg8::Gemm g{(const bf16_t*)(ws + WS_U), (const bf16_t*)(ws + WS_WO), DM, DM, DM}; pg8::Sched S; S.init(64, 8, gridDim.x, blockIdx.x, 256L * DM * 2, 256L * DM * 2);
    EpiBf E{(bf16_t*)(ws + WS_FMIX)}; pg8::gemm_phase(LDS_PTR(), g, S, E);
}
NOINL __device__ void ph_cmp2(unsigned char* ws) {
    const int tid = otid(), lane = tid & 63, wave = __builtin_amdgcn_readfirstlane(tid >> 6), bx = blockIdx.x;
    if (wave >= 4 || bx >= 256) return;
    const int src = bx >> 7, rt = bx & 127;
    const int r = lane & 31, hh = lane >> 5;
    const float* P = (const float*)(ws + WS_PART); const float* peb = (const float*)(ws + WS_PEB) + src * 128;
    const bf16_t* w2t = (const bf16_t*)(ws + WS_W2T) + (size_t)src * 128 * 128;
    f32x16 acc;
#pragma unroll
    for (int i = 0; i < 16; ++i) acc[i] = 0.f;
#pragma unroll 2
    for (int st = 0; st < 8; ++st) {
        const int k0 = 16 * st + 8 * hh; float a[8];
#pragma unroll
        for (int e = 0; e < 8; ++e) a[e] = peb[k0 + e];
#pragma unroll
        for (int ks = 0; ks < 8; ++ks) { const float* pp = P + ((size_t)((ks * 2 + src) * 4096 + rt * 32 + r)) * 128 + k0;
            const f32x4 x0 = *(const f32x4*)pp, x1 = *(const f32x4*)(pp + 4); a[0] += x0[0]; a[1] += x0[1]; a[2] += x0[2]; a[3] += x0[3]; a[4] += x1[0]; a[5] += x1[1]; a[6] += x1[2]; a[7] += x1[3]; }
        u32x4 w; w.x = pk2(gelu_t(a[0]), gelu_t(a[1])); w.y = pk2(gelu_t(a[2]), gelu_t(a[3])); w.z = pk2(gelu_t(a[4]), gelu_t(a[5])); w.w = pk2(gelu_t(a[6]), gelu_t(a[7]));
        const bf16x8 af = __builtin_bit_cast(bf16x8, w);
        const bf16x8 bfr = *(const bf16x8*)(w2t + (size_t)(32 * wave + r) * 128 + k0);
        acc = MFMA32(af, bfr, acc);
    }
#pragma unroll
    for (int i = 0; i < 16; ++i) {
        const int R = rt * 32 + crow(i, hh), nrow = R & 127, bgi = R >> 7, d = 32 * wave + r;
        const float v = (nrow == 127) ? 0.f : acc[i];
        const bf16_t o = (bf16_t)(pk2(v, 0.f) & 0xffffu);
        if (src == 0) ((bf16_t*)(ws + WS_KCC))[(size_t)R * 128 + d] = o;
        else ((bf16_t*)(ws + WS_VCT))[((size_t)bgi * 128 + d) * 128 + nrow] = o;
    }
}
NOINL __device__ void ph_lru_gates(unsigned char* ws, const float* conv_w, const float* conv_b, const float* lbr, const float* lbi, const float* llam) {
    const int tid = otid(), lane = tid & 63, wave = __builtin_amdgcn_readfirstlane(tid >> 6), bx = blockIdx.x, G = gridDim.x;
    LAS unsigned char* lds = LDS_PTR();
    const int h = bx & 15, cuh = bx >> 4, nch = G >> 4;
    LAS unsigned char* WL = lds; LAS unsigned char* XS = lds + 69632 + wave * 8704; LAS float* CW = (LAS float*)(lds + 139264);
    const bf16_t* wri = (const bf16_t*)(ws + WS_WRI) + (size_t)h * 256 * 128;
#pragma unroll
    for (int e = 0; e < 8; ++e) { const int c = tid + 512 * e; *(LAS u32x4*)(WL + (c >> 4) * 272 + (c & 15) * 16) = *(const u32x4*)(wri + (c >> 4) * 128 + (c & 15) * 8); }
    if (tid < 128) { const int ch = h * 128 + tid;
        CW[tid] = conv_w[ch]; CW[128 + tid] = conv_w[DM + ch]; CW[256 + tid] = conv_w[2 * DM + ch]; CW[384 + tid] = conv_w[3 * DM + ch];
        CW[512 + tid] = conv_b[ch]; CW[640 + tid] = lbr[ch]; CW[768 + tid] = lbi[ch];
        const float lam = llam[ch], ex = __expf(-lam);
        CW[896 + tid] = (ex < 0.03f) ? ex * (1.f - ex * (0.5f - ex * (0.33333333f - ex * (0.25f - ex * 0.2f)))) : __logf(1.f + ex); }
    __syncthreads();
    const int r = lane & 31, hh = lane >> 5;
    const bf16_t* XA = (const bf16_t*)(ws + WS_XA); bf16_t* LA = (bf16_t*)(ws + WS_U); bf16_t* BBp = (bf16_t*)(ws + WS_BB);
#pragma unroll 1
    for (int rt = cuh * 8 + wave; rt < T / 32; rt += nch * 8) {
        const int t0 = rt * 32, tok = t0 + r, s = tok & 2047;
        bf16x8 af[8];
#pragma unroll
        for (int st = 0; st < 8; ++st) {
            const int ch0 = 16 * st + 8 * hh; float xc[8];
#pragma unroll
            for (int e = 0; e < 8; ++e) xc[e] = CW[512 + ch0 + e];
#pragma unroll
            for (int j = 0; j < 4; ++j) { if (s - 3 + j >= 0) { const u32x4 xv = *(const u32x4*)(XA + ((size_t)(((tok >> 11) * 16 + h) * 2048 + (s - 3 + j))) * 128 + ch0);
                xc[0] += CW[j * 128 + ch0 + 0] * bflo(xv.x); xc[1] += CW[j * 128 + ch0 + 1] * bfhi(xv.x); xc[2] += CW[j * 128 + ch0 + 2] * bflo(xv.y); xc[3] += CW[j * 128 + ch0 + 3] * bfhi(xv.y);
                xc[4] += CW[j * 128 + ch0 + 4] * bflo(xv.z); xc[5] += CW[j * 128 + ch0 + 5] * bfhi(xv.z); xc[6] += CW[j * 128 + ch0 + 6] * bflo(xv.w); xc[7] += CW[j * 128 + ch0 + 7] * bfhi(xv.w); } }
            u32x4 w; w.x = pk2(xc[0], xc[1]); w.y = pk2(xc[2], xc[3]); w.z = pk2(xc[4], xc[5]); w.w = pk2(xc[6], xc[7]);
            af[st] = __builtin_bit_cast(bf16x8, w);
            *(LAS u32x4*)(XS + r * 272 + ch0 * 2) = w;
            if (st & 1) asm volatile("" ::: "memory");
        }
        LDS_WAIT();
#pragma unroll 1
        for (int cb = 0; cb < 4; ++cb) {
            f32x16 aR, aI;
#pragma unroll
            for (int i = 0; i < 16; ++i) { aR[i] = 0.f; aI[i] = 0.f; }
#pragma unroll
            for (int st = 0; st < 8; ++st) {
                const bf16x8 bR = *(const LAS bf16x8*)(WL + (32 * cb + r) * 272 + st * 32 + hh * 16), bI = *(const LAS bf16x8*)(WL + (128 + 32 * cb + r) * 272 + st * 32 + hh * 16);
                aR = MFMA32(af[st], bR, aR); aI = MFMA32(af[st], bI, aI);
            }
            const int ch = 32 * cb + r; const float br_ = CW[640 + ch], bi_ = CW[768 + ch], sp_ = CW[896 + ch];
#pragma unroll
            for (int i = 0; i < 16; ++i) {
                const int tk = crow(i, hh);
                const float rr = sigm(aR[i] + br_), ig = sigm(aI[i] + bi_), la = -8.f * rr * sp_;
                const float xcv = bf2f(*(const LAS bf16_t*)(XS + tk * 272 + ch * 2));
                const float bm = sqrtf(fmaxf(1.f - __expf(2.f * la), 0.f)) * ig * xcv;
                const int tkn = t0 + tk;
                const size_t o = ((size_t)(((tkn >> 11) * 32 + h * 2 + (cb >> 1)) * 2048 + (tkn & 2047))) * 64 + (cb & 1) * 32 + r;
                LA[o] = (bf16_t)(pk2(la, 0.f) & 0xffffu); BBp[o] = (bf16_t)(pk2(bm, 0.f) & 0xffffu);
            }
        }
        LDS_WAIT();
    }
}
NOINL __device__ void ph_scan(unsigned char* ws) {
    const int tid = otid(), lane = tid & 63, wave = __builtin_amdgcn_readfirstlane(tid >> 6), bx = blockIdx.x, G = gridDim.x;
    LAS float* car = (LAS float*)LDS_PTR();
    const bf16_t* LA = (const bf16_t*)(ws + WS_U); const bf16_t* BBp = (const bf16_t*)(ws + WS_BB); const bf16_t* GY = (const bf16_t*)(ws + WS_GY); bf16_t* HG = (bf16_t*)(ws + WS_HG);
    for (int unit = bx; unit < 256; unit += G) {
        const int b = unit >> 5, ch = (unit & 31) * 64 + lane;
        const size_t bbase = (size_t)unit * 2048 * 64 + lane;
        float hcarry = 0.f;
#pragma unroll 1
        for (int rd = 0; rd < 8; ++rd) {
            const size_t base = ((size_t)b * SEQ + rd * 256 + wave * 32) * DM + ch;
            float la[32], bb[32], gy[32];
#pragma unroll
            for (int e = 0; e < 32; ++e) { const size_t o = bbase + (size_t)(rd * 256 + wave * 32 + e) * 64; la[e] = bf2f(LA[o]); bb[e] = bf2f(BBp[o]); gy[e] = bf2f(GY[o]); }
            float hst = 0.f;
#pragma unroll
            for (int e = 0; e < 32; ++e) { la[e] = __expf(la[e]); hst = la[e] * hst + bb[e]; }
            float aprod = 1.f;
#pragma unroll
            for (int e = 0; e < 32; ++e) aprod *= la[e];
            LAS float* cb = car + (rd & 1) * 1024;
            cb[(wave * 2) * 64 + lane] = aprod; cb[(wave * 2 + 1) * 64 + lane] = hst;
            __syncthreads();
            float hin = hcarry, myhin = 0.f;
#pragma unroll
            for (int w = 0; w < 8; ++w) { if (w == wave) myhin = hin; hin = cb[(w * 2) * 64 + lane] * hin + cb[(w * 2 + 1) * 64 + lane]; }
            hcarry = hin; hst = myhin;
#pragma unroll
            for (int e = 0; e < 32; ++e) { hst = la[e] * hst + bb[e]; HG[base + (size_t)e * DM] = (bf16_t)(pk2(hst * gy[e], 0.f) & 0xffffu); }
        }
        __syncthreads();
    }
}
NOINL __device__ void ph_lru_fused(unsigned char* ws, const float* conv_w, const float* conv_b, const float* lbr, const float* lbi, const float* llam) {
    const int tid = otid(), lane = tid & 63, wave = __builtin_amdgcn_readfirstlane(tid >> 6), bx = blockIdx.x, G = gridDim.x;
    LAS unsigned char* lds = LDS_PTR();
    LAS unsigned char* WL = lds; LAS float* CW = (LAS float*)(lds + 34816); LAS unsigned char* XS = lds + 38912 + wave * 8704; LAS float* car = (LAS float*)(lds + 108544);
    const int r = lane & 31, hh = lane >> 5;
    const bf16_t* XA = (const bf16_t*)(ws + WS_XA); const bf16_t* GY = (const bf16_t*)(ws + WS_GY); bf16_t* HG = (bf16_t*)(ws + WS_HG);
#pragma unroll 1
    for (int unit = bx; unit < 256; unit += G) {
        const int b = unit >> 5, cgp = unit & 31, h = cgp >> 1, hf = cgp & 1;
        __syncthreads();
        {
            const bf16_t* wri = (const bf16_t*)(ws + WS_WRI) + (size_t)h * 256 * 128;
#pragma unroll
            for (int e = 0; e < 4; ++e) { const int c = tid + 512 * e, row = c >> 4, srow = (row < 64) ? hf * 64 + row : 128 + hf * 64 + (row - 64);
                *(LAS u32x4*)(WL + row * 272 + (c & 15) * 16) = *(const u32x4*)(wri + srow * 128 + (c & 15) * 8); }
            if (tid < 128) { const int ch = h * 128 + tid; CW[tid] = conv_w[ch]; CW[128 + tid] = conv_w[DM + ch]; CW[256 + tid] = conv_w[2 * DM + ch]; CW[384 + tid] = conv_w[3 * DM + ch]; CW[512 + tid] = conv_b[ch]; }
            if (tid < 64) { const int ch = h * 128 + hf * 64 + tid; CW[640 + tid] = lbr[ch]; CW[704 + tid] = lbi[ch];
                const float lam = llam[ch], ex = __expf(-lam);
                CW[768 + tid] = (ex < 0.03f) ? ex * (1.f - ex * (0.5f - ex * (0.33333333f - ex * (0.25f - ex * 0.2f)))) : __logf(1.f + ex); }
        }
        __syncthreads();
        const bf16_t* XAb = XA + (size_t)(b * 16 + h) * 2048 * 128;
        const bf16_t* GYb = GY + (size_t)unit * 2048 * 64;
        float hcar0 = 0.f, hcar1 = 0.f;
#pragma unroll 1
        for (int rd = 0; rd < 8; ++rd) {
            const int t0 = rd * 256 + wave * 32, s = t0 + r;
            bf16_t gyr[2][16];
#pragma unroll
            for (int cb = 0; cb < 2; ++cb)
#pragma unroll
                for (int i = 0; i < 16; ++i) gyr[cb][i] = GYb[(size_t)(t0 + crow(i, hh)) * 64 + 32 * cb + r];
            bf16x8 af[8];
            {
                u32x4 xv[8][4];
#pragma unroll
                for (int st = 0; st < 8; ++st)
#pragma unroll
                    for (int j = 0; j < 4; ++j) { const int sp = s - 3 + j; xv[st][j] = *(const u32x4*)(XAb + (size_t)(sp < 0 ? 0 : sp) * 128 + 16 * st + 8 * hh); }
#pragma unroll
                for (int st = 0; st < 8; ++st) {
                    const int ch0 = 16 * st + 8 * hh; float xc[8];
#pragma unroll
                    for (int e = 0; e < 8; ++e) xc[e] = CW[512 + ch0 + e];
#pragma unroll
                    for (int j = 0; j < 4; ++j) { const float ok = (s - 3 + j >= 0) ? 1.f : 0.f; const u32x4 x4 = xv[st][j];
                        xc[0] += ok * CW[j * 128 + ch0 + 0] * bflo(x4.x); xc[1] += ok * CW[j * 128 + ch0 + 1] * bfhi(x4.x); xc[2] += ok * CW[j * 128 + ch0 + 2] * bflo(x4.y); xc[3] += ok * CW[j * 128 + ch0 + 3] * bfhi(x4.y);
                        xc[4] += ok * CW[j * 128 + ch0 + 4] * bflo(x4.z); xc[5] += ok * CW[j * 128 + ch0 + 5] * bfhi(x4.z); xc[6] += ok * CW[j * 128 + ch0 + 6] * bflo(x4.w); xc[7] += ok * CW[j * 128 + ch0 + 7] * bfhi(x4.w); }
                    u32x4 w; w.x = pk2(xc[0], xc[1]); w.y = pk2(xc[2], xc[3]); w.z = pk2(xc[4], xc[5]); w.w = pk2(xc[6], xc[7]);
                    af[st] = __builtin_bit_cast(bf16x8, w);
                    *(LAS u32x4*)(XS + r * 272 + ch0 * 2) = w;
                }
            }
            LDS_WAIT();
            float av[2][16], bv[2][16];
#pragma unroll
            for (int cb = 0; cb < 2; ++cb) {
                f32x16 aR, aI;
#pragma unroll
                for (int i = 0; i < 16; ++i) { aR[i] = 0.f; aI[i] = 0.f; }
#pragma unroll
                for (int st = 0; st < 8; ++st) {
                    const bf16x8 bR = *(const LAS bf16x8*)(WL + (32 * cb + r) * 272 + st * 32 + hh * 16), bI = *(const LAS bf16x8*)(WL + (64 + 32 * cb + r) * 272 + st * 32 + hh * 16);
                    aR = MFMA32(af[st], bR, aR); aI = MFMA32(af[st], bI, aI);
                }
                const int chl = 32 * cb + r; const float br_ = CW[640 + chl], bi_ = CW[704 + chl], sp_ = CW[768 + chl];
#pragma unroll
                for (int i = 0; i < 16; ++i) {
                    const float rr = sigm(aR[i] + br_), ig = sigm(aI[i] + bi_), a = __expf(-8.f * rr * sp_);
                    const float xcv = bf2f(*(const LAS bf16_t*)(XS + crow(i, hh) * 272 + (hf * 64 + chl) * 2));
                    av[cb][i] = a; bv[cb][i] = __builtin_amdgcn_sqrtf(fmaxf(1.f - a * a, 0.f)) * ig * xcv;
                }
            }
            float GA[2][4], GB[2][4], PA[2][4], PB[2][4];
#pragma unroll
            for (int cb = 0; cb < 2; ++cb)
#pragma unroll
                for (int g = 0; g < 4; ++g) {
                    float A = av[cb][4 * g], B = bv[cb][4 * g];
#pragma unroll
                    for (int e = 1; e < 4; ++e) { B = av[cb][4 * g + e] * B + bv[cb][4 * g + e]; A *= av[cb][4 * g + e]; }
                    GA[cb][g] = A; GB[cb][g] = B; PA[cb][g] = __shfl_xor(A, 32); PB[cb][g] = __shfl_xor(B, 32);
                }
            LAS float* cbuf = car + (rd & 1) * 1024;
#pragma unroll
            for (int cb = 0; cb < 2; ++cb) {
                float A = 1.f, B = 0.f;
#pragma unroll
                for (int g = 0; g < 4; ++g) {
                    const float A0 = hh ? PA[cb][g] : GA[cb][g], B0 = hh ? PB[cb][g] : GB[cb][g], A1 = hh ? GA[cb][g] : PA[cb][g], B1 = hh ? GB[cb][g] : PB[cb][g];
                    B = A0 * B + B0; A *= A0; B = A1 * B + B1; A *= A1;
                }
                if (hh == 0) { cbuf[(wave * 2) * 64 + 32 * cb + r] = A; cbuf[(wave * 2 + 1) * 64 + 32 * cb + r] = B; }
            }
            __syncthreads();
#pragma unroll
            for (int cb = 0; cb < 2; ++cb) {
                float hin = cb ? hcar1 : hcar0, myhin = 0.f;
#pragma unroll
                for (int w = 0; w < 8; ++w) { if (w == wave) myhin = hin; hin = cbuf[(w * 2) * 64 + 32 * cb + r] * hin + cbuf[(w * 2 + 1) * 64 + 32 * cb + r]; }
                if (cb) hcar1 = hin; else hcar0 = hin;
                float hrun = myhin;
#pragma unroll
                for (int g = 0; g < 4; ++g) {
                    if (hh) hrun = PA[cb][g] * hrun + PB[cb][g];
                    float hv = hrun;
#pragma unroll
                    for (int e = 0; e < 4; ++e) { const int i = 4 * g + e; hv = av[cb][i] * hv + bv[cb][i];
                        HG[((size_t)b * SEQ + t0 + crow(i, hh)) * DM + h * 128 + hf * 64 + 32 * cb + r] = (bf16_t)(pk2(hv * bf2f(gyr[cb][i]), 0.f) & 0xffffu); }
                    hrun = hv;
                    if (!hh) hrun = PA[cb][g] * hrun + PB[cb][g];
                }
            }
        }
    }
}
NOINL __device__ void ph_nsa(unsigned char* ws) {
    const int bx = blockIdx.x, G = gridDim.x;
    const int vcu = (G % 8 == 0) ? (bx % 8) * (G / 8) + bx / 8 : bx;
#pragma unroll 1
    for (int uu = vcu; uu < 1024; uu += G) {
        const int pr = uu & 255, it = uu >> 8, bg = pr >> 3, s = pr & 7;
        const int qblk = (it == 0) ? s : (it == 1) ? 15 - s : (it == 2) ? 16 + s : 31 - s;
        nsa_unit(bg, qblk, ws, LDS_PTR());
    }
}

constexpr size_t WS_BAR = 960 * 1024;
constexpr int LDS_BARST = LDS_BYTES - 16;
#define XB_TMO      128
#define XB_XCNT(j)  (256  + 64 * (j))
#define XB_XSUB(j)  (1280 + 64 * (j))
#define XB_XGEN(j)  (2304 + 64 * (j))
#define XB_TOP      3328
#define XB_TOPGEN   3392
#define XCD_BAR_WORDS 3456
#define XB_SPIN_CAP (1u << 18)
DI unsigned xb_ld(unsigned* p)              { return __hip_atomic_load(p, __ATOMIC_RELAXED, __HIP_MEMORY_SCOPE_AGENT); }
DI unsigned xb_add(unsigned* p, unsigned v) { return __hip_atomic_fetch_add(p, v, __ATOMIC_RELAXED, __HIP_MEMORY_SCOPE_AGENT); }
DI unsigned xb_xcc_id() { return (unsigned)__builtin_amdgcn_s_getreg((3 << 11) | 20) & 0xFu; }
#define XB_SPIN(cond, bar) do { unsigned _sp = 0; while (cond) { __builtin_amdgcn_s_sleep(1); \
    if ((++_sp & 255u) == 0u) { if (xb_ld(&(bar)[XB_TMO])) break; if (_sp > XB_SPIN_CAP) { atomicAdd(&(bar)[XB_TMO], 1u); break; } } } } while (0)
DI void xcd_barrier_complete(unsigned* bar, unsigned x, unsigned& nloc, unsigned& nx) {
    const unsigned G = gridDim.x * gridDim.y * gridDim.z;
    unsigned sum, cnt, mine, sp = 0u;
    for (;;) {
        sum = 0u; cnt = 0u; mine = 0u;
#pragma unroll
        for (unsigned j = 0; j < 16; ++j) { const unsigned c = xb_ld(&bar[XB_XCNT(j)]); sum += c; cnt += (c > 0u) ? 1u : 0u; mine = (j == x) ? c : mine; }
        if (sum == G) break;
        __builtin_amdgcn_s_sleep(1);
        if ((++sp & 255u) == 0u) { if (xb_ld(&bar[XB_TMO])) break; if (sp > XB_SPIN_CAP) { atomicAdd(&bar[XB_TMO], 1u); break; } }
    }
    nloc = mine > 0u ? mine : 1u; nx = cnt > 0u ? cnt : 1u;
}
DI void xcd_barrier(unsigned* bar) {
    asm volatile("s_waitcnt vmcnt(0)" ::: "memory");
    __syncthreads();
    if (threadIdx.x == 0) {
        volatile LAS unsigned* st = (volatile LAS unsigned*)(LDS_PTR() + LDS_BARST);
        const unsigned x = xb_xcc_id();
        __builtin_amdgcn_s_waitcnt(0);
        unsigned nloc = st[0], nx = st[1];
        if (nloc == 0u) { xcd_barrier_complete(bar, x, nloc, nx); st[0] = nloc; st[1] = nx; }
        const unsigned old = xb_add(&bar[XB_XSUB(x)], 1u);
        const unsigned gen = old / nloc;
        if (old + 1u == (gen + 1u) * nloc) {
            __builtin_amdgcn_fence(__ATOMIC_RELEASE, "agent");
            asm volatile("s_waitcnt vmcnt(0)" ::: "memory");
            const unsigned og = xb_add(&bar[XB_TOP], 1u);
            const unsigned tg = og / nx;
            if (og + 1u == (tg + 1u) * nx) xb_add(&bar[XB_TOPGEN], 1u);
            else XB_SPIN(xb_ld(&bar[XB_TOPGEN]) == tg, bar);
            __builtin_amdgcn_fence(__ATOMIC_ACQUIRE, "agent");
            xb_add(&bar[XB_XGEN(x)], 1u);
            asm volatile("s_waitcnt vmcnt(0)" ::: "memory");
        } else {
            XB_SPIN(xb_ld(&bar[XB_XGEN(x)]) == gen, bar);
            __builtin_amdgcn_fence(__ATOMIC_ACQUIRE, "agent");
            asm volatile("s_waitcnt vmcnt(0)" ::: "memory");
        }
    }
    __syncthreads();
}

DI KArgs oargs() { auto p = __builtin_amdgcn_kernarg_segment_ptr(); asm volatile("" : "+s"(p)); return (KArgs)p; }

DI void ph_prologue() {
    KArgs ka = oargs();
    LAS unsigned char* lds = LDS_PTR(); unsigned char* ws = ka->ws; float* mod = (float*)(ws + WS_MOD);
    const int tid = otid(), lane = tid & 63, wave = __builtin_amdgcn_readfirstlane(tid >> 6), G = gridDim.x, bx = blockIdx.x, gw = bx * NWV + wave, ngw = G * NWV;
#ifdef PROBE_ADA
    const unsigned long long tp0 = __builtin_amdgcn_s_memrealtime();
#endif
    if (bx < 72) {
        LAS float* cact = (LAS float*)lds;
        LAS float* red = (LAS float*)(lds + 65536);
        const float* c = ka->in[1]; const float* wada = ka->in[2]; const float* bada = ka->in[3];
        for (int i = tid; i < NB * DM; i += NTHR) { const float v = c[i]; cact[i] = v * sigm(v); }
        __syncthreads();
        const int col = bx * 256 + 4 * lane;
        f32x4 acc[8];
#pragma unroll
        for (int b = 0; b < 8; ++b) acc[b] = (f32x4){0.f, 0.f, 0.f, 0.f};
        const float* wp = wada + (size_t)(wave * 256) * (NADA * DM) + col;
        f32x4 wn[8];
#pragma unroll
        for (int e = 0; e < 8; ++e) wn[e] = *(const f32x4*)(wp + (size_t)e * (NADA * DM));
#pragma unroll 1
        for (int k = 0; k < 256; k += 8) {
            f32x4 w[8];
#pragma unroll
            for (int e = 0; e < 8; ++e) w[e] = wn[e];
            if (k + 8 < 256) {
#pragma unroll
                for (int e = 0; e < 8; ++e) wn[e] = *(const f32x4*)(wp + (size_t)(k + 8 + e) * (NADA * DM)); }
#pragma unroll
            for (int e = 0; e < 8; ++e)
#pragma unroll
                for (int b = 0; b < 8; ++b) acc[b] += w[e] * cact[b * DM + wave * 256 + k + e];
        }
#pragma unroll
        for (int b = 0; b < 8; ++b) *(LAS f32x4*)(red + (wave * 8 + b) * 256 + 4 * lane) = acc[b];
        __syncthreads();
#pragma unroll
        for (int e = 0; e < 4; ++e) { const int idx = tid + 512 * e, b = idx >> 8, cc = idx & 255; float sum = bada[bx * 256 + cc];
#pragma unroll
            for (int w = 0; w < 8; ++w) sum += red[(w * 8 + b) * 256 + cc];
            mod[b * (NADA * DM) + bx * 256 + cc] = sum; }
        __syncthreads();
    }
#ifdef PROBE_ADA
    { const unsigned long long tp1 = __builtin_amdgcn_s_memrealtime(); while (__builtin_amdgcn_s_memrealtime() - tp1 < tp1 - tp0) __builtin_amdgcn_s_sleep(8); }
#endif
    {
        const int nada = (G > 72) ? 72 : 0, nslots = (G - nada) * NWV * 2 + nada * NWV;
        const int slot0 = (bx >= nada) ? ((bx - nada) * NWV + wave) * 2 : (G - nada) * NWV * 2 + bx * NWV + wave, nslot = (bx >= nada) ? 2 : 1;
        conv_jobs_w(0, 9, ka, lds, slot0, nslot, nslots, wave, lane);
        conv_jobs_w(11, 12, ka, lds, slot0, nslot, nslots, wave, lane);
    }
    {
        const int idx = bx * NTHR + tid;
        if (idx < SEQ * 16) { const int pos = idx >> 4, i = idx & 15;
            const float invf = __builtin_amdgcn_exp2f(-(float)i * 1.1832230356f); const float ang = (float)pos * invf;
            const float rev = ang * 0.15915494309189535f, fr = rev - floorf(rev);
            float* rp = (float*)(ws + WS_ROPE) + pos * 32; rp[i] = __builtin_amdgcn_cosf(fr); rp[16 + i] = __builtin_amdgcn_sinf(fr); }
    }
    __syncthreads();
}
template <bool RES, bool MODU>
DI void rows_run(const bf16_t* F, const float* X, float* XO, const float* gatebase, const float* pg, float wgt, const float* g, const float* shbase, const float* scbase, bf16_t* U, int lane, int gw, int ngw) {
    u32x4 fN[4]; f32x4 xN[8];
    if (gw < T) {
        if (RES) {
#pragma unroll
            for (int j = 0; j < 4; ++j) fN[j] = *(const u32x4*)(F + (size_t)gw * DM + 512 * j + 8 * lane); }
        row_load(xN, X + (size_t)gw * DM, lane);
    }
#pragma unroll 1
    for (int row = gw; row < T; row += ngw) {
        f32x4 v[8], fv[8];
#pragma unroll
        for (int q = 0; q < 8; ++q) v[q] = xN[q];
        if (RES) {
#pragma unroll
            for (int j = 0; j < 4; ++j) { const u32x4 w = fN[j]; fv[2 * j] = (f32x4){bflo(w.x), bfhi(w.x), bflo(w.y), bfhi(w.y)}; fv[2 * j + 1] = (f32x4){bflo(w.z), bfhi(w.z), bflo(w.w), bfhi(w.w)}; } }
        const int nrow = row + ngw;
        if (nrow < T) {
            if (RES) {
#pragma unroll
                for (int j = 0; j < 4; ++j) fN[j] = *(const u32x4*)(F + (size_t)nrow * DM + 512 * j + 8 * lane); }
            row_load(xN, X + (size_t)nrow * DM, lane);
        }
        const int b = row >> 11; const size_t mo = (size_t)b * (NADA * DM);
        if (RES) {
            const float rs = row_rstd(fv);
#pragma unroll
            for (int j = 0; j < 8; ++j) { const int c = rcol(j, lane); const f32x4 gt = *(const f32x4*)(gatebase + mo + c), pp = *(const f32x4*)(pg + c);
                v[j] = v[j] + (gt * wgt) * (fv[j] * rs * pp); *(f32x4*)(XO + (size_t)row * DM + c) = v[j]; }
        }
        if (MODU) { const float rs2 = row_rstd(v); row_modulate_store(v, rs2, g, shbase + mo, scbase + mo, U + (size_t)row * DM, lane); }
    }
}
DI void ph_rows(int which) {
    KArgs ka = oargs(); unsigned char* ws = ka->ws; float* out = ka->out; const float* mod = (const float*)(ws + WS_MOD);
    const int tid = otid(), lane = tid & 63, wave = __builtin_amdgcn_readfirstlane(tid >> 6), G = gridDim.x, bx = blockIdx.x, gw = bx * NWV + wave, ngw = G * NWV;
    bf16_t* U = (bf16_t*)(ws + WS_U);
    if (which == 0) rows_run<false, true>(nullptr, ka->in[0], nullptr, nullptr, nullptr, 0.f, ka->in[4], mod + 0 * DM, mod + 1 * DM, U, lane, gw, ngw);
    else if (which == 1) rows_run<true, true>((const bf16_t*)(ws + WS_F), ka->in[0], out, mod + 2 * DM, ka->in[5], 0.5f, ka->in[9], mod + 3 * DM, mod + 4 * DM, U, lane, gw, ngw);
    else if (which == 2) rows_run<true, true>((const bf16_t*)(ws + WS_FMIX), out, out, mod + 5 * DM, ka->in[10], 1.0f, ka->in[28], mod + 6 * DM, mod + 7 * DM, U, lane, gw, ngw);
    else rows_run<true, false>((const bf16_t*)(ws + WS_F), out, out, mod + 8 * DM, ka->in[29], 0.5f, nullptr, nullptr, nullptr, nullptr, lane, gw, ngw);
}

DI void ph_pebias() {
    const int G = gridDim.x, bx = blockIdx.x;
    if (bx < G - 2) return;
    KArgs ka = oargs(); unsigned char* ws = ka->ws;
    const int tid = otid(), src = bx - (G - 2); const float* pe = ka->in[src ? 22 : 19]; const float* w1 = ka->in[src ? 23 : 20];
    LAS f32x4* red = (LAS f32x4*)LDS_PTR();
    const int d4 = tid & 31, kq = tid >> 5;
    f32x4 acc = {0.f, 0.f, 0.f, 0.f};
#pragma unroll 1
    for (int k = kq * 256; k < kq * 256 + 256; k += 16) {
        f32x4 w[16]; float pv[16];
#pragma unroll
        for (int e = 0; e < 16; ++e) { w[e] = *(const f32x4*)(w1 + (size_t)(k + e) * 128 + 4 * d4); pv[e] = pe[k + e]; }
#pragma unroll
        for (int e = 0; e < 16; ++e) acc += w[e] * pv[e];
    }
    __syncthreads();
    red[tid] = acc; __syncthreads();
    if (tid < 32) { f32x4 sum = red[tid];
#pragma unroll
        for (int q = 1; q < 16; ++q) sum += red[q * 32 + tid];
        *(f32x4*)((float*)(ws + WS_PEB) + src * 128 + 4 * tid) = sum; }
    __syncthreads();
}

DI void ph_conv_ffn2() {
    const int G = gridDim.x, bx = blockIdx.x, nlong = (3136 % G);
    if (G <= nlong || bx < nlong) return;
    KArgs ka = oargs();
    const int tid = otid(), lane = tid & 63, wave = __builtin_amdgcn_readfirstlane(tid >> 6);
    __syncthreads();
    conv_jobs_w(9, 11, ka, LDS_PTR(), (bx - nlong) * NWV + wave, 1, (G - nlong) * NWV, wave, lane);
    __syncthreads();
}

__global__ void __launch_bounds__(NTHR) fwd_kernel(Args args_unused) {
    cg::grid_group grid = cg::this_grid();
    {
        volatile LAS unsigned* st = (volatile LAS unsigned*)(LDS_PTR() + LDS_BARST);
        if (threadIdx.x < 2) st[threadIdx.x] = 0u;
        __syncthreads();
        if (threadIdx.x == 0) (void)xb_add((unsigned*)(oargs()->ws + WS_BAR) + XB_XCNT(xb_xcc_id()), 1u);
    }
#ifndef PH_MASK
#define PH_MASK 0xffff
#endif
#define WSP() (oargs()->ws)
#ifndef PROBE_DUP
#define PROBE_DUP 0
#endif
#ifndef PROBE_SPIN
#define PROBE_SPIN 0
#endif
#define RUN(k, bit, body) if (oargs()->ph_lo <= (k) && (k) < oargs()->ph_hi) { unsigned long long _t0 = 0; if (((PROBE_SPIN) >> (k)) & 1) _t0 = __builtin_amdgcn_s_memrealtime(); \
    for (int _rep = 0; _rep < 1 + (((PROBE_DUP) >> (bit)) & 1); ++_rep) if (((PH_MASK) >> (bit)) & 1) { body; } \
    if (((PROBE_SPIN) >> (k)) & 1) { __syncthreads(); const unsigned long long _t1 = __builtin_amdgcn_s_memrealtime(); while (__builtin_amdgcn_s_memrealtime() - _t1 < _t1 - _t0) __builtin_amdgcn_s_sleep(8); } }
#define SEAMX(k) if (oargs()->ph_lo <= (k) && (k) + 1 < oargs()->ph_hi) { if (oargs()->ph_hi > 1000) grid.sync(); else xcd_barrier((unsigned*)(oargs()->ws + WS_BAR)); }
    RUN(0, 0, ph_prologue()) SEAMX(0)
    RUN(1, 1, ph_rows(0)) SEAMX(1)
    RUN(2, 2, ph_ffn_up(WSP())) SEAMX(2)
    RUN(3, 3, ph_ffn_down(WSP())) SEAMX(3)
    RUN(4, 4, ph_rows(1)) SEAMX(4)
    RUN(5, 5, ph_inproj(WSP()); ph_vt(WSP()); ph_pebias(); ph_conv_ffn2()) SEAMX(5)
    RUN(6, 6, ph_cmp1(WSP())) SEAMX(6)
    RUN(7, 7, ph_cmp2(WSP()); __syncthreads(); ph_lru_fused(oargs()->ws, oargs()->in[12], oargs()->in[13], oargs()->in[15], oargs()->in[17], oargs()->in[18]))
    SEAMX(7)
    RUN(8, 8, ph_nsa(WSP())) SEAMX(8)
    RUN(9, 9, ph_ya(WSP()))
    RUN(10, 10, ph_yb(WSP())) SEAMX(10)
    RUN(11, 11, ph_out(WSP())) SEAMX(11)
    RUN(12, 12, ph_rows(2)) SEAMX(12)
    RUN(13, 2, ph_ffn_up(WSP())) SEAMX(13)
    RUN(14, 3, ph_ffn_down(WSP())) SEAMX(14)
    RUN(15, 15, ph_rows(3))
}

extern "C" void kernel_launch(void* const* d_in, const int* in_sizes, int n_in, void* d_out, int out_size, void* d_ws, size_t ws_size, hipStream_t stream) {
    static int grid = 0;
    if (grid == 0) {
        if (n_in != 33 || out_size != T * DM || ws_size < WS_END) { fprintf(stderr, "kernel_launch: unexpected problem (n_in %d out %d ws %zu)\n", n_in, out_size, ws_size); grid = -1; return; }
        int dev = 0, cus = 0, per_cu = 0;
        hipGetDevice(&dev); hipDeviceGetAttribute(&cus, hipDeviceAttributeMultiprocessorCount, dev);
        if (hipFuncSetAttribute((const void*)fwd_kernel, hipFuncAttributeMaxDynamicSharedMemorySize, LDS_BYTES) != hipSuccess) { fprintf(stderr, "kernel_launch: hipFuncSetAttribute failed\n"); grid = -1; return; }
        if (hipOccupancyMaxActiveBlocksPerMultiprocessor(&per_cu, (const void*)fwd_kernel, NTHR, LDS_BYTES) != hipSuccess || per_cu < 1) { fprintf(stderr, "kernel_launch: occupancy query gives %d\n", per_cu); per_cu = 1; }
        (void)hipGetLastError();
        grid = cus;
    }
    if (grid < 0) return;
    if (hipMemsetAsync((char*)d_ws + WS_BAR, 0, 16384, stream) != hipSuccess) { fprintf(stderr, "kernel_launch: memset of the barrier words failed\n"); return; }
    Args a{};
    for (int i = 0; i < 33; ++i) a.in[i] = (const float*)d_in[i];
    a.out = (float*)d_out; a.ws = (unsigned char*)d_ws;
#if ONE_LAUNCH
    a.ph_lo = 0; a.ph_hi = 16;
    void* params[] = {&a};
    hipError_t e = hipLaunchCooperativeKernel((const void*)fwd_kernel, dim3(grid), dim3(NTHR), params, LDS_BYTES, stream);
    if (e != hipSuccess) fprintf(stderr, "cooperative launch failed: %s (grid %d)\n", hipGetErrorString(e), grid);
#else
    for (int p = 0; p < 16; ++p) { a.ph_lo = p; a.ph_hi = p + 1; hipLaunchKernelGGL(fwd_kernel, dim3(grid), dim3(NTHR), LDS_BYTES, stream, a); }
#endif
}
```

```cpp
#include <hip/hip_runtime.h>
#include <hip/hip_cooperative_groups.h>
#include <cstdio>
#include <cstdint>
namespace cg = cooperative_groups;


#ifndef ONE_LAUNCH
#define ONE_LAUNCH 1
#endif

#define LAS __attribute__((address_space(3)))
#define DI __device__ __forceinline__
typedef unsigned short bf16_t;
typedef short bf16x8 __attribute__((ext_vector_type(8)));
typedef short s16x4 __attribute__((ext_vector_type(4)));
typedef float f32x2 __attribute__((ext_vector_type(2)));
typedef float f32x4 __attribute__((ext_vector_type(4)));
typedef float f32x16 __attribute__((ext_vector_type(16)));
typedef unsigned u32x2 __attribute__((ext_vector_type(2)));
typedef unsigned u32x4 __attribute__((ext_vector_type(4)));
typedef __bf16 bf16x2_t __attribute__((ext_vector_type(2)));

constexpr int DM = 2048, NB = 8, SEQ = 2048, T = NB * SEQ, DFF = 5632, NADA = 9;
constexpr int INW = 13360;
constexpr int NTHR = 512, NWV = 8;
constexpr float EPS = 1e-6f;
constexpr size_t MiB = 1u << 20;
constexpr size_t WS_MOD = 0;
constexpr size_t WS_ROPE = 640 * 1024;
constexpr size_t WS_PEB = 900 * 1024;
constexpr size_t WS_W2T = 1 * MiB;
constexpr size_t WS_WGU = 2 * MiB, WS_WD = 46 * MiB;
constexpr size_t WS_BB = 2 * MiB;
constexpr size_t WS_WIN = 68 * MiB, WS_WV = 117 * MiB, WS_WA = 640 * MiB, WS_WB = 648 * MiB, WS_WO = 656 * MiB;
constexpr size_t WS_HG = 68 * MiB;
constexpr size_t WS_PART = 68 * MiB;
constexpr size_t WS_W1T = 145 * MiB, WS_WRI = 147 * MiB, WS_KCC = 152 * MiB, WS_VCT = 153 * MiB, WS_NG = 154 * MiB;
constexpr size_t WS_U = 160 * MiB;
constexpr size_t WS_H = 224 * MiB, WS_F = 400 * MiB;
constexpr size_t WS_XA = 224 * MiB, WS_GY = 288 * MiB, WS_Q = 352 * MiB, WS_KC = 416 * MiB, WS_VC = 432 * MiB, WS_KS = 448 * MiB, WS_KW = 464 * MiB;
constexpr size_t WS_VST = 480 * MiB, WS_VWT = 496 * MiB, WS_MG = 512 * MiB, WS_FMIX = 512 * MiB;
constexpr size_t WS_END = 664 * MiB;
constexpr int LDS_BYTES = 147456;

struct Args { const float* in[33]; float* out; unsigned char* ws; int ph_lo, ph_hi; };
typedef const Args __attribute__((address_space(4)))* KArgs;

DI unsigned pk2(float lo, float hi) { f32x2 v = {lo, hi}; bf16x2_t b = __builtin_convertvector(v, bf16x2_t); return __builtin_bit_cast(unsigned, b); }
DI float bf2f(bf16_t v) { return __uint_as_float((unsigned)v << 16); }
DI float bflo(unsigned w) { return __uint_as_float(w << 16); }
DI float bfhi(unsigned w) { return __uint_as_float(w & 0xffff0000u); }
DI float sigm(float x) { return __builtin_amdgcn_rcpf(1.f + __builtin_amdgcn_exp2f(-1.4426950408889634f * x)); }
DI float gelu_t(float x) { const float u = 0.7978845608028654f * (x + 0.044715f * x * x * x); return x * __builtin_amdgcn_rcpf(1.f + __builtin_amdgcn_exp2f(-2.8853900817779268f * u)); }
DI float wave_sum(float v) {
#pragma unroll
    for (int o = 1; o < 64; o <<= 1) v += __shfl_xor(v, o);
    return v;
}
#define LDS_WAIT() asm volatile("s_waitcnt lgkmcnt(0)" ::: "memory")
DI int otid() { int t = threadIdx.x; asm volatile("" : "+v"(t)); return t; }

namespace pg8 {
constexpr int BM = 256, BK = 64, HALF = 128, HTB = HALF * BK * 2, STAGE_BYTES = 8 * HTB, NXCD = 8, WGM = 8;
DI int lds_byte(int r, int c) { const int st = (r >> 4) * 2 + (c >> 5), rr = r & 15, cc = c & 31, ob = rr * 64 + cc * 2; return st * 1024 + (ob ^ (((ob >> 9) & 1) << 5)); }
DI void stage_rc(int b, int& R, int& C) { const int st = b / 1024, sb = b % 1024, swz = sb ^ (((sb >> 9) & 1) << 5); R = (st >> 1) * 16 + swz / 64; C = (st & 1) * 32 + (swz % 64) / 2; }
DI int perm32(int rho) { const int n = rho >> 4, i = rho & 15; return 8 * (i >> 2) + 4 * n + (i & 3); }

struct Unit { int pm, pn; long aoff, boff; };
struct Gemm { const bf16_t* A; const bf16_t* Bt; int lda, ldb, K; };
struct Sched {
    int nM, nN, nwg, G, c, mode; long astep, bstep, srcstride;
    DI void init(int nM_, int nN_, int G_, int c_, long astep_, long bstep_) { nM = nM_; nN = nN_; nwg = nM * nN; G = G_; c = c_; mode = 0; astep = astep_; bstep = bstep_; srcstride = 0; }
    DI bool next(int i, Unit& u) const {
        const long L = (long)i * G + c; if (L >= nwg) return false;
        int wgid = (int)L;
        if (mode == 1) {
            const int pm = wgid & 15, ks = (wgid >> 4) & 7, src = wgid >> 7;
            u.pm = pm; u.pn = src + 2 * ks; u.aoff = (long)src * srcstride + (long)pm * 256 * 2048 * 2 + (long)ks * 1024; u.boff = (long)ks * 1024; return true;
        }
        { const int q = nwg / NXCD, r = nwg % NXCD, xcd = wgid % NXCD, off = wgid / NXCD; wgid = (xcd < r ? xcd * (q + 1) : r * (q + 1) + (xcd - r) * q) + off; }
        const int nig = WGM * nN, gid = wgid / nig, fm = gid * WGM, gsz = (nM - fm) < WGM ? (nM - fm) : WGM;
        u.pm = fm + ((wgid % nig) % gsz); u.pn = (wgid % nig) / gsz; u.aoff = (long)u.pm * astep; u.boff = (long)u.pn * bstep; return true;
    }
};

template <class Epi>
DI void gemm_phase(LAS unsigned char* lds, const Gemm g, const Sched& S, const Epi& E) {
    const int tid = otid(), wid = __builtin_amdgcn_readfirstlane(tid >> 6), lane = tid & 63, wr = wid >> 2, wc = wid & 3, fr = lane & 15, fq = lane >> 4;
    const int K = g.K, nt = K / BK;
    unsigned voffA[2], voffB[2];
#pragma unroll
    for (int i = 0; i < 2; ++i) { int R, C; stage_rc(tid * 16 + i * 8192, R, C); const int Rb = Epi::PERM ? ((R & ~31) + perm32(R & 31)) : R;
        voffA[i] = (unsigned)(R * g.lda + C) * 2u; voffB[i] = (unsigned)(Rb * g.ldb + C) * 2u; }
    const size_t kstep = (size_t)(BK * 2);
    const size_t hsA = (size_t)HALF * g.lda * 2, hsB = (size_t)HALF * g.ldb * 2;
    const unsigned ldsw = (unsigned)wid * 1024u;
    const int aoff = lds_byte(wr * 64 + fr, fq * 8), boff = lds_byte(wc * 32 + fr, fq * 8);
#define PG8_SA(b, h) (((b) * 2 + (h)) * HTB)
#define PG8_SB(b, h) ((4 + (b) * 2 + (h)) * HTB)
#define PG8_STAGE(bufoff, gbase, voff) do { _Pragma("unroll") for (int _i = 0; _i < 2; ++_i) \
        __builtin_amdgcn_global_load_lds((const unsigned*)((const char*)(gbase) + (voff)[_i]), (LAS unsigned*)(lds + (bufoff) + ldsw + _i * 8192), 16, 0, 0); } while (0)
#define PG8_LDA(dst, b, h) do { _Pragma("unroll") for (int m = 0; m < 4; ++m) _Pragma("unroll") for (int k = 0; k < 2; ++k) dst[m][k] = *(const LAS bf16x8*)(lds + PG8_SA(b, h) + aoff + m * 2048 + k * 1024); } while (0)
#define PG8_LDB(dst, b, h) do { _Pragma("unroll") for (int n = 0; n < 2; ++n) _Pragma("unroll") for (int k = 0; k < 2; ++k) dst[n][k] = *(const LAS bf16x8*)(lds + PG8_SB(b, h) + boff + n * 2048 + k * 1024); } while (0)
#define PG8_MMA(ai, bj, At, Bt) do { __builtin_amdgcn_s_setprio(1); _Pragma("unroll") for (int m = 0; m < 4; ++m) _Pragma("unroll") for (int n = 0; n < 2; ++n) _Pragma("unroll") for (int k = 0; k < 2; ++k) \
        acc[ai][bj][m][n] = __builtin_amdgcn_mfma_f32_16x16x32_bf16(Bt[n][k], At[m][k], acc[ai][bj][m][n], 0, 0, 0); __builtin_amdgcn_s_setprio(0); } while (0)
#define PG8_WAIT_V(n) asm volatile("s_waitcnt vmcnt(" #n ")" ::: "memory")
#define PG8_WAIT_L(n) asm volatile("s_waitcnt lgkmcnt(" #n ")" ::: "memory")
#define PG8_BAR __builtin_amdgcn_s_barrier()
#define PG8_SCHED __builtin_amdgcn_sched_barrier(0)
    Unit cur, nxt; int ui = 0;
    if (!S.next(0, cur)) return;
    f32x4 acc[2][2][4][2];
#pragma unroll
    for (int a = 0; a < 2; ++a)
#pragma unroll
        for (int b = 0; b < 2; ++b)
#pragma unroll
            for (int m = 0; m < 4; ++m)
#pragma unroll
                for (int n = 0; n < 2; ++n) acc[a][b][m][n] = (f32x4){0.f, 0.f, 0.f, 0.f};
    bf16x8 At[4][2], B0[2][2], B1[2][2];
    const char* cA = (const char*)g.A + cur.aoff; const char* cB = (const char*)g.Bt + cur.boff;
    PG8_STAGE(PG8_SB(0, 0), cB, voffB); PG8_STAGE(PG8_SB(0, 1), cB + hsB, voffB); PG8_STAGE(PG8_SA(0, 0), cA, voffA); PG8_STAGE(PG8_SA(0, 1), cA + hsA, voffA);
    if (wr == 1) PG8_BAR;
    PG8_WAIT_V(2); PG8_BAR;
    PG8_STAGE(PG8_SB(1, 0), cB + kstep, voffB); PG8_STAGE(PG8_SA(1, 0), cA + kstep, voffA); PG8_STAGE(PG8_SB(1, 1), cB + hsB + kstep, voffB);
    PG8_WAIT_V(6); PG8_BAR;
    for (;;) {
        const bool has_next = S.next(ui + 1, nxt);
        const char* nA = has_next ? (const char*)g.A + nxt.aoff : cA; const char* nB = has_next ? (const char*)g.Bt + nxt.boff : cB;
        for (int t = 0; t < nt; t += 2) {
            const bool last = (t == nt - 2);
            const char* a1 = cA + (size_t)(t + 1) * kstep;
            const char* a2 = last ? nA : cA + (size_t)(t + 2) * kstep; const char* b2 = last ? nB : cB + (size_t)(t + 2) * kstep;
            const char* a3 = a2 + kstep; const char* b3 = b2 + kstep;
            PG8_LDB(B0, 0, 0); PG8_LDB(B1, 0, 1); PG8_SCHED; PG8_LDA(At, 0, 0); PG8_STAGE(PG8_SA(1, 1), a1 + hsA, voffA);
            PG8_WAIT_V(8); PG8_WAIT_L(0); PG8_BAR; PG8_MMA(0, 0, At, B0); PG8_MMA(0, 1, At, B1); PG8_BAR; PG8_SCHED;
            PG8_LDA(At, 0, 1); PG8_STAGE(PG8_SB(0, 0), b2, voffB); PG8_STAGE(PG8_SB(0, 1), b2 + hsB, voffB); PG8_STAGE(PG8_SA(0, 0), a2, voffA);
            PG8_WAIT_V(8); PG8_WAIT_L(0); PG8_BAR; PG8_MMA(1, 0, At, B0); PG8_MMA(1, 1, At, B1); PG8_BAR; PG8_SCHED;
            PG8_LDB(B0, 1, 0); PG8_LDB(B1, 1, 1); PG8_SCHED; PG8_LDA(At, 1, 0); PG8_STAGE(PG8_SA(0, 1), a2 + hsA, voffA);
            PG8_WAIT_V(8); PG8_WAIT_L(0); PG8_BAR; PG8_MMA(0, 0, At, B0); PG8_MMA(0, 1, At, B1); PG8_BAR; PG8_SCHED;
            PG8_LDA(At, 1, 1); PG8_STAGE(PG8_SB(1, 0), b3, voffB); PG8_STAGE(PG8_SB(1, 1), b3 + hsB, voffB); PG8_STAGE(PG8_SA(1, 0), a3, voffA);
            PG8_WAIT_V(8); PG8_WAIT_L(0); PG8_BAR; PG8_MMA(1, 0, At, B0); PG8_MMA(1, 1, At, B1); PG8_BAR; PG8_SCHED;
        }
        if (wr == 0) PG8_BAR;
        E(acc, cur, wr, wc, fr, fq);
        if (!has_next) break;
#pragma unroll
        for (int a = 0; a < 2; ++a)
#pragma unroll
            for (int b = 0; b < 2; ++b)
#pragma unroll
                for (int m = 0; m < 4; ++m)
#pragma unroll
                    for (int n = 0; n < 2; ++n) acc[a][b][m][n] = (f32x4){0.f, 0.f, 0.f, 0.f};
        cur = nxt; cA = nA; cB = nB; ++ui;
        if (wr == 1) PG8_BAR;
    }
    PG8_WAIT_V(0);
    PG8_BAR;
#undef PG8_SA
#undef PG8_SB
#undef PG8_STAGE
#undef PG8_LDA
#undef PG8_LDB
#undef PG8_MMA
#undef PG8_WAIT_V
#undef PG8_WAIT_L
#undef PG8_BAR
#undef PG8_SCHED
}
}
using pg8::Unit;
typedef f32x4 AccT[2][2][4][2];

struct EpiFFN {
    static constexpr bool PERM = true; bf16_t* H;
    DI void operator()(const AccT& acc, const Unit& u, int wr, int wc, int fr, int fq) const {
        const int col = u.pn * 128 + wc * 32 + fq * 8;
#pragma unroll
        for (int ai = 0; ai < 2; ++ai)
#pragma unroll
            for (int m = 0; m < 4; ++m) {
                const int row = u.pm * 256 + ai * 128 + wr * 64 + m * 16 + fr;
                float v[8];
#pragma unroll
                for (int n = 0; n < 2; ++n)
#pragma unroll
                    for (int e = 0; e < 4; ++e) { const float gt = acc[ai][0][m][n][e], up = acc[ai][1][m][n][e]; v[n * 4 + e] = gt * sigm(gt) * up; }
                u32x4 w; w.x = pk2(v[0], v[1]); w.y = pk2(v[2], v[3]); w.z = pk2(v[4], v[5]); w.w = pk2(v[6], v[7]);
                *(u32x4*)(H + (size_t)row * DFF + col) = w;
            }
    }
};
struct EpiBf {
    static constexpr bool PERM = true; bf16_t* O;
    DI void operator()(const AccT& acc, const Unit& u, int wr, int wc, int fr, int fq) const {
#pragma unroll
        for (int ai = 0; ai < 2; ++ai)
#pragma unroll
            for (int m = 0; m < 4; ++m) {
                const int row = u.pm * 256 + ai * 128 + wr * 64 + m * 16 + fr;
#pragma unroll
                for (int bj = 0; bj < 2; ++bj) { const f32x4 v0 = acc[ai][bj][m][0], v1 = acc[ai][bj][m][1];
                    u32x4 w; w.x = pk2(v0[0], v0[1]); w.y = pk2(v0[2], v0[3]); w.z = pk2(v1[0], v1[1]); w.w = pk2(v1[2], v1[3]);
                    *(u32x4*)(O + (size_t)row * DM + u.pn * 256 + bj * 128 + wc * 32 + fq * 8) = w; }
            }
    }
};
struct EpiPart {
    static constexpr bool PERM = false; float* P;
    DI void operator()(const AccT& acc, const Unit& u, int wr, int wc, int fr, int fq) const {
        const int src = u.pn & 1, ks = u.pn >> 1;
        float* base = P + ((size_t)(ks * 2 + src) * 4096) * 128;
#pragma unroll
        for (int ai = 0; ai < 2; ++ai)
#pragma unroll
            for (int m = 0; m < 4; ++m) {
                const int row = u.pm * 256 + ai * 128 + wr * 64 + m * 16 + fr;
#pragma unroll
                for (int n = 0; n < 2; ++n) { const f32x4 v = src ? acc[ai][1][m][n] : acc[ai][0][m][n]; *(f32x4*)(base + (size_t)row * 128 + wc * 32 + n * 16 + fq * 4) = v; }
            }
    }
};
struct EpiVT {
    static constexpr bool PERM = true; bf16_t* VT0; bf16_t* VT1;
    DI void operator()(const AccT& acc, const Unit& u, int wr, int wc, int fr, int fq) const {
#pragma unroll
        for (int ai = 0; ai < 2; ++ai)
#pragma unroll
            for (int m = 0; m < 4; ++m) {
                const int r = u.pm * 256 + ai * 128 + wr * 64 + m * 16 + fr;
                const int piece = r >> 9, gg = (r >> 7) & 3, d = r & 127;
                bf16_t* base = piece ? VT1 : VT0;
#pragma unroll
                for (int bj = 0; bj < 2; ++bj) {
                    const int t = u.pn * 256 + bj * 128 + wc * 32 + fq * 8, b = t >> 11, s = t & 2047;
                    const f32x4 v0 = acc[ai][bj][m][0], v1 = acc[ai][bj][m][1];
                    u32x4 w; w.x = pk2(v0[0], v0[1]); w.y = pk2(v0[2], v0[3]); w.z = pk2(v1[0], v1[1]); w.w = pk2(v1[2], v1[3]);
                    *(u32x4*)(base + ((size_t)((b * 4 + gg) * 128 + d)) * 2048 + s) = w;
                }
            }
    }
};
struct EpiGate {
    static constexpr bool PERM = true; const bf16_t* MG; const bf16_t* YAG; bf16_t* O; int mode;
    DI void operator()(const AccT& acc, const Unit& u, int wr, int wc, int fr, int fq) const {
#pragma unroll
        for (int ai = 0; ai < 2; ++ai)
#pragma unroll
            for (int m = 0; m < 4; ++m) {
                const int row = u.pm * 256 + ai * 128 + wr * 64 + m * 16 + fr;
#pragma unroll
                for (int bj = 0; bj < 2; ++bj) {
                    const int col = u.pn * 256 + bj * 128 + wc * 32 + fq * 8;
                    const u32x4 gw = *(const u32x4*)(MG + (size_t)row * 4096 + (mode ? 2048 : 0) + col);
                    const f32x4 v0 = acc[ai][bj][m][0], v1 = acc[ai][bj][m][1];
                    float o[8] = {v0[0] * bflo(gw.x), v0[1] * bfhi(gw.x), v0[2] * bflo(gw.y), v0[3] * bfhi(gw.y), v1[0] * bflo(gw.z), v1[1] * bfhi(gw.z), v1[2] * bflo(gw.w), v1[3] * bfhi(gw.w)};
                    if (mode) { const u32x4 yw = *(const u32x4*)(YAG + (size_t)row * DM + col);
                        o[0] += bflo(yw.x); o[1] += bfhi(yw.x); o[2] += bflo(yw.y); o[3] += bfhi(yw.y); o[4] += bflo(yw.z); o[5] += bfhi(yw.z); o[6] += bflo(yw.w); o[7] += bfhi(yw.w); }
                    u32x4 w; w.x = pk2(o[0], o[1]); w.y = pk2(o[2], o[3]); w.z = pk2(o[4], o[5]); w.w = pk2(o[6], o[7]);
                    *(u32x4*)(O + (size_t)row * DM + col) = w;
                }
            }
    }
};
struct EpiIn {
    static constexpr bool PERM = true; unsigned char* ws; const float* rope;
    DI void operator()(const AccT& acc, const Unit& u, int wr, int wc, int fr, int fq) const {
#pragma unroll
        for (int bj = 0; bj < 2; ++bj) {
            const int c0 = u.pn * 256 + bj * 128 + wc * 32;
            const int col = c0 + fq * 8;
#pragma unroll
            for (int ai = 0; ai < 2; ++ai)
#pragma unroll
                for (int m = 0; m < 4; ++m) {
                    const int row = u.pm * 256 + ai * 128 + wr * 64 + m * 16 + fr;
                    const int b = row >> 11, s = row & 2047;
                    float v[8];
#pragma unroll
                    for (int n = 0; n < 2; ++n)
#pragma unroll
                        for (int e = 0; e < 4; ++e) v[n * 4 + e] = acc[ai][bj][m][n][e];
                    bf16_t* dst = nullptr;
                    if (c0 < 2048) { dst = (bf16_t*)(ws + WS_XA) + ((size_t)((b * 16 + (col >> 7)) * 2048 + s)) * 128 + (col & 127); }
                    else if (c0 < 4096) {
#pragma unroll
                        for (int e = 0; e < 8; ++e) v[e] = gelu_t(v[e]);
                        { const int chn = col - 2048; dst = (bf16_t*)(ws + WS_GY) + ((size_t)((b * 32 + (chn >> 6)) * 2048 + s)) * 64 + (chn & 63); } }
                    else if (c0 < 8192) {
                        const bool isq = c0 < 6144;
                        const int pc = (c0 - 6144) >> 9;
                        if ((c0 & 127) == 0 && (isq || pc != 1)) {
#pragma unroll
                            for (int e = 0; e < 8; ++e) {
                                const float invf = __builtin_amdgcn_exp2f(-(float)(8 * (fq & 1) + e) * 1.1832230356f), ang = (float)s * invf;
                                const float rev = ang * 0.15915494309189535f, fr = rev - floorf(rev);
                                const float cs = __builtin_amdgcn_cosf(fr), sn = __builtin_amdgcn_sinf(fr);
                                const float mine = v[e], other = __shfl_xor(mine, 32); v[e] = (fq < 2) ? mine * cs - other * sn : mine * cs + other * sn; }
                        }
                        if (isq) dst = (bf16_t*)(ws + WS_Q) + (size_t)row * DM + (col - 4096);
                        else { const int gg = ((c0 - 6144) >> 7) & 3, d = col & 127; dst = (bf16_t*)(ws + WS_KC + (size_t)pc * 16 * MiB) + ((size_t)((b * 4 + gg) * 2048 + s)) * 128 + d; }
                    }
                    else if (c0 < 12288) {
#pragma unroll
                        for (int e = 0; e < 8; ++e) v[e] = sigm(v[e]);
                        dst = (bf16_t*)(ws + WS_MG) + (size_t)row * 4096 + (col - 8192); }
                    else {
                        const int cc = col - 12288;
                        if (cc < 48) { float* ng = (float*)(ws + WS_NG) + (size_t)row * 48 + cc;
                            *(f32x4*)ng = (f32x4){sigm(v[0]), sigm(v[1]), sigm(v[2]), sigm(v[3])}; *(f32x4*)(ng + 4) = (f32x4){sigm(v[4]), sigm(v[5]), sigm(v[6]), sigm(v[7])}; }
                    }
                    if (dst) { u32x4 w; w.x = pk2(v[0], v[1]); w.y = pk2(v[2], v[3]); w.z = pk2(v[4], v[5]); w.w = pk2(v[6], v[7]); *(u32x4*)dst = w; }
                }
        }
    }
};

struct ConvJob { int K, Nd; };
DI const float* conv_src(int job, int d, KArgs a, int& ld) {
    switch (job) {
    case 0: case 9: { const int pn = d >> 8, half = (d >> 7) & 1, j = d & 127; ld = DFF; const int base = job == 0 ? 6 : 30; return a->in[base + half] + 128 * pn + j; }
    case 1: ld = DM; return a->in[8] + d;
    case 10: ld = DM; return a->in[32] + d;
    case 2: { ld = INW; int col;
        if (d < 7680) col = d; else if (d < 8192) col = d + 512; else if (d < 12288) col = d - 8192 + 9264; else if (d < 12336) col = d - 12288 + 9216; else return nullptr;
        return a->in[11] + col; }
    case 3: ld = INW; return a->in[11] + (d < 512 ? 7680 + d : 8704 + (d - 512));
    case 4: ld = DM; return a->in[25] + d;
    case 5: ld = DM; return a->in[26] + d;
    case 6: ld = DM; return a->in[27] + d;
    case 7: ld = 128; return (d < 128) ? a->in[20] + d : a->in[23] + (d - 128);
    case 8: { const int h = d >> 8, half = (d >> 7) & 1, j = d & 127; ld = 128; return (half ? a->in[16] : a->in[14]) + h * 16384 + j; }
    default: ld = 128; return (d < 128) ? a->in[21] + d : a->in[24] + (d - 128);
    }
}
DI bf16_t* conv_dst(int job, unsigned char* ws) {
    switch (job) {
    case 0: case 9: return (bf16_t*)(ws + WS_WGU);
    case 1: case 10: return (bf16_t*)(ws + WS_WD);
    case 2: return (bf16_t*)(ws + WS_WIN);
    case 3: return (bf16_t*)(ws + WS_WV);
    case 4: return (bf16_t*)(ws + WS_WA);
    case 5: return (bf16_t*)(ws + WS_WB);
    case 6: return (bf16_t*)(ws + WS_WO);
    case 7: return (bf16_t*)(ws + WS_W1T);
    case 8: return (bf16_t*)(ws + WS_WRI);
    default: return (bf16_t*)(ws + WS_W2T);
    }
}
DI void conv_dims(int job, int& K, int& Nd) {
    switch (job) {
    case 0: case 9: K = DM; Nd = 11264; break;
    case 1: case 10: K = DFF; Nd = DM; break;
    case 2: K = DM; Nd = 12544; break;
    case 3: K = DM; Nd = 1024; break;
    case 4: case 5: case 6: K = DM; Nd = DM; break;
    case 7: K = 4096; Nd = 256; break;
    case 8: K = 128; Nd = 4096; break;
    default: K = 128; Nd = 256; break;
    }
}
DI void conv_item(int job, int item, KArgs a, LAS float* scr, int lane) {
    int K, Nd; conv_dims(job, K, Nd);
    const int nkb = K / 64, kb = item % nkb, nb = item / nkb, k0 = 64 * kb, n0 = 64 * nb;
    const int kk = lane >> 4, n4 = lane & 15;
    int ld; const float* src = conv_src(job, n0 + 4 * n4, a, ld);
    f32x4 v[16];
#pragma unroll
    for (int i = 0; i < 16; ++i) v[i] = src ? *(const f32x4*)(src + (size_t)(k0 + 4 * i + kk) * ld) : (f32x4){0.f, 0.f, 0.f, 0.f};
#pragma unroll
    for (int i = 0; i < 16; ++i) { LAS float* q = scr + (4 * i + kk) * 65 + 4 * n4; q[0] = v[i][0]; q[1] = v[i][1]; q[2] = v[i][2]; q[3] = v[i][3]; }
    LDS_WAIT();
    bf16_t* WT = conv_dst(job, a->ws);
    const int c = lane & 7, nn = lane >> 3;
#pragma unroll
    for (int j = 0; j < 8; ++j) { const int n = nn + 8 * j; const LAS float* q = scr + (8 * c) * 65 + n;
        u32x4 o; o.x = pk2(q[0 * 65], q[1 * 65]); o.y = pk2(q[2 * 65], q[3 * 65]); o.z = pk2(q[4 * 65], q[5 * 65]); o.w = pk2(q[6 * 65], q[7 * 65]);
        *(u32x4*)(WT + (size_t)(n0 + n) * K + k0 + 8 * c) = o; }
    LDS_WAIT();
}
DI void conv_jobs(int jlo, int jhi, KArgs a, LAS unsigned char* lds, int gw, int ngw, int wave, int lane) {
    LAS float* scr = (LAS float*)(lds + wave * 16640);
    for (int job = jlo; job < jhi; ++job) {
        int K, Nd; conv_dims(job, K, Nd);
        const int nit = (K / 64) * (Nd / 64);
        for (int it = gw; it < nit; it += ngw) conv_item(job, it, a, scr, lane);
    }
}
DI void conv_pair(int job, int itA, int itB, bool hasB, KArgs a, LAS float* scr, int lane) {
    int K, Nd; conv_dims(job, K, Nd);
    const int nkb = K / 64; const int kk = lane >> 4, n4 = lane & 15;
    const int nblk = Nd / 64; (void)nkb;
    const int k0A = 64 * (itA / nblk), n0A = 64 * (itA % nblk), k0B = 64 * (itB / nblk), n0B = 64 * (itB % nblk);
    int ldA, ldB; const float* srcA = conv_src(job, n0A + 4 * n4, a, ldA); const float* srcB = hasB ? conv_src(job, n0B + 4 * n4, a, ldB) : nullptr; if (!hasB) ldB = 0;
    f32x4 vA[16], vB[16];
#pragma unroll
    for (int i = 0; i < 16; ++i) vA[i] = srcA ? *(const f32x4*)(srcA + (size_t)(k0A + 4 * i + kk) * ldA) : (f32x4){0.f, 0.f, 0.f, 0.f};
#pragma unroll
    for (int i = 0; i < 16; ++i) vB[i] = srcB ? *(const f32x4*)(srcB + (size_t)(k0B + 4 * i + kk) * ldB) : (f32x4){0.f, 0.f, 0.f, 0.f};
    bf16_t* WT = conv_dst(job, a->ws);
    const int c = lane & 7, nn = lane >> 3;
#pragma unroll
    for (int half = 0; half < 2; ++half) {
        if (half && !hasB) break;
#pragma unroll
        for (int i = 0; i < 16; ++i) { const f32x4 t = half ? vB[i] : vA[i]; LAS float* q = scr + (4 * i + kk) * 65 + 4 * n4; q[0] = t[0]; q[1] = t[1]; q[2] = t[2]; q[3] = t[3]; }
        LDS_WAIT();
        const int n0 = half ? n0B : n0A, k0 = half ? k0B : k0A;
#pragma unroll
        for (int j = 0; j < 8; ++j) { const int n = nn + 8 * j; const LAS float* q = scr + (8 * c) * 65 + n;
            u32x4 o; o.x = pk2(q[0 * 65], q[1 * 65]); o.y = pk2(q[2 * 65], q[3 * 65]); o.z = pk2(q[4 * 65], q[5 * 65]); o.w = pk2(q[6 * 65], q[7 * 65]);
            *(u32x4*)(WT + (size_t)(n0 + n) * K + k0 + 8 * c) = o; }
        LDS_WAIT();
    }
}
DI void conv_jobs_w(int jlo, int jhi, KArgs a, LAS unsigned char* lds, int pair0, int npair, int npairs, int wave, int lane) {
    LAS float* scr = (LAS float*)(lds + wave * 16640);
    for (int job = jlo; job < jhi; ++job) {
        int K, Nd; conv_dims(job, K, Nd);
        const int nit = (K / 64) * (Nd / 64);
        for (int it0 = 0; it0 < nit; it0 += 2 * npairs)
            for (int sl = 0; sl < npair; ++sl) { const int it = it0 + 2 * (pair0 + sl); if (it < nit) conv_pair(job, it, it + 1, it + 1 < nit, a, scr, lane); }
    }
}

DI int rcol(int q, int lane) { return 512 * (q >> 1) + 8 * lane + 4 * (q & 1); }
DI void row_load(f32x4 (&v)[8], const float* p, int lane) {
#pragma unroll
    for (int q = 0; q < 8; ++q) v[q] = *(const f32x4*)(p + rcol(q, lane));
}
DI void row_load_bf16(f32x4 (&v)[8], const bf16_t* p, int lane) {
#pragma unroll
    for (int j = 0; j < 4; ++j) { const u32x4 w = *(const u32x4*)(p + 512 * j + 8 * lane);
        v[2 * j] = (f32x4){bflo(w.x), bfhi(w.x), bflo(w.y), bfhi(w.y)}; v[2 * j + 1] = (f32x4){bflo(w.z), bfhi(w.z), bflo(w.w), bfhi(w.w)}; }
}
DI float row_rstd(const f32x4 (&v)[8]) {
    float s = 0.f;
#pragma unroll
    for (int j = 0; j < 8; ++j) s += (v[j][0] * v[j][0] + v[j][1] * v[j][1]) + (v[j][2] * v[j][2] + v[j][3] * v[j][3]);
    return rsqrtf(wave_sum(s) * (1.f / DM) + EPS);
}
DI void row_modulate_store(const f32x4 (&v)[8], float rstd, const float* g, const float* sh, const float* sc, bf16_t* o, int lane) {
#pragma unroll
    for (int j = 0; j < 4; ++j) { f32x4 r[2];
#pragma unroll
        for (int e = 0; e < 2; ++e) { const int c = rcol(2 * j + e, lane); const f32x4 gg = *(const f32x4*)(g + c), s1 = *(const f32x4*)(sh + c), s2 = *(const f32x4*)(sc + c);
            r[e] = (v[2 * j + e] * rstd * gg) * (s2 + 1.f) + s1; }
        u32x4 w; w.x = pk2(r[0][0], r[0][1]); w.y = pk2(r[0][2], r[0][3]); w.z = pk2(r[1][0], r[1][1]); w.w = pk2(r[1][2], r[1][3]);
        *(u32x4*)(o + 512 * j + 8 * lane) = w; }
}
DI void row_residual(f32x4 (&v)[8], const bf16_t* f, const float* xres, const float* gate, const float* pg, float wgt, float* xo, int lane) {
    f32x4 fv[8]; row_load_bf16(fv, f, lane); const float rs = row_rstd(fv);
#pragma unroll
    for (int j = 0; j < 8; ++j) { const int c = rcol(j, lane); const f32x4 xr = *(const f32x4*)(xres + c), gt = *(const f32x4*)(gate + c), pp = *(const f32x4*)(pg + c);
        v[j] = xr + (gt * wgt) * (fv[j] * rs * pp); *(f32x4*)(xo + c) = v[j]; }
}

#define MFMA32(a, b, c) __builtin_amdgcn_mfma_f32_32x32x16_bf16((a), (b), (c), 0, 0, 0)
DI int crow(int r, int hi) { return (r & 3) + 8 * (r >> 2) + 4 * hi; }
constexpr int KPITCH = 272, VPITCH = 136, KVBUF = 17408;
constexpr int AL_K = 0, AL_V = 2 * KVBUF, AL_IMP4 = 4 * KVBUF, AL_IMPS = AL_IMP4 + 32768, AL_SEL = AL_IMPS + 8192;
constexpr float NEGB = -1e30f;
struct KVRegs { u32x4 k0, k1, v0, v1; };
DI void kv_load(KVRegs& R, const bf16_t* Kt, const bf16_t* Vt, int vpitch, int tid) {
    const int c = tid, c2 = tid + 512;
    R.k0 = *(const u32x4*)(Kt + (c >> 4) * 128 + (c & 15) * 8); R.k1 = *(const u32x4*)(Kt + (c2 >> 4) * 128 + (c2 & 15) * 8);
    R.v0 = *(const u32x4*)(Vt + (size_t)(c >> 3) * vpitch + (c & 7) * 8); R.v1 = *(const u32x4*)(Vt + (size_t)(c2 >> 3) * vpitch + (c2 & 7) * 8);
}
DI void kv_store(const KVRegs& R, LAS unsigned char* KB, LAS unsigned char* VB, int tid) {
    const int c = tid, c2 = tid + 512;
    *(LAS u32x4*)(KB + (c >> 4) * KPITCH + (c & 15) * 16) = R.k0; *(LAS u32x4*)(KB + (c2 >> 4) * KPITCH + (c2 & 15) * 16) = R.k1;
    LAS unsigned char* p = VB + (c >> 3) * VPITCH + (c & 7) * 16; *(LAS u32x2*)p = (u32x2){R.v0.x, R.v0.y}; *(LAS u32x2*)(p + 8) = (u32x2){R.v0.z, R.v0.w};
    p = VB + (c2 >> 3) * VPITCH + (c2 & 7) * 16; *(LAS u32x2*)p = (u32x2){R.v1.x, R.v1.y}; *(LAS u32x2*)(p + 8) = (u32x2){R.v1.z, R.v1.w};
}
DI void qk_tile(f32x16& p0, f32x16& p1, const LAS unsigned char* KB, const bf16x8 (&qr)[8], int r, int hi) {
#pragma unroll
    for (int i = 0; i < 16; ++i) { p0[i] = 0.f; p1[i] = 0.f; }
#pragma unroll
    for (int d0 = 0; d0 < 8; ++d0) {
        const bf16x8 a0 = *(const LAS bf16x8*)(KB + r * KPITCH + d0 * 32 + hi * 16), a1 = *(const LAS bf16x8*)(KB + (32 + r) * KPITCH + d0 * 32 + hi * 16);
        p0 = MFMA32(a0, qr[d0], p0); p1 = MFMA32(a1, qr[d0], p1);
    }
}
DI bf16x8 pack8(const f32x16& p, int s2) {
    u32x4 w; w.x = pk2(p[8 * s2], p[8 * s2 + 1]); w.y = pk2(p[8 * s2 + 2], p[8 * s2 + 3]); w.z = pk2(p[8 * s2 + 4], p[8 * s2 + 5]); w.w = pk2(p[8 * s2 + 6], p[8 * s2 + 7]);
    return __builtin_bit_cast(bf16x8, w);
}
DI void pv_tile(f32x16 (&o)[4], const LAS unsigned char* VB, const f32x16& p0, const f32x16& p1, int r, int hi) {
#pragma unroll
    for (int kb = 0; kb < 2; ++kb)
#pragma unroll
        for (int s2 = 0; s2 < 2; ++s2) {
            const bf16x8 pf = pack8(kb ? p1 : p0, s2);
#pragma unroll
            for (int db = 0; db < 4; ++db) {
                const LAS unsigned char* base = VB + (32 * db + r) * VPITCH + (32 * kb + 16 * s2 + 4 * hi) * 2;
                const s16x4 lo = *(const LAS s16x4*)base, hh = *(const LAS s16x4*)(base + 16);
                const bf16x8 af = __builtin_shufflevector(lo, hh, 0, 1, 2, 3, 4, 5, 6, 7);
                o[db] = MFMA32(af, pf, o[db]);
            }
        }
}
constexpr float SCL = 0.08838834764831845f * 1.4426950408889634f;

DI void flash_step(f32x16 (&o)[4], float& mrun, float& lrun, const LAS unsigned char* KB, const LAS unsigned char* VB, const bf16x8 (&qr)[8],
                   int r, int hi, int qpos, int key0, bool rowok, bool need_c, bool need_w) {
    f32x16 p0, p1; qk_tile(p0, p1, KB, qr, r, hi);
    float mnew, alpha, ls = 0.f;
    if (!need_c && !need_w) {
        float mt = fmaxf(p0[0], p1[0]);
#pragma unroll
        for (int i = 1; i < 16; ++i) mt = fmaxf(mt, fmaxf(p0[i], p1[i]));
        mt = rowok ? mt * SCL : NEGB;
        mt = fmaxf(mt, __shfl_xor(mt, 32));
        mnew = fmaxf(mrun, mt);
        alpha = __builtin_amdgcn_exp2f(mrun - mnew);
        const float nb = rowok ? -mnew : NEGB;
#pragma unroll
        for (int i = 0; i < 16; ++i) {
            p0[i] = __builtin_amdgcn_exp2f(__builtin_fmaf(p0[i], SCL, nb));
            p1[i] = __builtin_amdgcn_exp2f(__builtin_fmaf(p1[i], SCL, nb));
            ls += p0[i] + p1[i];
        }
    } else {
        float mt = NEGB;
#pragma unroll
        for (int i = 0; i < 16; ++i) {
            const int k0 = key0 + crow(i, hi), k1 = k0 + 32;
            bool v0 = rowok, v1 = rowok;
            if (need_c) { v0 = v0 && (k0 <= qpos); v1 = v1 && (k1 <= qpos); }
            if (need_w) { v0 = v0 && (k0 > qpos - 512); v1 = v1 && (k1 > qpos - 512); }
            p0[i] = v0 ? p0[i] * SCL : NEGB; p1[i] = v1 ? p1[i] * SCL : NEGB;
            mt = fmaxf(mt, fmaxf(p0[i], p1[i]));
        }
        mt = fmaxf(mt, __shfl_xor(mt, 32));
        mnew = fmaxf(mrun, mt);
        alpha = __builtin_amdgcn_exp2f(mrun - mnew);
#pragma unroll
        for (int i = 0; i < 16; ++i) {
            p0[i] = __builtin_amdgcn_exp2f(p0[i] - mnew);
            p1[i] = __builtin_amdgcn_exp2f(p1[i] - mnew);
            ls += p0[i] + p1[i];
        }
    }
    lrun = lrun * alpha + ls;
    if (__any(mnew > mrun)) {
#pragma unroll
        for (int db = 0; db < 4; ++db)
#pragma unroll
            for (int i = 0; i < 16; ++i) o[db][i] *= alpha;
    }
    mrun = mnew;
    pv_tile(o, VB, p0, p1, r, hi);
}

DI void nsa_unit(int bg, int qblk, unsigned char* ws, LAS unsigned char* lds) {
    const int tid = otid(), lane = tid & 63, r = lane & 31, hi = lane >> 5, wave = __builtin_amdgcn_readfirstlane(tid >> 6);
    const int b = bg >> 2, g = bg & 3, head = g * 4 + (wave >> 1), q0 = qblk * 64, qw0 = q0 + 32 * (wave & 1), qpos = qw0 + r;
    const size_t trow = (size_t)b * SEQ + qpos;
    const bf16_t* Qp = (const bf16_t*)(ws + WS_Q) + trow * DM + head * 128;
    bf16_t* Op = (bf16_t*)(ws + WS_XA) + trow * DM + head * 128;
    bf16x8 qr[8];
#pragma unroll
    for (int d0 = 0; d0 < 8; ++d0) qr[d0] = *(const bf16x8*)(Qp + d0 * 16 + hi * 8);
    const float* ngp = (const float*)(ws + WS_NG) + trow * 48 + head * 3;
    const float g0 = ngp[0], g1 = ngp[1], g2 = ngp[2];
    LAS unsigned char* KB0 = lds + AL_K; LAS unsigned char* VB0 = lds + AL_V;
    LAS float* IMP4 = (LAS float*)(lds + AL_IMP4); LAS float* IMPS = (LAS float*)(lds + AL_IMPS); LAS unsigned* SEL = (LAS unsigned*)(lds + AL_SEL);
    unsigned opk[4][8];
    KVRegs R;
    {
        const bf16_t* kc = (const bf16_t*)(ws + WS_KCC) + (size_t)bg * 128 * 128;
        const bf16_t* vct = (const bf16_t*)(ws + WS_VCT) + (size_t)bg * 128 * 128;
        { KVRegs R2; kv_load(R, kc, vct, 128, tid); kv_load(R2, kc + 64 * 128, vct + 64, 128, tid);
          kv_store(R, KB0, VB0, tid); kv_store(R2, KB0 + KVBUF, VB0 + KVBUF, tid); }
        if (tid < 65) SEL[tid] = 0u;
        __syncthreads();
        f32x16 pa0, pa1, pb0, pb1;
        qk_tile(pa0, pa1, KB0, qr, r, hi); qk_tile(pb0, pb1, KB0 + KVBUF, qr, r, hi);
        float mt = NEGB;
#pragma unroll
        for (int i = 0; i < 16; ++i) {
            const int n = crow(i, hi);
            pa0[i] = (16 * n + 31 <= qpos) ? pa0[i] * SCL : NEGB; pa1[i] = (16 * (n + 32) + 31 <= qpos) ? pa1[i] * SCL : NEGB;
            pb0[i] = (16 * (n + 64) + 31 <= qpos) ? pb0[i] * SCL : NEGB; pb1[i] = (16 * (n + 96) + 31 <= qpos) ? pb1[i] * SCL : NEGB;
            mt = fmaxf(fmaxf(mt, fmaxf(pa0[i], pa1[i])), fmaxf(pb0[i], pb1[i]));
        }
        mt = fmaxf(mt, __shfl_xor(mt, 32));
        float ls = 0.f;
#pragma unroll
        for (int i = 0; i < 16; ++i) {
            pa0[i] = (pa0[i] > -1e29f) ? __builtin_amdgcn_exp2f(pa0[i] - mt) : 0.f; pa1[i] = (pa1[i] > -1e29f) ? __builtin_amdgcn_exp2f(pa1[i] - mt) : 0.f;
            pb0[i] = (pb0[i] > -1e29f) ? __builtin_amdgcn_exp2f(pb0[i] - mt) : 0.f; pb1[i] = (pb1[i] > -1e29f) ? __builtin_amdgcn_exp2f(pb1[i] - mt) : 0.f;
            ls += (pa0[i] + pa1[i]) + (pb0[i] + pb1[i]);
        }
        ls += __shfl_xor(ls, 32);
        const float inv = ls > 0.f ? 1.f / ls : 0.f;
#pragma unroll
        for (int i = 0; i < 16; ++i) { pa0[i] *= inv; pa1[i] *= inv; pb0[i] *= inv; pb1[i] *= inv; }
        if (qblk >= 16) {
            LAS float* ip = IMP4 + ((wave >> 1) * 64 + 32 * (wave & 1) + r) * 32;
#define IMP_G(P, blk) _Pragma("unroll") for (int g4 = 0; g4 < 4; ++g4) ip[8 * (blk) + 2 * g4 + hi] = (P[4 * g4] + P[4 * g4 + 1]) + (P[4 * g4 + 2] + P[4 * g4 + 3]);
            IMP_G(pa0, 0) IMP_G(pa1, 1) IMP_G(pb0, 2) IMP_G(pb1, 3)
            LDS_WAIT();
#define IMP_L(P, blk) _Pragma("unroll") for (int g4 = 0; g4 < 4; ++g4) { const int j1 = 8 * (blk) + 2 * g4 + hi + 1; if (j1 < 32) ip[j1] += P[4 * g4 + 3]; }
            IMP_L(pa0, 0) IMP_L(pa1, 1) IMP_L(pb0, 2) IMP_L(pb1, 3)
#undef IMP_G
#undef IMP_L
        }
        f32x16 oc[4];
#pragma unroll
        for (int db = 0; db < 4; ++db)
#pragma unroll
            for (int i = 0; i < 16; ++i) oc[db][i] = 0.f;
        pv_tile(oc, VB0, pa0, pa1, r, hi); pv_tile(oc, VB0 + KVBUF, pb0, pb1, r, hi);
#pragma unroll
        for (int db = 0; db < 4; ++db)
#pragma unroll
            for (int i = 0; i < 8; ++i) opk[db][i] = pk2(oc[db][2 * i] * g0, oc[db][2 * i + 1] * g0);
    }
    __syncthreads();
    if (qblk >= 16) {
#pragma unroll
        for (int e = 0; e < 4; ++e) { const int idx = tid + 512 * e; IMPS[idx] = (IMP4[idx] + IMP4[2048 + idx]) + (IMP4[4096 + idx] + IMP4[6144 + idx]); }
        __syncthreads();
        const int q = tid >> 3;
        float val[32];
#pragma unroll
        for (int j4 = 0; j4 < 8; ++j4) { const f32x4 t4 = *(const LAS f32x4*)(IMPS + q * 32 + 4 * j4); val[4 * j4] = t4[0]; val[4 * j4 + 1] = t4[1]; val[4 * j4 + 2] = t4[2]; val[4 * j4 + 3] = t4[3]; }
        unsigned bits = 0u;
#pragma unroll
        for (int e = 0; e < 4; ++e) {
            const int j = (tid & 7) * 4 + e;
            float vj = 0.f;
#pragma unroll
            for (int i = 0; i < 32; ++i) vj = (i == j) ? val[i] : vj;
            int rank = 0;
#pragma unroll
            for (int i = 1; i < 32; ++i) { const bool cand = (i <= qblk - 2); rank += (cand && (val[i] > vj || (val[i] == vj && i < j))) ? 1 : 0; }
            const bool forced = (j == 0) || (j == qblk) || (j == qblk - 1);
            const bool sel = forced || (j >= 1 && j <= qblk - 2 && rank < 13);
            bits |= sel ? (1u << j) : 0u;
        }
        __hip_atomic_fetch_or(SEL + q, bits, __ATOMIC_RELAXED, __HIP_MEMORY_SCOPE_WORKGROUP);
        __syncthreads();
    } else {
        if (tid < 64) SEL[tid] = (2u << qblk) - 1u;
        __syncthreads();
    }
    if (tid < 64) { unsigned v = SEL[tid];
#pragma unroll
        for (int o = 1; o < 64; o <<= 1) v |= __shfl_xor(v, o);
        if (tid == 0) SEL[64] = v; }
    __syncthreads();
    const unsigned mysel = SEL[32 * (wave & 1) + r];
    unsigned uni = (unsigned)__builtin_amdgcn_readfirstlane(SEL[64]) & ((2u << qblk) - 1u);
#pragma unroll 1
    for (int mode = 0; mode < 2; ++mode) {
        const bf16_t* Kg = (const bf16_t*)(ws + (mode ? WS_KW : WS_KS)) + (size_t)bg * SEQ * 128;
        const bf16_t* Vg = (const bf16_t*)(ws + (mode ? WS_VWT : WS_VST)) + (size_t)bg * 128 * SEQ;
        unsigned todo;
        if (mode) { const int jlo = qblk >= 8 ? qblk - 8 : 0; todo = ((2u << qblk) - 1u) & ~((1u << jlo) - 1u); } else todo = uni;
        f32x16 o[4];
#pragma unroll
        for (int db = 0; db < 4; ++db)
#pragma unroll
            for (int i = 0; i < 16; ++i) o[db][i] = 0.f;
        float mrun = -1e20f, lrun = 0.f;
        int cur = __builtin_ctz(todo); todo &= todo - 1u;
        kv_load(R, Kg + (size_t)cur * 64 * 128, Vg + cur * 64, SEQ, tid); kv_store(R, KB0, VB0, tid);
        int bi = 0;
        for (;;) {
            __syncthreads();
            const int nxt = todo ? __builtin_ctz(todo) : -1; todo &= todo - 1u;
            if (nxt >= 0) kv_load(R, Kg + (size_t)nxt * 64 * 128, Vg + nxt * 64, SEQ, tid);
            const int key0 = cur * 64;
            const bool rowok = mode ? true : (((mysel >> cur) & 1u) != 0u);
            const bool need_c = (key0 + 63 > qw0), need_w = mode && (key0 <= qw0 + 31 - 512);
            const bool wave_skip = mode ? (key0 + 63 <= qw0 - 512) : !__any(rowok);
            if (!wave_skip) flash_step(o, mrun, lrun, KB0 + bi * KVBUF, VB0 + bi * KVBUF, qr, r, hi, qpos, key0, rowok, need_c, need_w);
            if (nxt < 0) break;
            kv_store(R, KB0 + (bi ^ 1) * KVBUF, VB0 + (bi ^ 1) * KVBUF, tid);
            bi ^= 1; cur = nxt;
        }
        __syncthreads();
        lrun += __shfl_xor(lrun, 32);
        const float sc = (mode ? g2 : g1) / lrun;
#pragma unroll
        for (int db = 0; db < 4; ++db)
#pragma unroll
            for (int i = 0; i < 8; ++i) opk[db][i] = pk2(bflo(opk[db][i]) + o[db][2 * i] * sc, bfhi(opk[db][i]) + o[db][2 * i + 1] * sc);
    }
#pragma unroll
    for (int db = 0; db < 4; ++db)
#pragma unroll
        for (int g4 = 0; g4 < 4; ++g4) { u32x2 w; w.x = opk[db][2 * g4]; w.y = opk[db][2 * g4 + 1];
            *(u32x2*)(Op + 32 * db + 8 * g4 + 4 * hi) = w; }
}

#define NOINL __forceinline__
#define LDS_PTR() ((LAS unsigned char*)lds_raw)
extern __shared__ __attribute__((aligned(16))) unsigned char lds_raw[];

NOINL __device__ void ph_ffn_up(unsigned char* ws) {
    pg8::Gemm g{(const bf16_t*)(ws + WS_U), (const bf16_t*)(ws + WS_WGU), DM, DM, DM}; pg8::Sched S; S.init(64, 44, gridDim.x, blockIdx.x, 256L * DM * 2, 256L * DM * 2);
    EpiFFN E{(bf16_t*)(ws + WS_H)}; pg8::gemm_phase(LDS_PTR(), g, S, E);
}
NOINL __device__ void ph_ffn_down(unsigned char* ws) {
    pg8::Gemm g{(const bf16_t*)(ws + WS_H), (const bf16_t*)(ws + WS_WD), DFF, DFF, DFF}; pg8::Sched S; S.init(64, 8, gridDim.x, blockIdx.x, 256L * DFF * 2, 256L * DFF * 2);
    EpiBf E{(bf16_t*)(ws + WS_F)}; pg8::gemm_phase(LDS_PTR(), g, S, E);
}
NOINL __device__ void ph_inproj(unsigned char* ws) {
    pg8::Gemm g{(const bf16_t*)(ws + WS_U), (const bf16_t*)(ws + WS_WIN), DM, DM, DM}; pg8::Sched S; S.init(64, 49, gridDim.x, blockIdx.x, 256L * DM * 2, 256L * DM * 2);
    EpiIn E{ws, (const float*)(ws + WS_ROPE)}; pg8::gemm_phase(LDS_PTR(), g, S, E);
}
NOINL __device__ void ph_vt(unsigned char* ws) {
    pg8::Gemm g{(const bf16_t*)(ws + WS_WV), (const bf16_t*)(ws + WS_U), DM, DM, DM}; pg8::Sched S; S.init(4, 64, gridDim.x, blockIdx.x, 256L * DM * 2, 256L * DM * 2);
    EpiVT E{(bf16_t*)(ws + WS_VST), (bf16_t*)(ws + WS_VWT)}; pg8::gemm_phase(LDS_PTR(), g, S, E);
}
NOINL __device__ void ph_cmp1(unsigned char* ws) {
    pg8::Gemm g{(const bf16_t*)(ws + WS_KC), (const bf16_t*)(ws + WS_W1T), 2048, 4096, 512}; pg8::Sched S; S.init(16, 16, gridDim.x, blockIdx.x, 0, 0); S.mode = 1; S.srcstride = (long)(WS_VC - WS_KC);
    EpiPart E{(float*)(ws + WS_PART)}; pg8::gemm_phase(LDS_PTR(), g, S, E);
}
NOINL __device__ void ph_ya(unsigned char* ws) {
    pg8::Gemm g{(const bf16_t*)(ws + WS_HG), (const bf16_t*)(ws + WS_WA), DM, DM, DM}; pg8::Sched S; S.init(64, 8, gridDim.x, blockIdx.x, 256L * DM * 2, 256L * DM * 2);
    EpiGate E{(const bf16_t*)(ws + WS_MG), nullptr, (bf16_t*)(ws + WS_Q), 0}; pg8::gemm_phase(LDS_PTR(), g, S, E);
}
NOINL __device__ void ph_yb(unsigned char* ws) {
    pg8::Gemm g{(const bf16_t*)(ws + WS_XA), (const bf16_t*)(ws + WS_WB), DM, DM, DM}; pg8::Sched S; S.init(64, 8, gridDim.x, blockIdx.x, 256L * DM * 2, 256L * DM * 2);
    EpiGate E{(const bf16_t*)(ws + WS_MG), (const bf16_t*)(ws + WS_Q), (bf16_t*)(ws + WS_U), 1}; pg8::gemm_phase(LDS_PTR(), g, S, E);
}
NOINL __device__ void ph_out(unsigned char* ws) {
    pg8::Gemm g{(const bf16_t*)(ws + WS_U), (const bf16_t*)(ws + WS_WO), DM, DM, DM}; pg8::Sched S; S.init(64, 8, gridDim.x, blockIdx.x, 256L * DM * 2, 256L * DM * 2);
    EpiBf E{(bf16_t*)(ws + WS_FMIX)}; pg8::gemm_phase(LDS_PTR(), g, S, E);
}
NOINL __device__ void ph_cmp2(unsigned char* ws) {
    const int tid = otid(), lane = tid & 63, wave = __builtin_amdgcn_readfirstlane(tid >> 6), bx = blockIdx.x;
    if (wave >= 4 || bx >= 256) return;
    const int src = bx >> 7, rt = bx & 127;
    const int r = lane & 31, hh = lane >> 5;
    const float* P = (const float*)(ws + WS_PART); const float* peb = (const float*)(ws + WS_PEB) + src * 128;
    const bf16_t* w2t = (const bf16_t*)(ws + WS_W2T) + (size_t)src * 128 * 128;
    f32x16 acc;
#pragma unroll
    for (int i = 0; i < 16; ++i) acc[i] = 0.f;
#pragma unroll 2
    for (int st = 0; st < 8; ++st) {
        const int k0 = 16 * st + 8 * hh; float a[8];
#pragma unroll
        for (int e = 0; e < 8; ++e) a[e] = peb[k0 + e];
#pragma unroll
        for (int ks = 0; ks < 8; ++ks) { const float* pp = P + ((size_t)((ks * 2 + src) * 4096 + rt * 32 + r)) * 128 + k0;
            const f32x4 x0 = *(const f32x4*)pp, x1 = *(const f32x4*)(pp + 4); a[0] += x0[0]; a[1] += x0[1]; a[2] += x0[2]; a[3] += x0[3]; a[4] += x1[0]; a[5] += x1[1]; a[6] += x1[2]; a[7] += x1[3]; }
        u32x4 w; w.x = pk2(gelu_t(a[0]), gelu_t(a[1])); w.y = pk2(gelu_t(a[2]), gelu_t(a[3])); w.z = pk2(gelu_t(a[4]), gelu_t(a[5])); w.w = pk2(gelu_t(a[6]), gelu_t(a[7]));
        const bf16x8 af = __builtin_bit_cast(bf16x8, w);
        const bf16x8 bfr = *(const bf16x8*)(w2t + (size_t)(32 * wave + r) * 128 + k0);
        acc = MFMA32(af, bfr, acc);
    }
#pragma unroll
    for (int i = 0; i < 16; ++i) {
        const int R = rt * 32 + crow(i, hh), nrow = R & 127, bgi = R >> 7, d = 32 * wave + r;
        const float v = (nrow == 127) ? 0.f : acc[i];
        const bf16_t o = (bf16_t)(pk2(v, 0.f) & 0xffffu);
        if (src == 0) ((bf16_t*)(ws + WS_KCC))[(size_t)R * 128 + d] = o;
        else ((bf16_t*)(ws + WS_VCT))[((size_t)bgi * 128 + d) * 128 + nrow] = o;
    }
}
NOINL __device__ void ph_lru_gates(unsigned char* ws, const float* conv_w, const float* conv_b, const float* lbr, const float* lbi, const float* llam) {
    const int tid = otid(), lane = tid & 63, wave = __builtin_amdgcn_readfirstlane(tid >> 6), bx = blockIdx.x, G = gridDim.x;
    LAS unsigned char* lds = LDS_PTR();
    const int h = bx & 15, cuh = bx >> 4, nch = G >> 4;
    LAS unsigned char* WL = lds; LAS unsigned char* XS = lds + 69632 + wave * 8704; LAS float* CW = (LAS float*)(lds + 139264);
    const bf16_t* wri = (const bf16_t*)(ws + WS_WRI) + (size_t)h * 256 * 128;
#pragma unroll
    for (int e = 0; e < 8; ++e) { const int c = tid + 512 * e; *(LAS u32x4*)(WL + (c >> 4) * 272 + (c & 15) * 16) = *(const u32x4*)(wri + (c >> 4) * 128 + (c & 15) * 8); }
    if (tid < 128) { const int ch = h * 128 + tid;
        CW[tid] = conv_w[ch]; CW[128 + tid] = conv_w[DM + ch]; CW[256 + tid] = conv_w[2 * DM + ch]; CW[384 + tid] = conv_w[3 * DM + ch];
        CW[512 + tid] = conv_b[ch]; CW[640 + tid] = lbr[ch]; CW[768 + tid] = lbi[ch];
        const float lam = llam[ch], ex = __expf(-lam);
        CW[896 + tid] = (ex < 0.03f) ? ex * (1.f - ex * (0.5f - ex * (0.33333333f - ex * (0.25f - ex * 0.2f)))) : __logf(1.f + ex); }
    __syncthreads();
    const int r = lane & 31, hh = lane >> 5;
    const bf16_t* XA = (const bf16_t*)(ws + WS_XA); bf16_t* LA = (bf16_t*)(ws + WS_U); bf16_t* BBp = (bf16_t*)(ws + WS_BB);
#pragma unroll 1
    for (int rt = cuh * 8 + wave; rt < T / 32; rt += nch * 8) {
        const int t0 = rt * 32, tok = t0 + r, s = tok & 2047;
        bf16x8 af[8];
#pragma unroll
        for (int st = 0; st < 8; ++st) {
            const int ch0 = 16 * st + 8 * hh; float xc[8];
#pragma unroll
            for (int e = 0; e < 8; ++e) xc[e] = CW[512 + ch0 + e];
#pragma unroll
            for (int j = 0; j < 4; ++j) { if (s - 3 + j >= 0) { const u32x4 xv = *(const u32x4*)(XA + ((size_t)(((tok >> 11) * 16 + h) * 2048 + (s - 3 + j))) * 128 + ch0);
                xc[0] += CW[j * 128 + ch0 + 0] * bflo(xv.x); xc[1] += CW[j * 128 + ch0 + 1] * bfhi(xv.x); xc[2] += CW[j * 128 + ch0 + 2] * bflo(xv.y); xc[3] += CW[j * 128 + ch0 + 3] * bfhi(xv.y);
                xc[4] += CW[j * 128 + ch0 + 4] * bflo(xv.z); xc[5] += CW[j * 128 + ch0 + 5] * bfhi(xv.z); xc[6] += CW[j * 128 + ch0 + 6] * bflo(xv.w); xc[7] += CW[j * 128 + ch0 + 7] * bfhi(xv.w); } }
            u32x4 w; w.x = pk2(xc[0], xc[1]); w.y = pk2(xc[2], xc[3]); w.z = pk2(xc[4], xc[5]); w.w = pk2(xc[6], xc[7]);
            af[st] = __builtin_bit_cast(bf16x8, w);
            *(LAS u32x4*)(XS + r * 272 + ch0 * 2) = w;
            if (st & 1) asm volatile("" ::: "memory");
        }
        LDS_WAIT();
#pragma unroll 1
        for (int cb = 0; cb < 4; ++cb) {
            f32x16 aR, aI;
#pragma unroll
            for (int i = 0; i < 16; ++i) { aR[i] = 0.f; aI[i] = 0.f; }
#pragma unroll
            for (int st = 0; st < 8; ++st) {
                const bf16x8 bR = *(const LAS bf16x8*)(WL + (32 * cb + r) * 272 + st * 32 + hh * 16), bI = *(const LAS bf16x8*)(WL + (128 + 32 * cb + r) * 272 + st * 32 + hh * 16);
                aR = MFMA32(af[st], bR, aR); aI = MFMA32(af[st], bI, aI);
            }
            const int ch = 32 * cb + r; const float br_ = CW[640 + ch], bi_ = CW[768 + ch], sp_ = CW[896 + ch];
#pragma unroll
            for (int i = 0; i < 16; ++i) {
                const int tk = crow(i, hh);
                const float rr = sigm(aR[i] + br_), ig = sigm(aI[i] + bi_), la = -8.f * rr * sp_;
                const float xcv = bf2f(*(const LAS bf16_t*)(XS + tk * 272 + ch * 2));
                const float bm = sqrtf(fmaxf(1.f - __expf(2.f * la), 0.f)) * ig * xcv;
                const int tkn = t0 + tk;
                const size_t o = ((size_t)(((tkn >> 11) * 32 + h * 2 + (cb >> 1)) * 2048 + (tkn & 2047))) * 64 + (cb & 1) * 32 + r;
                LA[o] = (bf16_t)(pk2(la, 0.f) & 0xffffu); BBp[o] = (bf16_t)(pk2(bm, 0.f) & 0xffffu);
            }
        }
        LDS_WAIT();
    }
}
NOINL __device__ void ph_scan(unsigned char* ws) {
    const int tid = otid(), lane = tid & 63, wave = __builtin_amdgcn_readfirstlane(tid >> 6), bx = blockIdx.x, G = gridDim.x;
    LAS float* car = (LAS float*)LDS_PTR();
    const bf16_t* LA = (const bf16_t*)(ws + WS_U); const bf16_t* BBp = (const bf16_t*)(ws + WS_BB); const bf16_t* GY = (const bf16_t*)(ws + WS_GY); bf16_t* HG = (bf16_t*)(ws + WS_HG);
    for (int unit = bx; unit < 256; unit += G) {
        const int b = unit >> 5, ch = (unit & 31) * 64 + lane;
        const size_t bbase = (size_t)unit * 2048 * 64 + lane;
        float hcarry = 0.f;
#pragma unroll 1
        for (int rd = 0; rd < 8; ++rd) {
            const size_t base = ((size_t)b * SEQ + rd * 256 + wave * 32) * DM + ch;
            float la[32], bb[32], gy[32];
#pragma unroll
            for (int e = 0; e < 32; ++e) { const size_t o = bbase + (size_t)(rd * 256 + wave * 32 + e) * 64; la[e] = bf2f(LA[o]); bb[e] = bf2f(BBp[o]); gy[e] = bf2f(GY[o]); }
            float hst = 0.f;
#pragma unroll
            for (int e = 0; e < 32; ++e) { la[e] = __expf(la[e]); hst = la[e] * hst + bb[e]; }
            float aprod = 1.f;
#pragma unroll
            for (int e = 0; e < 32; ++e) aprod *= la[e];
            LAS float* cb = car + (rd & 1) * 1024;
            cb[(wave * 2) * 64 + lane] = aprod; cb[(wave * 2 + 1) * 64 + lane] = hst;
            __syncthreads();
            float hin = hcarry, myhin = 0.f;
#pragma unroll
            for (int w = 0; w < 8; ++w) { if (w == wave) myhin = hin; hin = cb[(w * 2) * 64 + lane] * hin + cb[(w * 2 + 1) * 64 + lane]; }
            hcarry = hin; hst = myhin;
#pragma unroll
            for (int e = 0; e < 32; ++e) { hst = la[e] * hst + bb[e]; HG[base + (size_t)e * DM] = (bf16_t)(pk2(hst * gy[e], 0.f) & 0xffffu); }
        }
        __syncthreads();
    }
}
NOINL __device__ void ph_lru_fused(unsigned char* ws, const float* conv_w, const float* conv_b, const float* lbr, const float* lbi, const float* llam) {
    const int tid = otid(), lane = tid & 63, wave = __builtin_amdgcn_readfirstlane(tid >> 6), bx = blockIdx.x, G = gridDim.x;
    LAS unsigned char* lds = LDS_PTR();
    LAS unsigned char* WL = lds; LAS float* CW = (LAS float*)(lds + 34816); LAS unsigned char* XS = lds + 38912 + wave * 8704; LAS float* car = (LAS float*)(lds + 108544);
    const int r = lane & 31, hh = lane >> 5;
    const bf16_t* XA = (const bf16_t*)(ws + WS_XA); const bf16_t* GY = (const bf16_t*)(ws + WS_GY); bf16_t* HG = (bf16_t*)(ws + WS_HG);
#pragma unroll 1
    for (int unit = bx; unit < 256; unit += G) {
        const int b = unit >> 5, cgp = unit & 31, h = cgp >> 1, hf = cgp & 1;
        __syncthreads();
        {
            const bf16_t* wri = (const bf16_t*)(ws + WS_WRI) + (size_t)h * 256 * 128;
#pragma unroll
            for (int e = 0; e < 4; ++e) { const int c = tid + 512 * e, row = c >> 4, srow = (row < 64) ? hf * 64 + row : 128 + hf * 64 + (row - 64);
                *(LAS u32x4*)(WL + row * 272 + (c & 15) * 16) = *(const u32x4*)(wri + srow * 128 + (c & 15) * 8); }
            if (tid < 128) { const int ch = h * 128 + tid; CW[tid] = conv_w[ch]; CW[128 + tid] = conv_w[DM + ch]; CW[256 + tid] = conv_w[2 * DM + ch]; CW[384 + tid] = conv_w[3 * DM + ch]; CW[512 + tid] = conv_b[ch]; }
            if (tid < 64) { const int ch = h * 128 + hf * 64 + tid; CW[640 + tid] = lbr[ch]; CW[704 + tid] = lbi[ch];
                const float lam = llam[ch], ex = __expf(-lam);
                CW[768 + tid] = (ex < 0.03f) ? ex * (1.f - ex * (0.5f - ex * (0.33333333f - ex * (0.25f - ex * 0.2f)))) : __logf(1.f + ex); }
        }
        __syncthreads();
        const bf16_t* XAb = XA + (size_t)(b * 16 + h) * 2048 * 128;
        const bf16_t* GYb = GY + (size_t)unit * 2048 * 64;
        float hcar0 = 0.f, hcar1 = 0.f;
#pragma unroll 1
        for (int rd = 0; rd < 8; ++rd) {
            const int t0 = rd * 256 + wave * 32, s = t0 + r;
            bf16_t gyr[2][16];
#pragma unroll
            for (int cb = 0; cb < 2; ++cb)
#pragma unroll
                for (int i = 0; i < 16; ++i) gyr[cb][i] = GYb[(size_t)(t0 + crow(i, hh)) * 64 + 32 * cb + r];
            bf16x8 af[8];
            {
                u32x4 xv[8][4];
#pragma unroll
                for (int st = 0; st < 8; ++st)
#pragma unroll
                    for (int j = 0; j < 4; ++j) { const int sp = s - 3 + j; xv[st][j] = *(const u32x4*)(XAb + (size_t)(sp < 0 ? 0 : sp) * 128 + 16 * st + 8 * hh); }
#pragma unroll
                for (int st = 0; st < 8; ++st) {
                    const int ch0 = 16 * st + 8 * hh; float xc[8];
#pragma unroll
                    for (int e = 0; e < 8; ++e) xc[e] = CW[512 + ch0 + e];
#pragma unroll
                    for (int j = 0; j < 4; ++j) { const float ok = (s - 3 + j >= 0) ? 1.f : 0.f; const u32x4 x4 = xv[st][j];
                        xc[0] += ok * CW[j * 128 + ch0 + 0] * bflo(x4.x); xc[1] += ok * CW[j * 128 + ch0 + 1] * bfhi(x4.x); xc[2] += ok * CW[j * 128 + ch0 + 2] * bflo(x4.y); xc[3] += ok * CW[j * 128 + ch0 + 3] * bfhi(x4.y);
                        xc[4] += ok * CW[j * 128 + ch0 + 4] * bflo(x4.z); xc[5] += ok * CW[j * 128 + ch0 + 5] * bfhi(x4.z); xc[6] += ok * CW[j * 128 + ch0 + 6] * bflo(x4.w); xc[7] += ok * CW[j * 128 + ch0 + 7] * bfhi(x4.w); }
                    u32x4 w; w.x = pk2(xc[0], xc[1]); w.y = pk2(xc[2], xc[3]); w.z = pk2(xc[4], xc[5]); w.w = pk2(xc[6], xc[7]);
                    af[st] = __builtin_bit_cast(bf16x8, w);
                    *(LAS u32x4*)(XS + r * 272 + ch0 * 2) = w;
                }
            }
            LDS_WAIT();
            float av[2][16], bv[2][16];
#pragma unroll
            for (int cb = 0; cb < 2; ++cb) {
                f32x16 aR, aI;
#pragma unroll
                for (int i = 0; i < 16; ++i) { aR[i] = 0.f; aI[i] = 0.f; }
#pragma unroll
                for (int st = 0; st < 8; ++st) {
                    const bf16x8 bR = *(const LAS bf16x8*)(WL + (32 * cb + r) * 272 + st * 32 + hh * 16), bI = *(const LAS bf16x8*)(WL + (64 + 32 * cb + r) * 272 + st * 32 + hh * 16);
                    aR = MFMA32(af[st], bR, aR); aI = MFMA32(af[st], bI, aI);
                }
                const int chl = 32 * cb + r; const float br_ = CW[640 + chl], bi_ = CW[704 + chl], sp_ = CW[768 + chl];
#pragma unroll
                for (int i = 0; i < 16; ++i) {
                    const float rr = sigm(aR[i] + br_), ig = sigm(aI[i] + bi_), a = __expf(-8.f * rr * sp_);
                    const float xcv = bf2f(*(const LAS bf16_t*)(XS + crow(i, hh) * 272 + (hf * 64 + chl) * 2));
                    av[cb][i] = a; bv[cb][i] = __builtin_amdgcn_sqrtf(fmaxf(1.f - a * a, 0.f)) * ig * xcv;
                }
            }
            float GA[2][4], GB[2][4], PA[2][4], PB[2][4];
#pragma unroll
            for (int cb = 0; cb < 2; ++cb)
#pragma unroll
                for (int g = 0; g < 4; ++g) {
                    float A = av[cb][4 * g], B = bv[cb][4 * g];
#pragma unroll
                    for (int e = 1; e < 4; ++e) { B = av[cb][4 * g + e] * B + bv[cb][4 * g + e]; A *= av[cb][4 * g + e]; }
                    GA[cb][g] = A; GB[cb][g] = B; PA[cb][g] = __shfl_xor(A, 32); PB[cb][g] = __shfl_xor(B, 32);
                }
            LAS float* cbuf = car + (rd & 1) * 1024;
#pragma unroll
            for (int cb = 0; cb < 2; ++cb) {
                float A = 1.f, B = 0.f;
#pragma unroll
                for (int g = 0; g < 4; ++g) {
                    const float A0 = hh ? PA[cb][g] : GA[cb][g], B0 = hh ? PB[cb][g] : GB[cb][g], A1 = hh ? GA[cb][g] : PA[cb][g], B1 = hh ? GB[cb][g] : PB[cb][g];
                    B = A0 * B + B0; A *= A0; B = A1 * B + B1; A *= A1;
                }
                if (hh == 0) { cbuf[(wave * 2) * 64 + 32 * cb + r] = A; cbuf[(wave * 2 + 1) * 64 + 32 * cb + r] = B; }
            }
            __syncthreads();
#pragma unroll
            for (int cb = 0; cb < 2; ++cb) {
                float hin = cb ? hcar1 : hcar0, myhin = 0.f;
#pragma unroll
                for (int w = 0; w < 8; ++w) { if (w == wave) myhin = hin; hin = cbuf[(w * 2) * 64 + 32 * cb + r] * hin + cbuf[(w * 2 + 1) * 64 + 32 * cb + r]; }
                if (cb) hcar1 = hin; else hcar0 = hin;
                float hrun = myhin;
#pragma unroll
                for (int g = 0; g < 4; ++g) {
                    if (hh) hrun = PA[cb][g] * hrun + PB[cb][g];
                    float hv = hrun;
#pragma unroll
                    for (int e = 0; e < 4; ++e) { const int i = 4 * g + e; hv = av[cb][i] * hv + bv[cb][i];
                        HG[((size_t)b * SEQ + t0 + crow(i, hh)) * DM + h * 128 + hf * 64 + 32 * cb + r] = (bf16_t)(pk2(hv * bf2f(gyr[cb][i]), 0.f) & 0xffffu); }
                    hrun = hv;
                    if (!hh) hrun = PA[cb][g] * hrun + PB[cb][g];
                }
            }
        }
    }
}
NOINL __device__ void ph_nsa(unsigned char* ws) {
    const int bx = blockIdx.x, G = gridDim.x;
    const int vcu = (G % 8 == 0) ? (bx % 8) * (G / 8) + bx / 8 : bx;
#pragma unroll 1
    for (int uu = vcu; uu < 1024; uu += G) {
        const int pr = uu & 255, it = uu >> 8, bg = pr >> 3, s = pr & 7;
        const int qblk = (it == 0) ? s : (it == 1) ? 15 - s : (it == 2) ? 16 + s : 31 - s;
        nsa_unit(bg, qblk, ws, LDS_PTR());
    }
}

constexpr size_t WS_BAR = 960 * 1024;
constexpr int LDS_BARST = LDS_BYTES - 16;
#define XB_TMO      128
#define XB_XCNT(j)  (256  + 64 * (j))
#define XB_XSUB(j)  (1280 + 64 * (j))
#define XB_XGEN(j)  (2304 + 64 * (j))
#define XB_TOP      3328
#define XB_TOPGEN   3392
#define XCD_BAR_WORDS 3456
#define XB_SPIN_CAP (1u << 18)
DI unsigned xb_ld(unsigned* p)              { return __hip_atomic_load(p, __ATOMIC_RELAXED, __HIP_MEMORY_SCOPE_AGENT); }
DI unsigned xb_add(unsigned* p, unsigned v) { return __hip_atomic_fetch_add(p, v, __ATOMIC_RELAXED, __HIP_MEMORY_SCOPE_AGENT); }
DI unsigned xb_xcc_id() { return (unsigned)__builtin_amdgcn_s_getreg((3 << 11) | 20) & 0xFu; }
#define XB_SPIN(cond, bar) do { unsigned _sp = 0; while (cond) { __builtin_amdgcn_s_sleep(1); \
    if ((++_sp & 255u) == 0u) { if (xb_ld(&(bar)[XB_TMO])) break; if (_sp > XB_SPIN_CAP) { atomicAdd(&(bar)[XB_TMO], 1u); break; } } } } while (0)
DI void xcd_barrier_complete(unsigned* bar, unsigned x, unsigned& nloc, unsigned& nx) {
    const unsigned G = gridDim.x * gridDim.y * gridDim.z;
    unsigned sum, cnt, mine, sp = 0u;
    for (;;) {
        sum = 0u; cnt = 0u; mine = 0u;
#pragma unroll
        for (unsigned j = 0; j < 16; ++j) { const unsigned c = xb_ld(&bar[XB_XCNT(j)]); sum += c; cnt += (c > 0u) ? 1u : 0u; mine = (j == x) ? c : mine; }
        if (sum == G) break;
        __builtin_amdgcn_s_sleep(1);
        if ((++sp & 255u) == 0u) { if (xb_ld(&bar[XB_TMO])) break; if (sp > XB_SPIN_CAP) { atomicAdd(&bar[XB_TMO], 1u); break; } }
    }
    nloc = mine > 0u ? mine : 1u; nx = cnt > 0u ? cnt : 1u;
}
DI void xcd_barrier(unsigned* bar) {
    asm volatile("s_waitcnt vmcnt(0)" ::: "memory");
    __syncthreads();
    if (threadIdx.x == 0) {
        volatile LAS unsigned* st = (volatile LAS unsigned*)(LDS_PTR() + LDS_BARST);
        const unsigned x = xb_xcc_id();
        __builtin_amdgcn_s_waitcnt(0);
        unsigned nloc = st[0], nx = st[1];
        if (nloc == 0u) { xcd_barrier_complete(bar, x, nloc, nx); st[0] = nloc; st[1] = nx; }
        const unsigned old = xb_add(&bar[XB_XSUB(x)], 1u);
        const unsigned gen = old / nloc;
        if (old + 1u == (gen + 1u) * nloc) {
            __builtin_amdgcn_fence(__ATOMIC_RELEASE, "agent");
            asm volatile("s_waitcnt vmcnt(0)" ::: "memory");
            const unsigned og = xb_add(&bar[XB_TOP], 1u);
            const unsigned tg = og / nx;
            if (og + 1u == (tg + 1u) * nx) xb_add(&bar[XB_TOPGEN], 1u);
            else XB_SPIN(xb_ld(&bar[XB_TOPGEN]) == tg, bar);
            __builtin_amdgcn_fence(__ATOMIC_ACQUIRE, "agent");
            xb_add(&bar[XB_XGEN(x)], 1u);
            asm volatile("s_waitcnt vmcnt(0)" ::: "memory");
        } else {
            XB_SPIN(xb_ld(&bar[XB_XGEN(x)]) == gen, bar);
            __builtin_amdgcn_fence(__ATOMIC_ACQUIRE, "agent");
            asm volatile("s_waitcnt vmcnt(0)" ::: "memory");
        }
    }
    __syncthreads();
}

DI KArgs oargs() { auto p = __builtin_amdgcn_kernarg_segment_ptr(); asm volatile("" : "+s"(p)); return (KArgs)p; }

DI void ph_prologue() {
    KArgs ka = oargs();
    LAS unsigned char* lds = LDS_PTR(); unsigned char* ws = ka->ws; float* mod = (float*)(ws + WS_MOD);
    const int tid = otid(), lane = tid & 63, wave = __builtin_amdgcn_readfirstlane(tid >> 6), G = gridDim.x, bx = blockIdx.x, gw = bx * NWV + wave, ngw = G * NWV;
#ifdef PROBE_ADA
    const unsigned long long tp0 = __builtin_amdgcn_s_memrealtime();
#endif
    if (bx < 72) {
        LAS float* cact = (LAS float*)lds;
        LAS float* red = (LAS float*)(lds + 65536);
        const float* c = ka->in[1]; const float* wada = ka->in[2]; const float* bada = ka->in[3];
        for (int i = tid; i < NB * DM; i += NTHR) { const float v = c[i]; cact[i] = v * sigm(v); }
        __syncthreads();
        const int col = bx * 256 + 4 * lane;
        f32x4 acc[8];
#pragma unroll
        for (int b = 0; b < 8; ++b) acc[b] = (f32x4){0.f, 0.f, 0.f, 0.f};
        const float* wp = wada + (size_t)(wave * 256) * (NADA * DM) + col;
        f32x4 wn[8];
#pragma unroll
        for (int e = 0; e < 8; ++e) wn[e] = *(const f32x4*)(wp + (size_t)e * (NADA * DM));
#pragma unroll 1
        for (int k = 0; k < 256; k += 8) {
            f32x4 w[8];
#pragma unroll
            for (int e = 0; e < 8; ++e) w[e] = wn[e];
            if (k + 8 < 256) {
#pragma unroll
                for (int e = 0; e < 8; ++e) wn[e] = *(const f32x4*)(wp + (size_t)(k + 8 + e) * (NADA * DM)); }
#pragma unroll
            for (int e = 0; e < 8; ++e)
#pragma unroll
                for (int b = 0; b < 8; ++b) acc[b] += w[e] * cact[b * DM + wave * 256 + k + e];
        }
#pragma unroll
        for (int b = 0; b < 8; ++b) *(LAS f32x4*)(red + (wave * 8 + b) * 256 + 4 * lane) = acc[b];
        __syncthreads();
#pragma unroll
        for (int e = 0; e < 4; ++e) { const int idx = tid + 512 * e, b = idx >> 8, cc = idx & 255; float sum = bada[bx * 256 + cc];
#pragma unroll
            for (int w = 0; w < 8; ++w) sum += red[(w * 8 + b) * 256 + cc];
            mod[b * (NADA * DM) + bx * 256 + cc] = sum; }
        __syncthreads();
    }
#ifdef PROBE_ADA
    { const unsigned long long tp1 = __builtin_amdgcn_s_memrealtime(); while (__builtin_amdgcn_s_memrealtime() - tp1 < tp1 - tp0) __builtin_amdgcn_s_sleep(8); }
#endif
    {
        const int nada = (G > 72) ? 72 : 0, nslots = (G - nada) * NWV * 2 + nada * NWV;
        const int slot0 = (bx >= nada) ? ((bx - nada) * NWV + wave) * 2 : (G - nada) * NWV * 2 + bx * NWV + wave, nslot = (bx >= nada) ? 2 : 1;
        conv_jobs_w(0, 9, ka, lds, slot0, nslot, nslots, wave, lane);
        conv_jobs_w(11, 12, ka, lds, slot0, nslot, nslots, wave, lane);
    }
    {
        const int idx = bx * NTHR + tid;
        if (idx < SEQ * 16) { const int pos = idx >> 4, i = idx & 15;
            const float invf = __builtin_amdgcn_exp2f(-(float)i * 1.1832230356f); const float ang = (float)pos * invf;
            const float rev = ang * 0.15915494309189535f, fr = rev - floorf(rev);
            float* rp = (float*)(ws + WS_ROPE) + pos * 32; rp[i] = __builtin_amdgcn_cosf(fr); rp[16 + i] = __builtin_amdgcn_sinf(fr); }
    }
    __syncthreads();
}
template <bool RES>
DI void rows_fetch(u32x4 (&fN)[4], f32x4 (&xN)[8], const bf16_t* F, const float* X, int row, int lane) {
    if (row < T) {
        if (RES) {
#pragma unroll
            for (int j = 0; j < 4; ++j) fN[j] = *(const u32x4*)(F + (size_t)row * DM + 512 * j + 8 * lane); }
        row_load(xN, X + (size_t)row * DM, lane);
    }
}
template <bool RES, bool MODU>
DI void rows_proc(const u32x4 (&fN)[4], const f32x4 (&xN)[8], int row, float* XO, const float* gatebase, const float* pg, float wgt, const float* g, const float* shbase, const float* scbase, bf16_t* U, int lane) {
    f32x4 v[8], fv[8];
#pragma unroll
    for (int q = 0; q < 8; ++q) v[q] = xN[q];
    if (RES) {
#pragma unroll
        for (int j = 0; j < 4; ++j) { const u32x4 w = fN[j]; fv[2 * j] = (f32x4){bflo(w.x), bfhi(w.x), bflo(w.y), bfhi(w.y)}; fv[2 * j + 1] = (f32x4){bflo(w.z), bfhi(w.z), bflo(w.w), bfhi(w.w)}; } }
    const int b = row >> 11; const size_t mo = (size_t)b * (NADA * DM);
    if (RES) {
        const float rs = row_rstd(fv);
#pragma unroll
        for (int j = 0; j < 8; ++j) { const int c = rcol(j, lane); const f32x4 gt = *(const f32x4*)(gatebase + mo + c), pp = *(const f32x4*)(pg + c);
            v[j] = v[j] + (gt * wgt) * (fv[j] * rs * pp); *(f32x4*)(XO + (size_t)row * DM + c) = v[j]; }
    }
    if (MODU) { const float rs2 = row_rstd(v); row_modulate_store(v, rs2, g, shbase + mo, scbase + mo, U + (size_t)row * DM, lane); }
}
template <bool RES, bool MODU>
DI void rows_run(const bf16_t* F, const float* X, float* XO, const float* gatebase, const float* pg, float wgt, const float* g, const float* shbase, const float* scbase, bf16_t* U, int lane, int gw, int ngw) {
    u32x4 fA[4], fB[4]; f32x4 xA[8], xB[8];
    rows_fetch<RES>(fA, xA, F, X, gw, lane); rows_fetch<RES>(fB, xB, F, X, gw + ngw, lane);
#pragma unroll 1
    for (int row = gw; row < T; row += 2 * ngw) {
        u32x4 fc[4]; f32x4 xc[8];
#pragma unroll
        for (int j = 0; j < 4; ++j) fc[j] = fA[j];
#pragma unroll
        for (int q = 0; q < 8; ++q) xc[q] = xA[q];
        rows_fetch<RES>(fA, xA, F, X, row + 2 * ngw, lane);
        rows_proc<RES, MODU>(fc, xc, row, XO, gatebase, pg, wgt, g, shbase, scbase, U, lane);
        if (row + ngw < T) {
#pragma unroll
            for (int j = 0; j < 4; ++j) fc[j] = fB[j];
#pragma unroll
            for (int q = 0; q < 8; ++q) xc[q] = xB[q];
            rows_fetch<RES>(fB, xB, F, X, row + 3 * ngw, lane);
            rows_proc<RES, MODU>(fc, xc, row + ngw, XO, gatebase, pg, wgt, g, shbase, scbase, U, lane);
        }
    }
}
DI void ph_rows(int which) {
    KArgs ka = oargs(); unsigned char* ws = ka->ws; float* out = ka->out; const float* mod = (const float*)(ws + WS_MOD);
    const int tid = otid(), lane = tid & 63, wave = __builtin_amdgcn_readfirstlane(tid >> 6), G = gridDim.x, bx = blockIdx.x, gw = bx * NWV + wave, ngw = G * NWV;
    bf16_t* U = (bf16_t*)(ws + WS_U);
    if (which == 0) rows_run<false, true>(nullptr, ka->in[0], nullptr, nullptr, nullptr, 0.f, ka->in[4], mod + 0 * DM, mod + 1 * DM, U, lane, gw, ngw);
    else if (which == 1) rows_run<true, true>((const bf16_t*)(ws + WS_F), ka->in[0], out, mod + 2 * DM, ka->in[5], 0.5f, ka->in[9], mod + 3 * DM, mod + 4 * DM, U, lane, gw, ngw);
    else if (which == 2) rows_run<true, true>((const bf16_t*)(ws + WS_FMIX), out, out, mod + 5 * DM, ka->in[10], 1.0f, ka->in[28], mod + 6 * DM, mod + 7 * DM, U, lane, gw, ngw);
    else rows_run<true, false>((const bf16_t*)(ws + WS_F), out, out, mod + 8 * DM, ka->in[29], 0.5f, nullptr, nullptr, nullptr, nullptr, lane, gw, ngw);
}

DI void ph_pebias() {
    const int G = gridDim.x, bx = blockIdx.x;
    if (bx < G - 2) return;
    KArgs ka = oargs(); unsigned char* ws = ka->ws;
    const int tid = otid(), src = bx - (G - 2); const float* pe = ka->in[src ? 22 : 19]; const float* w1 = ka->in[src ? 23 : 20];
    LAS f32x4* red = (LAS f32x4*)LDS_PTR();
    const int d4 = tid & 31, kq = tid >> 5;
    f32x4 acc = {0.f, 0.f, 0.f, 0.f};
#pragma unroll 1
    for (int k = kq * 256; k < kq * 256 + 256; k += 16) {
        f32x4 w[16]; float pv[16];
#pragma unroll
        for (int e = 0; e < 16; ++e) { w[e] = *(const f32x4*)(w1 + (size_t)(k + e) * 128 + 4 * d4); pv[e] = pe[k + e]; }
#pragma unroll
        for (int e = 0; e < 16; ++e) acc += w[e] * pv[e];
    }
    __syncthreads();
    red[tid] = acc; __syncthreads();
    if (tid < 32) { f32x4 sum = red[tid];
#pragma unroll
        for (int q = 1; q < 16; ++q) sum += red[q * 32 + tid];
        *(f32x4*)((float*)(ws + WS_PEB) + src * 128 + 4 * tid) = sum; }
    __syncthreads();
}

DI void ph_conv_ffn2() {
    const int G = gridDim.x, bx = blockIdx.x, nlong = (3136 % G);
    if (G <= nlong || bx < nlong) return;
    KArgs ka = oargs();
    const int tid = otid(), lane = tid & 63, wave = __builtin_amdgcn_readfirstlane(tid >> 6);
    __syncthreads();
    conv_jobs_w(9, 11, ka, LDS_PTR(), (bx - nlong) * NWV + wave, 1, (G - nlong) * NWV, wave, lane);
    __syncthreads();
}

__global__ void __launch_bounds__(NTHR) fwd_kernel(Args args_unused) {
    cg::grid_group grid = cg::this_grid();
    {
        volatile LAS unsigned* st = (volatile LAS unsigned*)(LDS_PTR() + LDS_BARST);
        if (threadIdx.x < 2) st[threadIdx.x] = 0u;
        __syncthreads();
        if (threadIdx.x == 0) (void)xb_add((unsigned*)(oargs()->ws + WS_BAR) + XB_XCNT(xb_xcc_id()), 1u);
    }
#ifndef PH_MASK
#define PH_MASK 0xffff
#endif
#define WSP() (oargs()->ws)
#ifndef PROBE_DUP
#define PROBE_DUP 0
#endif
#ifndef PROBE_SPIN
#define PROBE_SPIN 0
#endif
#define RUN(k, bit, body) if (oargs()->ph_lo <= (k) && (k) < oargs()->ph_hi) { unsigned long long _t0 = 0; if (((PROBE_SPIN) >> (k)) & 1) _t0 = __builtin_amdgcn_s_memrealtime(); \
    for (int _rep = 0; _rep < 1 + (((PROBE_DUP) >> (bit)) & 1); ++_rep) if (((PH_MASK) >> (bit)) & 1) { body; } \
    if (((PROBE_SPIN) >> (k)) & 1) { __syncthreads(); const unsigned long long _t1 = __builtin_amdgcn_s_memrealtime(); while (__builtin_amdgcn_s_memrealtime() - _t1 < _t1 - _t0) __builtin_amdgcn_s_sleep(8); } }
#define SEAMX(k) if (oargs()->ph_lo <= (k) && (k) + 1 < oargs()->ph_hi) { if (oargs()->ph_hi > 1000) grid.sync(); else xcd_barrier((unsigned*)(oargs()->ws + WS_BAR)); }
    RUN(0, 0, ph_prologue()) SEAMX(0)
    RUN(1, 1, ph_rows(0)) SEAMX(1)
    RUN(2, 2, ph_ffn_up(WSP())) SEAMX(2)
    RUN(3, 3, ph_ffn_down(WSP())) SEAMX(3)
    RUN(4, 4, ph_rows(1)) SEAMX(4)
    RUN(5, 5, ph_inproj(WSP()); ph_vt(WSP()); ph_pebias(); ph_conv_ffn2()) SEAMX(5)
    RUN(6, 6, ph_cmp1(WSP())) SEAMX(6)
    RUN(7, 7, ph_cmp2(WSP()); __syncthreads(); ph_lru_fused(oargs()->ws, oargs()->in[12], oargs()->in[13], oargs()->in[15], oargs()->in[17], oargs()->in[18]))
    SEAMX(7)
    RUN(8, 8, ph_nsa(WSP())) SEAMX(8)
    RUN(9, 9, ph_ya(WSP()))
    RUN(10, 10, ph_yb(WSP())) SEAMX(10)
    RUN(11, 11, ph_out(WSP())) SEAMX(11)
    RUN(12, 12, ph_rows(2)) SEAMX(12)
    RUN(13, 2, ph_ffn_up(WSP())) SEAMX(13)
    RUN(14, 3, ph_ffn_down(WSP())) SEAMX(14)
    RUN(15, 15, ph_rows(3))
}

extern "C" void kernel_launch(void* const* d_in, const int* in_sizes, int n_in, void* d_out, int out_size, void* d_ws, size_t ws_size, hipStream_t stream) {
    static int grid = 0;
    if (grid == 0) {
        if (n_in != 33 || out_size != T * DM || ws_size < WS_END) { fprintf(stderr, "kernel_launch: unexpected problem (n_in %d out %d ws %zu)\n", n_in, out_size, ws_size); grid = -1; return; }
        int dev = 0, cus = 0, per_cu = 0;
        hipGetDevice(&dev); hipDeviceGetAttribute(&cus, hipDeviceAttributeMultiprocessorCount, dev);
        if (hipFuncSetAttribute((const void*)fwd_kernel, hipFuncAttributeMaxDynamicSharedMemorySize, LDS_BYTES) != hipSuccess) { fprintf(stderr, "kernel_launch: hipFuncSetAttribute failed\n"); grid = -1; return; }
        if (hipOccupancyMaxActiveBlocksPerMultiprocessor(&per_cu, (const void*)fwd_kernel, NTHR, LDS_BYTES) != hipSuccess || per_cu < 1) { fprintf(stderr, "kernel_launch: occupancy query gives %d\n", per_cu); per_cu = 1; }
        (void)hipGetLastError();
        grid = cus;
    }
    if (grid < 0) return;
    if (hipMemsetAsync((char*)d_ws + WS_BAR, 0, 16384, stream) != hipSuccess) { fprintf(stderr, "kernel_launch: memset of the barrier words failed\n"); return; }
    Args a{};
    for (int i = 0; i < 33; ++i) a.in[i] = (const float*)d_in[i];
    a.out = (float*)d_out; a.ws = (unsigned char*)d_ws;
#if ONE_LAUNCH
    a.ph_lo = 0; a.ph_hi = 16;
    void* params[] = {&a};
    hipError_t e = hipLaunchCooperativeKernel((const void*)fwd_kernel, dim3(grid), dim3(NTHR), params, LDS_BYTES, stream);
    if (e != hipSuccess) fprintf(stderr, "cooperative launch failed: %s (grid %d)\n", hipGetErrorString(e), grid);
#else
    for (int p = 0; p < 16; ++p) { a.ph_lo = p; a.ph_hi = p + 1; hipLaunchKernelGGL(fwd_kernel, dim3(grid), dim3(NTHR), LDS_BYTES, stream, a); }
#endif
}
```

```cpp
#include <hip/hip_runtime.h>
#include <hip/hip_cooperative_groups.h>
#include <cstdio>
#include <cstdint>
namespace cg = cooperative_groups;


#ifndef ONE_LAUNCH
#define ONE_LAUNCH 1
#endif

#define LAS __attribute__((address_space(3)))
#define DI __device__ __forceinline__
typedef unsigned short bf16_t;
typedef short bf16x8 __attribute__((ext_vector_type(8)));
typedef short s16x4 __attribute__((ext_vector_type(4)));
typedef float f32x2 __attribute__((ext_vector_type(2)));
typedef float f32x4 __attribute__((ext_vector_type(4)));
typedef float f32x16 __attribute__((ext_vector_type(16)));
typedef unsigned u32x2 __attribute__((ext_vector_type(2)));
typedef unsigned u32x4 __attribute__((ext_vector_type(4)));
typedef __bf16 bf16x2_t __attribute__((ext_vector_type(2)));

constexpr int DM = 2048, NB = 8, SEQ = 2048, T = NB * SEQ, DFF = 5632, NADA = 9;
constexpr int INW = 13360;
constexpr int NTHR = 512, NWV = 8;
constexpr float EPS = 1e-6f;
constexpr size_t MiB = 1u << 20;
constexpr size_t WS_MOD = 0;
constexpr size_t WS_ROPE = 640 * 1024;
constexpr size_t WS_PEB = 900 * 1024;
constexpr size_t WS_W2T = 1 * MiB;
constexpr size_t WS_WGU = 2 * MiB, WS_WD = 46 * MiB;
constexpr size_t WS_BB = 2 * MiB;
constexpr size_t WS_WIN = 68 * MiB, WS_WV = 117 * MiB, WS_WA = 640 * MiB, WS_WB = 648 * MiB, WS_WO = 656 * MiB;
constexpr size_t WS_HG = 68 * MiB;
constexpr size_t WS_PART = 68 * MiB;
constexpr size_t WS_W1T = 145 * MiB, WS_WRI = 147 * MiB, WS_KCC = 152 * MiB, WS_VCT = 153 * MiB, WS_NG = 154 * MiB;
constexpr size_t WS_U = 160 * MiB;
constexpr size_t WS_H = 224 * MiB, WS_F = 400 * MiB;
constexpr size_t WS_XA = 224 * MiB, WS_GY = 288 * MiB, WS_Q = 352 * MiB, WS_KC = 416 * MiB, WS_VC = 432 * MiB, WS_KS = 448 * MiB, WS_KW = 464 * MiB;
constexpr size_t WS_VST = 480 * MiB, WS_VWT = 496 * MiB, WS_MG = 512 * MiB, WS_FMIX = 512 * MiB;
constexpr size_t WS_END = 664 * MiB;
constexpr int LDS_BYTES = 147456;

struct Args { const float* in[33]; float* out; unsigned char* ws; int ph_lo, ph_hi; };
typedef const Args __attribute__((address_space(4)))* KArgs;

DI unsigned pk2(float lo, float hi) { f32x2 v = {lo, hi}; bf16x2_t b = __builtin_convertvector(v, bf16x2_t); return __builtin_bit_cast(unsigned, b); }
DI float bf2f(bf16_t v) { return __uint_as_float((unsigned)v << 16); }
DI float bflo(unsigned w) { return __uint_as_float(w << 16); }
DI float bfhi(unsigned w) { return __uint_as_float(w & 0xffff0000u); }
DI float sigm(float x) { return __builtin_amdgcn_rcpf(1.f + __builtin_amdgcn_exp2f(-1.4426950408889634f * x)); }
DI float gelu_t(float x) { const float u = 0.7978845608028654f * (x + 0.044715f * x * x * x); return x * __builtin_amdgcn_rcpf(1.f + __builtin_amdgcn_exp2f(-2.8853900817779268f * u)); }
DI float wave_sum(float v) {
#pragma unroll
    for (int o = 1; o < 64; o <<= 1) v += __shfl_xor(v, o);
    return v;
}
#define LDS_WAIT() asm volatile("s_waitcnt lgkmcnt(0)" ::: "memory")
DI int otid() { int t = threadIdx.x; asm volatile("" : "+v"(t)); return t; }

namespace pg8 {
constexpr int BM = 256, BK = 64, HALF = 128, HTB = HALF * BK * 2, STAGE_BYTES = 8 * HTB, NXCD = 8, WGM = 8;
DI int lds_byte(int r, int c) { const int st = (r >> 4) * 2 + (c >> 5), rr = r & 15, cc = c & 31, ob = rr * 64 + cc * 2; return st * 1024 + (ob ^ (((ob >> 9) & 1) << 5)); }
DI void stage_rc(int b, int& R, int& C) { const int st = b / 1024, sb = b % 1024, swz = sb ^ (((sb >> 9) & 1) << 5); R = (st >> 1) * 16 + swz / 64; C = (st & 1) * 32 + (swz % 64) / 2; }
DI int perm32(int rho) { const int n = rho >> 4, i = rho & 15; return 8 * (i >> 2) + 4 * n + (i & 3); }

struct Unit { int pm, pn; long aoff, boff; };
struct Gemm { const bf16_t* A; const bf16_t* Bt; int lda, ldb, K; };
struct Sched {
    int nM, nN, nwg, G, c, mode; long astep, bstep, srcstride;
    DI void init(int nM_, int nN_, int G_, int c_, long astep_, long bstep_) { nM = nM_; nN = nN_; nwg = nM * nN; G = G_; c = c_; mode = 0; astep = astep_; bstep = bstep_; srcstride = 0; }
    DI bool next(int i, Unit& u) const {
        const long L = (long)i * G + c; if (L >= nwg) return false;
        int wgid = (int)L;
        if (mode == 1) {
            const int pm = wgid & 15, ks = (wgid >> 4) & 7, src = wgid >> 7;
            u.pm = pm; u.pn = src + 2 * ks; u.aoff = (long)src * srcstride + (long)pm * 256 * 2048 * 2 + (long)ks * 1024; u.boff = (long)ks * 1024; return true;
        }
        { const int q = nwg / NXCD, r = nwg % NXCD, xcd = wgid % NXCD, off = wgid / NXCD; wgid = (xcd < r ? xcd * (q + 1) : r * (q + 1) + (xcd - r) * q) + off; }
        const int nig = WGM * nN, gid = wgid / nig, fm = gid * WGM, gsz = (nM - fm) < WGM ? (nM - fm) : WGM;
        u.pm = fm + ((wgid % nig) % gsz); u.pn = (wgid % nig) / gsz; u.aoff = (long)u.pm * astep; u.boff = (long)u.pn * bstep; return true;
    }
};

template <class Epi>
DI void gemm_phase(LAS unsigned char* lds, const Gemm g, const Sched& S, const Epi& E) {
    const int tid = otid(), wid = __builtin_amdgcn_readfirstlane(tid >> 6), lane = tid & 63, wr = wid >> 2, wc = wid & 3, fr = lane & 15, fq = lane >> 4;
    const int K = g.K, nt = K / BK;
    unsigned voffA[2], voffB[2];
#pragma unroll
    for (int i = 0; i < 2; ++i) { int R, C; stage_rc(tid * 16 + i * 8192, R, C); const int Rb = Epi::PERM ? ((R & ~31) + perm32(R & 31)) : R;
        voffA[i] = (unsigned)(R * g.lda + C) * 2u; voffB[i] = (unsigned)(Rb * g.ldb + C) * 2u; }
    const size_t kstep = (size_t)(BK * 2);
    const size_t hsA = (size_t)HALF * g.lda * 2, hsB = (size_t)HALF * g.ldb * 2;
    const unsigned ldsw = (unsigned)wid * 1024u;
    const int aoff = lds_byte(wr * 64 + fr, fq * 8), boff = lds_byte(wc * 32 + fr, fq * 8);
#define PG8_SA(b, h) (((b) * 2 + (h)) * HTB)
#define PG8_SB(b, h) ((4 + (b) * 2 + (h)) * HTB)
#define PG8_STAGE(bufoff, gbase, voff) do { _Pragma("unroll") for (int _i = 0; _i < 2; ++_i) \
        __builtin_amdgcn_global_load_lds((const unsigned*)((const char*)(gbase) + (voff)[_i]), (LAS unsigned*)(lds + (bufoff) + ldsw + _i * 8192), 16, 0, 0); } while (0)
#define PG8_LDA(dst, b, h) do { _Pragma("unroll") for (int m = 0; m < 4; ++m) _Pragma("unroll") for (int k = 0; k < 2; ++k) dst[m][k] = *(const LAS bf16x8*)(lds + PG8_SA(b, h) + aoff + m * 2048 + k * 1024); } while (0)
#define PG8_LDB(dst, b, h) do { _Pragma("unroll") for (int n = 0; n < 2; ++n) _Pragma("unroll") for (int k = 0; k < 2; ++k) dst[n][k] = *(const LAS bf16x8*)(lds + PG8_SB(b, h) + boff + n * 2048 + k * 1024); } while (0)
#define PG8_MMA(ai, bj, At, Bt) do { __builtin_amdgcn_s_setprio(1); _Pragma("unroll") for (int m = 0; m < 4; ++m) _Pragma("unroll") for (int n = 0; n < 2; ++n) _Pragma("unroll") for (int k = 0; k < 2; ++k) \
        acc[ai][bj][m][n] = __builtin_amdgcn_mfma_f32_16x16x32_bf16(Bt[n][k], At[m][k], acc[ai][bj][m][n], 0, 0, 0); __builtin_amdgcn_s_setprio(0); } while (0)
#define PG8_WAIT_V(n) asm volatile("s_waitcnt vmcnt(" #n ")" ::: "memory")
#define PG8_WAIT_L(n) asm volatile("s_waitcnt lgkmcnt(" #n ")" ::: "memory")
#define PG8_BAR __builtin_amdgcn_s_barrier()
#define PG8_SCHED __builtin_amdgcn_sched_barrier(0)
    Unit cur, nxt; int ui = 0;
    if (!S.next(0, cur)) return;
    f32x4 acc[2][2][4][2];
#pragma unroll
    for (int a = 0; a < 2; ++a)
#pragma unroll
        for (int b = 0; b < 2; ++b)
#pragma unroll
            for (int m = 0; m < 4; ++m)
#pragma unroll
                for (int n = 0; n < 2; ++n) acc[a][b][m][n] = (f32x4){0.f, 0.f, 0.f, 0.f};
    bf16x8 At[4][2], B0[2][2], B1[2][2];
    const char* cA = (const char*)g.A + cur.aoff; const char* cB = (const char*)g.Bt + cur.boff;
    PG8_STAGE(PG8_SB(0, 0), cB, voffB); PG8_STAGE(PG8_SB(0, 1), cB + hsB, voffB); PG8_STAGE(PG8_SA(0, 0), cA, voffA); PG8_STAGE(PG8_SA(0, 1), cA + hsA, voffA);
    if (wr == 1) PG8_BAR;
    PG8_WAIT_V(2); PG8_BAR;
    PG8_STAGE(PG8_SB(1, 0), cB + kstep, voffB); PG8_STAGE(PG8_SA(1, 0), cA + kstep, voffA); PG8_STAGE(PG8_SB(1, 1), cB + hsB + kstep, voffB);
    PG8_WAIT_V(6); PG8_BAR;
    for (;;) {
        const bool has_next = S.next(ui + 1, nxt);
        const char* nA = has_next ? (const char*)g.A + nxt.aoff : cA; const char* nB = has_next ? (const char*)g.Bt + nxt.boff : cB;
        for (int t = 0; t < nt; t += 2) {
            const bool last = (t == nt - 2);
            const char* a1 = cA + (size_t)(t + 1) * kstep;
            const char* a2 = last ? nA : cA + (size_t)(t + 2) * kstep; const char* b2 = last ? nB : cB + (size_t)(t + 2) * kstep;
            const char* a3 = a2 + kstep; const char* b3 = b2 + kstep;
            PG8_LDB(B0, 0, 0); PG8_LDB(B1, 0, 1); PG8_SCHED; PG8_LDA(At, 0, 0); PG8_STAGE(PG8_SA(1, 1), a1 + hsA, voffA);
            PG8_WAIT_V(8); PG8_WAIT_L(0); PG8_BAR; PG8_MMA(0, 0, At, B0); PG8_MMA(0, 1, At, B1); PG8_BAR; PG8_SCHED;
            PG8_LDA(At, 0, 1); PG8_STAGE(PG8_SB(0, 0), b2, voffB); PG8_STAGE(PG8_SB(0, 1), b2 + hsB, voffB); PG8_STAGE(PG8_SA(0, 0), a2, voffA);
            PG8_WAIT_V(8); PG8_WAIT_L(0); PG8_BAR; PG8_MMA(1, 0, At, B0); PG8_MMA(1, 1, At, B1); PG8_BAR; PG8_SCHED;
            PG8_LDB(B0, 1, 0); PG8_LDB(B1, 1, 1); PG8_SCHED; PG8_LDA(At, 1, 0); PG8_STAGE(PG8_SA(0, 1), a2 + hsA, voffA);
            PG8_WAIT_V(8); PG8_WAIT_L(0); PG8_BAR; PG8_MMA(0, 0, At, B0); PG8_MMA(0, 1, At, B1); PG8_BAR; PG8_SCHED;
            PG8_LDA(At, 1, 1); PG8_STAGE(PG8_SB(1, 0), b3, voffB); PG8_STAGE(PG8_SB(1, 1), b3 + hsB, voffB); PG8_STAGE(PG8_SA(1, 0), a3, voffA);
            PG8_WAIT_V(8); PG8_WAIT_L(0); PG8_BAR; PG8_MMA(1, 0, At, B0); PG8_MMA(1, 1, At, B1); PG8_BAR; PG8_SCHED;
        }
        if (wr == 0) PG8_BAR;
        E(acc, cur, wr, wc, fr, fq);
        if (!has_next) break;
#pragma unroll
        for (int a = 0; a < 2; ++a)
#pragma unroll
            for (int b = 0; b < 2; ++b)
#pragma unroll
                for (int m = 0; m < 4; ++m)
#pragma unroll
                    for (int n = 0; n < 2; ++n) acc[a][b][m][n] = (f32x4){0.f, 0.f, 0.f, 0.f};
        cur = nxt; cA = nA; cB = nB; ++ui;
        if (wr == 1) PG8_BAR;
    }
    PG8_WAIT_V(0);
    PG8_BAR;
#undef PG8_SA
#undef PG8_SB
#undef PG8_STAGE
#undef PG8_LDA
#undef PG8_LDB
#undef PG8_MMA
#undef PG8_WAIT_V
#undef PG8_WAIT_L
#undef PG8_BAR
#undef PG8_SCHED
}
}
using pg8::Unit;
typedef f32x4 AccT[2][2][4][2];

struct EpiFFN {
    static constexpr bool PERM = true; bf16_t* H;
    DI void operator()(const AccT& acc, const Unit& u, int wr, int wc, int fr, int fq) const {
        const int col = u.pn * 128 + wc * 32 + fq * 8;
#pragma unroll
        for (int ai = 0; ai < 2; ++ai)
#pragma unroll
            for (int m = 0; m < 4; ++m) {
                const int row = u.pm * 256 + ai * 128 + wr * 64 + m * 16 + fr;
                float v[8];
#pragma unroll
                for (int n = 0; n < 2; ++n)
#pragma unroll
                    for (int e = 0; e < 4; ++e) { const float gt = acc[ai][0][m][n][e], up = acc[ai][1][m][n][e]; v[n * 4 + e] = gt * sigm(gt) * up; }
                u32x4 w; w.x = pk2(v[0], v[1]); w.y = pk2(v[2], v[3]); w.z = pk2(v[4], v[5]); w.w = pk2(v[6], v[7]);
                *(u32x4*)(H + (size_t)row * DFF + col) = w;
            }
    }
};
struct EpiBf {
    static constexpr bool PERM = true; bf16_t* O;
    DI void operator()(const AccT& acc, const Unit& u, int wr, int wc, int fr, int fq) const {
#pragma unroll
        for (int ai = 0; ai < 2; ++ai)
#pragma unroll
            for (int m = 0; m < 4; ++m) {
                const int row = u.pm * 256 + ai * 128 + wr * 64 + m * 16 + fr;
#pragma unroll
                for (int bj = 0; bj < 2; ++bj) { const f32x4 v0 = acc[ai][bj][m][0], v1 = acc[ai][bj][m][1];
                    u32x4 w; w.x = pk2(v0[0], v0[1]); w.y = pk2(v0[2], v0[3]); w.z = pk2(v1[0], v1[1]); w.w = pk2(v1[2], v1[3]);
                    *(u32x4*)(O + (size_t)row * DM + u.pn * 256 + bj * 128 + wc * 32 + fq * 8) = w; }
            }
    }
};
struct EpiPart {
    static constexpr bool PERM = false; float* P;
    DI void operator()(const AccT& acc, const Unit& u, int wr, int wc, int fr, int fq) const {
        const int src = u.pn & 1, ks = u.pn >> 1;
        float* base = P + ((size_t)(ks * 2 + src) * 4096) * 128;
#pragma unroll
        for (int ai = 0; ai < 2; ++ai)
#pragma unroll
            for (int m = 0; m < 4; ++m) {
                const int row = u.pm * 256 + ai * 128 + wr * 64 + m * 16 + fr;
#pragma unroll
                for (int n = 0; n < 2; ++n) { const f32x4 v = src ? acc[ai][1][m][n] : acc[ai][0][m][n]; *(f32x4*)(base + (size_t)row * 128 + wc * 32 + n * 16 + fq * 4) = v; }
            }
    }
};
struct EpiVT {
    static constexpr bool PERM = true; bf16_t* VT0; bf16_t* VT1;
    DI void operator()(const AccT& acc, const Unit& u, int wr, int wc, int fr, int fq) const {
#pragma unroll
        for (int ai = 0; ai < 2; ++ai)
#pragma unroll
            for (int m = 0; m < 4; ++m) {
                const int r = u.pm * 256 + ai * 128 + wr * 64 + m * 16 + fr;
                const int piece = r >> 9, gg = (r >> 7) & 3, d = r & 127;
                bf16_t* base = piece ? VT1 : VT0;
#pragma unroll
                for (int bj = 0; bj < 2; ++bj) {
                    const int t = u.pn * 256 + bj * 128 + wc * 32 + fq * 8, b = t >> 11, s = t & 2047;
                    const f32x4 v0 = acc[ai][bj][m][0], v1 = acc[ai][bj][m][1];
                    u32x4 w; w.x = pk2(v0[0], v0[1]); w.y = pk2(v0[2], v0[3]); w.z = pk2(v1[0], v1[1]); w.w = pk2(v1[2], v1[3]);
                    *(u32x4*)(base + ((size_t)((b * 4 + gg) * 128 + d)) * 2048 + s) = w;
                }
            }
    }
};
struct EpiGate {
    static constexpr bool PERM = true; const bf16_t* MG; const bf16_t* YAG; bf16_t* O; int mode;
    DI void operator()(const AccT& acc, const Unit& u, int wr, int wc, int fr, int fq) const {
#pragma unroll
        for (int ai = 0; ai < 2; ++ai)
#pragma unroll
            for (int m = 0; m < 4; ++m) {
                const int row = u.pm * 256 + ai * 128 + wr * 64 + m * 16 + fr;
#pragma unroll
                for (int bj = 0; bj < 2; ++bj) {
                    const int col = u.pn * 256 + bj * 128 + wc * 32 + fq * 8;
                    const u32x4 gw = *(const u32x4*)(MG + (size_t)row * 4096 + (mode ? 2048 : 0) + col);
                    const f32x4 v0 = acc[ai][bj][m][0], v1 = acc[ai][bj][m][1];
                    float o[8] = {v0[0] * bflo(gw.x), v0[1] * bfhi(gw.x), v0[2] * bflo(gw.y), v0[3] * bfhi(gw.y), v1[0] * bflo(gw.z), v1[1] * bfhi(gw.z), v1[2] * bflo(gw.w), v1[3] * bfhi(gw.w)};
                    if (mode) { const u32x4 yw = *(const u32x4*)(YAG + (size_t)row * DM + col);
                        o[0] += bflo(yw.x); o[1] += bfhi(yw.x); o[2] += bflo(yw.y); o[3] += bfhi(yw.y); o[4] += bflo(yw.z); o[5] += bfhi(yw.z); o[6] += bflo(yw.w); o[7] += bfhi(yw.w); }
                    u32x4 w; w.x = pk2(o[0], o[1]); w.y = pk2(o[2], o[3]); w.z = pk2(o[4], o[5]); w.w = pk2(o[6], o[7]);
                    *(u32x4*)(O + (size_t)row * DM + col) = w;
                }
            }
    }
};
struct EpiIn {
    static constexpr bool PERM = true; unsigned char* ws; const float* rope;
    DI void operator()(const AccT& acc, const Unit& u, int wr, int wc, int fr, int fq) const {
#pragma unroll
        for (int bj = 0; bj < 2; ++bj) {
            const int c0 = u.pn * 256 + bj * 128 + wc * 32;
            const int col = c0 + fq * 8;
#pragma unroll
            for (int ai = 0; ai < 2; ++ai)
#pragma unroll
                for (int m = 0; m < 4; ++m) {
                    const int row = u.pm * 256 + ai * 128 + wr * 64 + m * 16 + fr;
                    const int b = row >> 11, s = row & 2047;
                    float v[8];
#pragma unroll
                    for (int n = 0; n < 2; ++n)
#pragma unroll
                        for (int e = 0; e < 4; ++e) v[n * 4 + e] = acc[ai][bj][m][n][e];
                    bf16_t* dst = nullptr;
                    if (c0 < 2048) { dst = (bf16_t*)(ws + WS_XA) + ((size_t)((b * 16 + (col >> 7)) * 2048 + s)) * 128 + (col & 127); }
                    else if (c0 < 4096) {
#pragma unroll
                        for (int e = 0; e < 8; ++e) v[e] = gelu_t(v[e]);
                        { const int chn = col - 2048; dst = (bf16_t*)(ws + WS_GY) + ((size_t)((b * 32 + (chn >> 6)) * 2048 + s)) * 64 + (chn & 63); } }
                    else if (c0 < 8192) {
                        const bool isq = c0 < 6144;
                        const int pc = (c0 - 6144) >> 9;
                        if ((c0 & 127) == 0 && (isq || pc != 1)) {
#pragma unroll
                            for (int e = 0; e < 8; ++e) {
                                const float invf = __builtin_amdgcn_exp2f(-(float)(8 * (fq & 1) + e) * 1.1832230356f), ang = (float)s * invf;
                                const float rev = ang * 0.15915494309189535f, fr = rev - floorf(rev);
                                const float cs = __builtin_amdgcn_cosf(fr), sn = __builtin_amdgcn_sinf(fr);
                                const float mine = v[e], other = __shfl_xor(mine, 32); v[e] = (fq < 2) ? mine * cs - other * sn : mine * cs + other * sn; }
                        }
                        if (isq) dst = (bf16_t*)(ws + WS_Q) + (size_t)row * DM + (col - 4096);
                        else { const int gg = ((c0 - 6144) >> 7) & 3, d = col & 127; dst = (bf16_t*)(ws + WS_KC + (size_t)pc * 16 * MiB) + ((size_t)((b * 4 + gg) * 2048 + s)) * 128 + d; }
                    }
                    else if (c0 < 12288) {
#pragma unroll
                        for (int e = 0; e < 8; ++e) v[e] = sigm(v[e]);
                        dst = (bf16_t*)(ws + WS_MG) + (size_t)row * 4096 + (col - 8192); }
                    else {
                        const int cc = col - 12288;
                        if (cc < 48) { float* ng = (float*)(ws + WS_NG) + (size_t)row * 48 + cc;
                            *(f32x4*)ng = (f32x4){sigm(v[0]), sigm(v[1]), sigm(v[2]), sigm(v[3])}; *(f32x4*)(ng + 4) = (f32x4){sigm(v[4]), sigm(v[5]), sigm(v[6]), sigm(v[7])}; }
                    }
                    if (dst) { u32x4 w; w.x = pk2(v[0], v[1]); w.y = pk2(v[2], v[3]); w.z = pk2(v[4], v[5]); w.w = pk2(v[6], v[7]); *(u32x4*)dst = w; }
                }
        }
    }
};

struct ConvJob { int K, Nd; };
DI const float* conv_src(int job, int d, KArgs a, int& ld) {
    switch (job) {
    case 0: case 9: { const int pn = d >> 8, half = (d >> 7) & 1, j = d & 127; ld = DFF; const int base = job == 0 ? 6 : 30; return a->in[base + half] + 128 * pn + j; }
    case 1: ld = DM; return a->in[8] + d;
    case 10: ld = DM; return a->in[32] + d;
    case 2: { ld = INW; int col;
        if (d < 7680) col = d; else if (d < 8192) col = d + 512; else if (d < 12288) col = d - 8192 + 9264; else if (d < 12336) col = d - 12288 + 9216; else return nullptr;
        return a->in[11] + col; }
    case 3: ld = INW; return a->in[11] + (d < 512 ? 7680 + d : 8704 + (d - 512));
    case 4: ld = DM; return a->in[25] + d;
    case 5: ld = DM; return a->in[26] + d;
    case 6: ld = DM; return a->in[27] + d;
    case 7: ld = 128; return (d < 128) ? a->in[20] + d : a->in[23] + (d - 128);
    case 8: { const int h = d >> 8, half = (d >> 7) & 1, j = d & 127; ld = 128; return (half ? a->in[16] : a->in[14]) + h * 16384 + j; }
    default: ld = 128; return (d < 128) ? a->in[21] + d : a->in[24] + (d - 128);
    }
}
DI bf16_t* conv_dst(int job, unsigned char* ws) {
    switch (job) {
    case 0: case 9: return (bf16_t*)(ws + WS_WGU);
    case 1: case 10: return (bf16_t*)(ws + WS_WD);
    case 2: return (bf16_t*)(ws + WS_WIN);
    case 3: return (bf16_t*)(ws + WS_WV);
    case 4: return (bf16_t*)(ws + WS_WA);
    case 5: return (bf16_t*)(ws + WS_WB);
    case 6: return (bf16_t*)(ws + WS_WO);
    case 7: return (bf16_t*)(ws + WS_W1T);
    case 8: return (bf16_t*)(ws + WS_WRI);
    default: return (bf16_t*)(ws + WS_W2T);
    }
}
DI void conv_dims(int job, int& K, int& Nd) {
    switch (job) {
    case 0: case 9: K = DM; Nd = 11264; break;
    case 1: case 10: K = DFF; Nd = DM; break;
    case 2: K = DM; Nd = 12544; break;
    case 3: K = DM; Nd = 1024; break;
    case 4: case 5: case 6: K = DM; Nd = DM; break;
    case 7: K = 4096; Nd = 256; break;
    case 8: K = 128; Nd = 4096; break;
    default: K = 128; Nd = 256; break;
    }
}
DI void conv_item(int job, int item, KArgs a, LAS float* scr, int lane) {
    int K, Nd; conv_dims(job, K, Nd);
    const int nkb = K / 64, kb = item % nkb, nb = item / nkb, k0 = 64 * kb, n0 = 64 * nb;
    const int kk = lane >> 4, n4 = lane & 15;
    int ld; const float* src = conv_src(job, n0 + 4 * n4, a, ld);
    f32x4 v[16];
#pragma unroll
    for (int i = 0; i < 16; ++i) v[i] = src ? *(const f32x4*)(src + (size_t)(k0 + 4 * i + kk) * ld) : (f32x4){0.f, 0.f, 0.f, 0.f};
#pragma unroll
    for (int i = 0; i < 16; ++i) { LAS float* q = scr + (4 * i + kk) * 65 + 4 * n4; q[0] = v[i][0]; q[1] = v[i][1]; q[2] = v[i][2]; q[3] = v[i][3]; }
    LDS_WAIT();
    bf16_t* WT = conv_dst(job, a->ws);
    const int c = lane & 7, nn = lane >> 3;
#pragma unroll
    for (int j = 0; j < 8; ++j) { const int n = nn + 8 * j; const LAS float* q = scr + (8 * c) * 65 + n;
        u32x4 o; o.x = pk2(q[0 * 65], q[1 * 65]); o.y = pk2(q[2 * 65], q[3 * 65]); o.z = pk2(q[4 * 65], q[5 * 65]); o.w = pk2(q[6 * 65], q[7 * 65]);
        *(u32x4*)(WT + (size_t)(n0 + n) * K + k0 + 8 * c) = o; }
    LDS_WAIT();
}
DI void conv_jobs(int jlo, int jhi, KArgs a, LAS unsigned char* lds, int gw, int ngw, int wave, int lane) {
    LAS float* scr = (LAS float*)(lds + wave * 16640);
    for (int job = jlo; job < jhi; ++job) {
        int K, Nd; conv_dims(job, K, Nd);
        const int nit = (K / 64) * (Nd / 64);
        for (int it = gw; it < nit; it += ngw) conv_item(job, it, a, scr, lane);
    }
}
DI void conv_pair(int job, int itA, int itB, bool hasB, KArgs a, LAS float* scr, int lane) {
    int K, Nd; conv_dims(job, K, Nd);
    const int nkb = K / 64; const int kk = lane >> 4, n4 = lane & 15;
    const int nblk = Nd / 64; (void)nkb;
    const int k0A = 64 * (itA / nblk), n0A = 64 * (itA % nblk), k0B = 64 * (itB / nblk), n0B = 64 * (itB % nblk);
    int ldA, ldB; const float* srcA = conv_src(job, n0A + 4 * n4, a, ldA); const float* srcB = hasB ? conv_src(job, n0B + 4 * n4, a, ldB) : nullptr; if (!hasB) ldB = 0;
    f32x4 vA[16], vB[16];
#pragma unroll
    for (int i = 0; i < 16; ++i) vA[i] = srcA ? *(const f32x4*)(srcA + (size_t)(k0A + 4 * i + kk) * ldA) : (f32x4){0.f, 0.f, 0.f, 0.f};
#pragma unroll
    for (int i = 0; i < 16; ++i) vB[i] = srcB ? *(const f32x4*)(srcB + (size_t)(k0B + 4 * i + kk) * ldB) : (f32x4){0.f, 0.f, 0.f, 0.f};
    bf16_t* WT = conv_dst(job, a->ws);
    const int c = lane & 7, nn = lane >> 3;
#pragma unroll
    for (int half = 0; half < 2; ++half) {
        if (half && !hasB) break;
#pragma unroll
        for (int i = 0; i < 16; ++i) { const f32x4 t = half ? vB[i] : vA[i]; LAS float* q = scr + (4 * i + kk) * 65 + 4 * n4; q[0] = t[0]; q[1] = t[1]; q[2] = t[2]; q[3] = t[3]; }
        LDS_WAIT();
        const int n0 = half ? n0B : n0A, k0 = half ? k0B : k0A;
#pragma unroll
        for (int j = 0; j < 8; ++j) { const int n = nn + 8 * j; const LAS float* q = scr + (8 * c) * 65 + n;
            u32x4 o; o.x = pk2(q[0 * 65], q[1 * 65]); o.y = pk2(q[2 * 65], q[3 * 65]); o.z = pk2(q[4 * 65], q[5 * 65]); o.w = pk2(q[6 * 65], q[7 * 65]);
            *(u32x4*)(WT + (size_t)(n0 + n) * K + k0 + 8 * c) = o; }
        LDS_WAIT();
    }
}
DI void conv_jobs_w(int jlo, int jhi, KArgs a, LAS unsigned char* lds, int pair0, int npair, int npairs, int wave, int lane) {
    LAS float* scr = (LAS float*)(lds + wave * 16640);
    for (int job = jlo; job < jhi; ++job) {
        int K, Nd; conv_dims(job, K, Nd);
        const int nit = (K / 64) * (Nd / 64);
        for (int it0 = 0; it0 < nit; it0 += 2 * npairs)
            for (int sl = 0; sl < npair; ++sl) { const int it = it0 + 2 * (pair0 + sl); if (it < nit) conv_pair(job, it, it + 1, it + 1 < nit, a, scr, lane); }
    }
}

DI int rcol(int q, int lane) { return 512 * (q >> 1) + 8 * lane + 4 * (q & 1); }
DI void row_load(f32x4 (&v)[8], const float* p, int lane) {
#pragma unroll
    for (int q = 0; q < 8; ++q) v[q] = *(const f32x4*)(p + rcol(q, lane));
}
DI void row_load_bf16(f32x4 (&v)[8], const bf16_t* p, int lane) {
#pragma unroll
    for (int j = 0; j < 4; ++j) { const u32x4 w = *(const u32x4*)(p + 512 * j + 8 * lane);
        v[2 * j] = (f32x4){bflo(w.x), bfhi(w.x), bflo(w.y), bfhi(w.y)}; v[2 * j + 1] = (f32x4){bflo(w.z), bfhi(w.z), bflo(w.w), bfhi(w.w)}; }
}
DI float row_rstd(const f32x4 (&v)[8]) {
    float s = 0.f;
#pragma unroll
    for (int j = 0; j < 8; ++j) s += (v[j][0] * v[j][0] + v[j][1] * v[j][1]) + (v[j][2] * v[j][2] + v[j][3] * v[j][3]);
    return rsqrtf(wave_sum(s) * (1.f / DM) + EPS);
}
DI void row_modulate_store(const f32x4 (&v)[8], float rstd, const float* g, const float* sh, const float* sc, bf16_t* o, int lane) {
#pragma unroll
    for (int j = 0; j < 4; ++j) { f32x4 r[2];
#pragma unroll
        for (int e = 0; e < 2; ++e) { const int c = rcol(2 * j + e, lane); const f32x4 gg = *(const f32x4*)(g + c), s1 = *(const f32x4*)(sh + c), s2 = *(const f32x4*)(sc + c);
            r[e] = (v[2 * j + e] * rstd * gg) * (s2 + 1.f) + s1; }
        u32x4 w; w.x = pk2(r[0][0], r[0][1]); w.y = pk2(r[0][2], r[0][3]); w.z = pk2(r[1][0], r[1][1]); w.w = pk2(r[1][2], r[1][3]);
        *(u32x4*)(o + 512 * j + 8 * lane) = w; }
}
DI void row_residual(f32x4 (&v)[8], const bf16_t* f, const float* xres, const float* gate, const float* pg, float wgt, float* xo, int lane) {
    f32x4 fv[8]; row_load_bf16(fv, f, lane); const float rs = row_rstd(fv);
#pragma unroll
    for (int j = 0; j < 8; ++j) { const int c = rcol(j, lane); const f32x4 xr = *(const f32x4*)(xres + c), gt = *(const f32x4*)(gate + c), pp = *(const f32x4*)(pg + c);
        v[j] = xr + (gt * wgt) * (fv[j] * rs * pp); *(f32x4*)(xo + c) = v[j]; }
}

#define MFMA32(a, b, c) __builtin_amdgcn_mfma_f32_32x32x16_bf16((a), (b), (c), 0, 0, 0)
DI int crow(int r, int hi) { return (r & 3) + 8 * (r >> 2) + 4 * hi; }
constexpr int KPITCH = 272, VPITCH = 136, KVBUF = 17408;
constexpr int AL_K = 0, AL_V = 2 * KVBUF, AL_IMP4 = 4 * KVBUF, AL_IMPS = AL_IMP4 + 32768, AL_SEL = AL_IMPS + 8192;
constexpr float NEGB = -1e30f;
struct KVRegs { u32x4 k0, k1, v0, v1; };
DI void kv_load(KVRegs& R, const bf16_t* Kt, const bf16_t* Vt, int vpitch, int tid) {
    const int c = tid, c2 = tid + 512;
    R.k0 = *(const u32x4*)(Kt + (c >> 4) * 128 + (c & 15) * 8); R.k1 = *(const u32x4*)(Kt + (c2 >> 4) * 128 + (c2 & 15) * 8);
    R.v0 = *(const u32x4*)(Vt + (size_t)(c >> 3) * vpitch + (c & 7) * 8); R.v1 = *(const u32x4*)(Vt + (size_t)(c2 >> 3) * vpitch + (c2 & 7) * 8);
}
DI void kv_store(const KVRegs& R, LAS unsigned char* KB, LAS unsigned char* VB, int tid) {
    const int c = tid, c2 = tid + 512;
    *(LAS u32x4*)(KB + (c >> 4) * KPITCH + (c & 15) * 16) = R.k0; *(LAS u32x4*)(KB + (c2 >> 4) * KPITCH + (c2 & 15) * 16) = R.k1;
    LAS unsigned char* p = VB + (c >> 3) * VPITCH + (c & 7) * 16; *(LAS u32x2*)p = (u32x2){R.v0.x, R.v0.y}; *(LAS u32x2*)(p + 8) = (u32x2){R.v0.z, R.v0.w};
    p = VB + (c2 >> 3) * VPITCH + (c2 & 7) * 16; *(LAS u32x2*)p = (u32x2){R.v1.x, R.v1.y}; *(LAS u32x2*)(p + 8) = (u32x2){R.v1.z, R.v1.w};
}
DI void qk_tile(f32x16& p0, f32x16& p1, const LAS unsigned char* KB, const bf16x8 (&qr)[8], int r, int hi) {
#pragma unroll
    for (int i = 0; i < 16; ++i) { p0[i] = 0.f; p1[i] = 0.f; }
    const LAS unsigned char* k0p = KB + r * KPITCH + hi * 16; const LAS unsigned char* k1p = KB + (32 + r) * KPITCH + hi * 16;
    bf16x8 a0[8], a1[8];
    a0[0] = *(const LAS bf16x8*)(k0p); a1[0] = *(const LAS bf16x8*)(k1p);
    a0[1] = *(const LAS bf16x8*)(k0p + 32); a1[1] = *(const LAS bf16x8*)(k1p + 32);
#pragma unroll
    for (int d0 = 0; d0 < 8; ++d0) {
        if (d0 + 2 < 8) { a0[d0 + 2] = *(const LAS bf16x8*)(k0p + (d0 + 2) * 32); a1[d0 + 2] = *(const LAS bf16x8*)(k1p + (d0 + 2) * 32); }
        p0 = MFMA32(a0[d0], qr[d0], p0); p1 = MFMA32(a1[d0], qr[d0], p1);
        if (d0 + 2 < 8) __builtin_amdgcn_sched_group_barrier(0x100, 2, 0);
        __builtin_amdgcn_sched_group_barrier(0x008, 2, 0);
    }
}
DI bf16x8 pack8(const f32x16& p, int s2) {
    u32x4 w; w.x = pk2(p[8 * s2], p[8 * s2 + 1]); w.y = pk2(p[8 * s2 + 2], p[8 * s2 + 3]); w.z = pk2(p[8 * s2 + 4], p[8 * s2 + 5]); w.w = pk2(p[8 * s2 + 6], p[8 * s2 + 7]);
    return __builtin_bit_cast(bf16x8, w);
}
DI void pv_tile(f32x16 (&o)[4], const LAS unsigned char* VB, const f32x16& p0, const f32x16& p1, int r, int hi) {
    const bf16x8 pf[4] = {pack8(p0, 0), pack8(p0, 1), pack8(p1, 0), pack8(p1, 1)};
    s16x4 lo[16], hh[16];
#define PV_LD(t) do { const int kbs = (t) >> 2, db_ = (t) & 3; const LAS unsigned char* base = VB + (32 * db_ + r) * VPITCH + (16 * kbs + 4 * hi) * 2; \
        lo[t] = *(const LAS s16x4*)base; hh[t] = *(const LAS s16x4*)(base + 16); } while (0)
    PV_LD(0); PV_LD(1);
#pragma unroll
    for (int t = 0; t < 16; ++t) {
        if (t + 2 < 16) PV_LD(t + 2);
        const bf16x8 af = __builtin_shufflevector(lo[t], hh[t], 0, 1, 2, 3, 4, 5, 6, 7);
        o[t & 3] = MFMA32(af, pf[t >> 2], o[t & 3]);
        if (t + 2 < 16) __builtin_amdgcn_sched_group_barrier(0x100, 2, 0);
        __builtin_amdgcn_sched_group_barrier(0x008, 1, 0);
    }
#undef PV_LD
}
constexpr float SCL = 0.08838834764831845f * 1.4426950408889634f;

DI void flash_step(f32x16 (&o)[4], float& mrun, float& lrun, const LAS unsigned char* KB, const LAS unsigned char* VB, const bf16x8 (&qr)[8],
                   int r, int hi, int qpos, int key0, bool rowok, bool need_c, bool need_w) {
    f32x16 p0, p1; qk_tile(p0, p1, KB, qr, r, hi);
    float mnew, alpha, ls = 0.f;
    if (!need_c && !need_w) {
        float mt = fmaxf(p0[0], p1[0]);
#pragma unroll
        for (int i = 1; i < 16; ++i) mt = fmaxf(mt, fmaxf(p0[i], p1[i]));
        mt = rowok ? mt * SCL : NEGB;
        mt = fmaxf(mt, __shfl_xor(mt, 32));
        mnew = fmaxf(mrun, mt);
        alpha = __builtin_amdgcn_exp2f(mrun - mnew);
        const float nb = rowok ? -mnew : NEGB;
#pragma unroll
        for (int i = 0; i < 16; ++i) {
            p0[i] = __builtin_amdgcn_exp2f(__builtin_fmaf(p0[i], SCL, nb));
            p1[i] = __builtin_amdgcn_exp2f(__builtin_fmaf(p1[i], SCL, nb));
            ls += p0[i] + p1[i];
        }
    } else {
        float mt = NEGB;
#pragma unroll
        for (int i = 0; i < 16; ++i) {
            const int k0 = key0 + crow(i, hi), k1 = k0 + 32;
            bool v0 = rowok, v1 = rowok;
            if (need_c) { v0 = v0 && (k0 <= qpos); v1 = v1 && (k1 <= qpos); }
            if (need_w) { v0 = v0 && (k0 > qpos - 512); v1 = v1 && (k1 > qpos - 512); }
            p0[i] = v0 ? p0[i] * SCL : NEGB; p1[i] = v1 ? p1[i] * SCL : NEGB;
            mt = fmaxf(mt, fmaxf(p0[i], p1[i]));
        }
        mt = fmaxf(mt, __shfl_xor(mt, 32));
        mnew = fmaxf(mrun, mt);
        alpha = __builtin_amdgcn_exp2f(mrun - mnew);
#pragma unroll
        for (int i = 0; i < 16; ++i) {
            p0[i] = __builtin_amdgcn_exp2f(p0[i] - mnew);
            p1[i] = __builtin_amdgcn_exp2f(p1[i] - mnew);
            ls += p0[i] + p1[i];
        }
    }
    lrun = lrun * alpha + ls;
    if (__any(mnew > mrun)) {
#pragma unroll
        for (int db = 0; db < 4; ++db)
#pragma unroll
            for (int i = 0; i < 16; ++i) o[db][i] *= alpha;
    }
    mrun = mnew;
    pv_tile(o, VB, p0, p1, r, hi);
}

DI void nsa_unit(int bg, int qblk, unsigned char* ws, LAS unsigned char* lds) {
    const int tid = otid(), lane = tid & 63, r = lane & 31, hi = lane >> 5, wave = __builtin_amdgcn_readfirstlane(tid >> 6);
    const int b = bg >> 2, g = bg & 3, head = g * 4 + (wave >> 1), q0 = qblk * 64, qw0 = q0 + 32 * (wave & 1), qpos = qw0 + r;
    const size_t trow = (size_t)b * SEQ + qpos;
    const bf16_t* Qp = (const bf16_t*)(ws + WS_Q) + trow * DM + head * 128;
    bf16_t* Op = (bf16_t*)(ws + WS_XA) + trow * DM + head * 128;
    bf16x8 qr[8];
#pragma unroll
    for (int d0 = 0; d0 < 8; ++d0) qr[d0] = *(const bf16x8*)(Qp + d0 * 16 + hi * 8);
    const float* ngp = (const float*)(ws + WS_NG) + trow * 48 + head * 3;
    const float g0 = ngp[0], g1 = ngp[1], g2 = ngp[2];
    LAS unsigned char* KB0 = lds + AL_K; LAS unsigned char* VB0 = lds + AL_V;
    LAS float* IMP4 = (LAS float*)(lds + AL_IMP4); LAS float* IMPS = (LAS float*)(lds + AL_IMPS); LAS unsigned* SEL = (LAS unsigned*)(lds + AL_SEL);
    unsigned opk[4][8];
    KVRegs R;
    {
        const bf16_t* kc = (const bf16_t*)(ws + WS_KCC) + (size_t)bg * 128 * 128;
        const bf16_t* vct = (const bf16_t*)(ws + WS_VCT) + (size_t)bg * 128 * 128;
        { KVRegs R2; kv_load(R, kc, vct, 128, tid); kv_load(R2, kc + 64 * 128, vct + 64, 128, tid);
          kv_store(R, KB0, VB0, tid); kv_store(R2, KB0 + KVBUF, VB0 + KVBUF, tid); }
        if (tid < 65) SEL[tid] = 0u;
        __syncthreads();
        f32x16 pa0, pa1, pb0, pb1;
        qk_tile(pa0, pa1, KB0, qr, r, hi); qk_tile(pb0, pb1, KB0 + KVBUF, qr, r, hi);
        float mt = NEGB;
#pragma unroll
        for (int i = 0; i < 16; ++i) {
            const int n = crow(i, hi);
            pa0[i] = (16 * n + 31 <= qpos) ? pa0[i] * SCL : NEGB; pa1[i] = (16 * (n + 32) + 31 <= qpos) ? pa1[i] * SCL : NEGB;
            pb0[i] = (16 * (n + 64) + 31 <= qpos) ? pb0[i] * SCL : NEGB; pb1[i] = (16 * (n + 96) + 31 <= qpos) ? pb1[i] * SCL : NEGB;
            mt = fmaxf(fmaxf(mt, fmaxf(pa0[i], pa1[i])), fmaxf(pb0[i], pb1[i]));
        }
        mt = fmaxf(mt, __shfl_xor(mt, 32));
        float ls = 0.f;
#pragma unroll
        for (int i = 0; i < 16; ++i) {
            pa0[i] = (pa0[i] > -1e29f) ? __builtin_amdgcn_exp2f(pa0[i] - mt) : 0.f; pa1[i] = (pa1[i] > -1e29f) ? __builtin_amdgcn_exp2f(pa1[i] - mt) : 0.f;
            pb0[i] = (pb0[i] > -1e29f) ? __builtin_amdgcn_exp2f(pb0[i] - mt) : 0.f; pb1[i] = (pb1[i] > -1e29f) ? __builtin_amdgcn_exp2f(pb1[i] - mt) : 0.f;
            ls += (pa0[i] + pa1[i]) + (pb0[i] + pb1[i]);
        }
        ls += __shfl_xor(ls, 32);
        const float inv = ls > 0.f ? 1.f / ls : 0.f;
#pragma unroll
        for (int i = 0; i < 16; ++i) { pa0[i] *= inv; pa1[i] *= inv; pb0[i] *= inv; pb1[i] *= inv; }
        if (qblk >= 16) {
            LAS float* ip = IMP4 + ((wave >> 1) * 64 + 32 * (wave & 1) + r) * 32;
#define IMP_G(P, blk) _Pragma("unroll") for (int g4 = 0; g4 < 4; ++g4) ip[8 * (blk) + 2 * g4 + hi] = (P[4 * g4] + P[4 * g4 + 1]) + (P[4 * g4 + 2] + P[4 * g4 + 3]);
            IMP_G(pa0, 0) IMP_G(pa1, 1) IMP_G(pb0, 2) IMP_G(pb1, 3)
            LDS_WAIT();
#define IMP_L(P, blk) _Pragma("unroll") for (int g4 = 0; g4 < 4; ++g4) { const int j1 = 8 * (blk) + 2 * g4 + hi + 1; if (j1 < 32) ip[j1] += P[4 * g4 + 3]; }
            IMP_L(pa0, 0) IMP_L(pa1, 1) IMP_L(pb0, 2) IMP_L(pb1, 3)
#undef IMP_G
#undef IMP_L
        }
        f32x16 oc[4];
#pragma unroll
        for (int db = 0; db < 4; ++db)
#pragma unroll
            for (int i = 0; i < 16; ++i) oc[db][i] = 0.f;
        pv_tile(oc, VB0, pa0, pa1, r, hi); pv_tile(oc, VB0 + KVBUF, pb0, pb1, r, hi);
#pragma unroll
        for (int db = 0; db < 4; ++db)
#pragma unroll
            for (int i = 0; i < 8; ++i) opk[db][i] = pk2(oc[db][2 * i] * g0, oc[db][2 * i + 1] * g0);
    }
    __syncthreads();
    if (qblk >= 16) {
#pragma unroll
        for (int e = 0; e < 4; ++e) { const int idx = tid + 512 * e; IMPS[idx] = (IMP4[idx] + IMP4[2048 + idx]) + (IMP4[4096 + idx] + IMP4[6144 + idx]); }
        __syncthreads();
        const int q = tid >> 3;
        float val[32];
#pragma unroll
        for (int j4 = 0; j4 < 8; ++j4) { const f32x4 t4 = *(const LAS f32x4*)(IMPS + q * 32 + 4 * j4); val[4 * j4] = t4[0]; val[4 * j4 + 1] = t4[1]; val[4 * j4 + 2] = t4[2]; val[4 * j4 + 3] = t4[3]; }
        unsigned bits = 0u;
#pragma unroll
        for (int e = 0; e < 4; ++e) {
            const int j = (tid & 7) * 4 + e;
            float vj = 0.f;
#pragma unroll
            for (int i = 0; i < 32; ++i) vj = (i == j) ? val[i] : vj;
            int rank = 0;
#pragma unroll
            for (int i = 1; i < 32; ++i) { const bool cand = (i <= qblk - 2); rank += (cand && (val[i] > vj || (val[i] == vj && i < j))) ? 1 : 0; }
            const bool forced = (j == 0) || (j == qblk) || (j == qblk - 1);
            const bool sel = forced || (j >= 1 && j <= qblk - 2 && rank < 13);
            bits |= sel ? (1u << j) : 0u;
        }
        __hip_atomic_fetch_or(SEL + q, bits, __ATOMIC_RELAXED, __HIP_MEMORY_SCOPE_WORKGROUP);
        __syncthreads();
    } else {
        if (tid < 64) SEL[tid] = (2u << qblk) - 1u;
        __syncthreads();
    }
    if (tid < 64) { unsigned v = SEL[tid];
#pragma unroll
        for (int o = 1; o < 64; o <<= 1) v |= __shfl_xor(v, o);
        if (tid == 0) SEL[64] = v; }
    __syncthreads();
    const unsigned mysel = SEL[32 * (wave & 1) + r];
    unsigned uni = (unsigned)__builtin_amdgcn_readfirstlane(SEL[64]) & ((2u << qblk) - 1u);
    __syncthreads();
    LAS unsigned* OPK = (LAS unsigned*)(lds + AL_IMP4) + tid;
#pragma unroll
    for (int db = 0; db < 4; ++db)
#pragma unroll
        for (int i = 0; i < 8; ++i) OPK[(db * 8 + i) * 512] = opk[db][i];
    int bi = 0;
#pragma unroll 1
    for (int mode = 0; mode < 2; ++mode) {
        const bf16_t* Kg = (const bf16_t*)(ws + (mode ? WS_KW : WS_KS)) + (size_t)bg * SEQ * 128;
        const bf16_t* Vg = (const bf16_t*)(ws + (mode ? WS_VWT : WS_VST)) + (size_t)bg * 128 * SEQ;
        unsigned todo;
        if (mode) { const int jlo = qblk >= 8 ? qblk - 8 : 0; todo = ((2u << qblk) - 1u) & ~((1u << jlo) - 1u); } else todo = uni;
        f32x16 o[4];
#pragma unroll
        for (int db = 0; db < 4; ++db)
#pragma unroll
            for (int i = 0; i < 16; ++i) o[db][i] = 0.f;
        float mrun = -1e20f, lrun = 0.f;
        int cur = __builtin_ctz(todo); todo &= todo - 1u;
        if (mode == 0) { kv_load(R, Kg + (size_t)cur * 64 * 128, Vg + cur * 64, SEQ, tid); kv_store(R, KB0, VB0, tid); bi = 0; }
        for (;;) {
            __syncthreads();
            const int nxt = todo ? __builtin_ctz(todo) : -1; todo &= todo - 1u;
            const bool stage_next = (nxt < 0) && (mode == 0);
            if (nxt >= 0) kv_load(R, Kg + (size_t)nxt * 64 * 128, Vg + nxt * 64, SEQ, tid);
            else if (stage_next) { const int jl = qblk >= 8 ? qblk - 8 : 0;
                kv_load(R, (const bf16_t*)(ws + WS_KW) + (size_t)bg * SEQ * 128 + (size_t)jl * 64 * 128, (const bf16_t*)(ws + WS_VWT) + (size_t)bg * 128 * SEQ + jl * 64, SEQ, tid); }
            const int key0 = cur * 64;
            const bool rowok = mode ? true : (((mysel >> cur) & 1u) != 0u);
            const bool need_c = (key0 + 63 > qw0), need_w = mode && (key0 <= qw0 + 31 - 512);
            const bool wave_skip = mode ? (key0 + 63 <= qw0 - 512) : !__any(rowok);
            if (!wave_skip) flash_step(o, mrun, lrun, KB0 + bi * KVBUF, VB0 + bi * KVBUF, qr, r, hi, qpos, key0, rowok, need_c, need_w);
            if (nxt < 0 && !stage_next) break;
            kv_store(R, KB0 + (bi ^ 1) * KVBUF, VB0 + (bi ^ 1) * KVBUF, tid);
            bi ^= 1; cur = nxt;
            if (nxt < 0) break;
        }
        __syncthreads();
        lrun += __shfl_xor(lrun, 32);
        const float sc = (mode ? g2 : g1) / lrun;
#pragma unroll
        for (int db = 0; db < 4; ++db)
#pragma unroll
            for (int i = 0; i < 8; ++i) { const unsigned w = OPK[(db * 8 + i) * 512]; opk[db][i] = pk2(bflo(w) + o[db][2 * i] * sc, bfhi(w) + o[db][2 * i + 1] * sc); if (mode == 0) OPK[(db * 8 + i) * 512] = opk[db][i]; }
    }
#pragma unroll
    for (int db = 0; db < 4; ++db)
#pragma unroll
        for (int g4 = 0; g4 < 4; ++g4) { u32x2 w; w.x = opk[db][2 * g4]; w.y = opk[db][2 * g4 + 1];
            *(u32x2*)(Op + 32 * db + 8 * g4 + 4 * hi) = w; }
}

#define NOINL __forceinline__
#define LDS_PTR() ((LAS unsigned char*)lds_raw)
extern __shared__ __attribute__((aligned(16))) unsigned char lds_raw[];

NOINL __device__ void ph_ffn_up(unsigned char* ws) {
    pg8::Gemm g{(const bf16_t*)(ws + WS_U), (const bf16_t*)(ws + WS_WGU), DM, DM, DM}; pg8::Sched S; S.init(64, 44, gridDim.x, blockIdx.x, 256L * DM * 2, 256L * DM * 2);
    EpiFFN E{(bf16_t*)(ws + WS_H)}; pg8::gemm_phase(LDS_PTR(), g, S, E);
}
NOINL __device__ void ph_ffn_down(unsigned char* ws) {
    pg8::Gemm g{(const bf16_t*)(ws + WS_H), (const bf16_t*)(ws + WS_WD), DFF, DFF, DFF}; pg8::Sched S; S.init(64, 8, gridDim.x, blockIdx.x, 256L * DFF * 2, 256L * DFF * 2);
    EpiBf E{(bf16_t*)(ws + WS_F)}; pg8::gemm_phase(LDS_PTR(), g, S, E);
}
NOINL __device__ void ph_inproj(unsigned char* ws) {
    pg8::Gemm g{(const bf16_t*)(ws + WS_U), (const bf16_t*)(ws + WS_WIN), DM, DM, DM}; pg8::Sched S; S.init(64, 49, gridDim.x, blockIdx.x, 256L * DM * 2, 256L * DM * 2);
    EpiIn E{ws, (const float*)(ws + WS_ROPE)}; pg8::gemm_phase(LDS_PTR(), g, S, E);
}
NOINL __device__ void ph_vt(unsigned char* ws) {
    pg8::Gemm g{(const bf16_t*)(ws + WS_WV), (const bf16_t*)(ws + WS_U), DM, DM, DM}; pg8::Sched S; S.init(4, 64, gridDim.x, blockIdx.x, 256L * DM * 2, 256L * DM * 2);
    EpiVT E{(bf16_t*)(ws + WS_VST), (bf16_t*)(ws + WS_VWT)}; pg8::gemm_phase(LDS_PTR(), g, S, E);
}
NOINL __device__ void ph_cmp1(unsigned char* ws) {
    pg8::Gemm g{(const bf16_t*)(ws + WS_KC), (const bf16_t*)(ws + WS_W1T), 2048, 4096, 512}; pg8::Sched S; S.init(16, 16, gridDim.x, blockIdx.x, 0, 0); S.mode = 1; S.srcstride = (long)(WS_VC - WS_KC);
    EpiPart E{(float*)(ws + WS_PART)}; pg8::gemm_phase(LDS_PTR(), g, S, E);
}
NOINL __device__ void ph_ya(unsigned char* ws) {
    pg8::Gemm g{(const bf16_t*)(ws + WS_HG), (const bf16_t*)(ws + WS_WA), DM, DM, DM}; pg8::Sched S; S.init(64, 8, gridDim.x, blockIdx.x, 256L * DM * 2, 256L * DM * 2);
    EpiGate E{(const bf16_t*)(ws + WS_MG), nullptr, (bf16_t*)(ws + WS_Q), 0}; pg8::gemm_phase(LDS_PTR(), g, S, E);
}
NOINL __device__ void ph_yb(unsigned char* ws) {
    pg8::Gemm g{(const bf16_t*)(ws + WS_XA), (const bf16_t*)(ws + WS_WB), DM, DM, DM}; pg8::Sched S; S.init(64, 8, gridDim.x, blockIdx.x, 256L * DM * 2, 256L * DM * 2);
    EpiGate E{(const bf16_t*)(ws + WS_MG), (const bf16_t*)(ws + WS_Q), (bf16_t*)(ws + WS_U), 1}; pg8::gemm_phase(LDS_PTR(), g, S, E);
}
NOINL __device__ void ph_out(unsigned char* ws) {
    pg8::Gemm g{(const bf16_t*)(ws + WS_U), (const bf16_t*)(ws + WS_WO), DM, DM, DM}; pg8::Sched S; S.init(64, 8, gridDim.x, blockIdx.x, 256L * DM * 2, 256L * DM * 2);
    EpiBf E{(bf16_t*)(ws + WS_FMIX)}; pg8::gemm_phase(LDS_PTR(), g, S, E);
}
NOINL __device__ void ph_cmp2(unsigned char* ws) {
    const int tid = otid(), lane = tid & 63, wave = __builtin_amdgcn_readfirstlane(tid >> 6), bx = blockIdx.x;
    if (wave >= 4 || bx >= 256) return;
    const int src = bx >> 7, rt = bx & 127;
    const int r = lane & 31, hh = lane >> 5;
    const float* P = (const float*)(ws + WS_PART); const float* peb = (const float*)(ws + WS_PEB) + src * 128;
    const bf16_t* w2t = (const bf16_t*)(ws + WS_W2T) + (size_t)src * 128 * 128;
    f32x16 acc;
#pragma unroll
    for (int i = 0; i < 16; ++i) acc[i] = 0.f;
#pragma unroll 2
    for (int st = 0; st < 8; ++st) {
        const int k0 = 16 * st + 8 * hh; float a[8];
#pragma unroll
        for (int e = 0; e < 8; ++e) a[e] = peb[k0 + e];
#pragma unroll
        for (int ks = 0; ks < 8; ++ks) { const float* pp = P + ((size_t)((ks * 2 + src) * 4096 + rt * 32 + r)) * 128 + k0;
            const f32x4 x0 = *(const f32x4*)pp, x1 = *(const f32x4*)(pp + 4); a[0] += x0[0]; a[1] += x0[1]; a[2] += x0[2]; a[3] += x0[3]; a[4] += x1[0]; a[5] += x1[1]; a[6] += x1[2]; a[7] += x1[3]; }
        u32x4 w; w.x = pk2(gelu_t(a[0]), gelu_t(a[1])); w.y = pk2(gelu_t(a[2]), gelu_t(a[3])); w.z = pk2(gelu_t(a[4]), gelu_t(a[5])); w.w = pk2(gelu_t(a[6]), gelu_t(a[7]));
        const bf16x8 af = __builtin_bit_cast(bf16x8, w);
        const bf16x8 bfr = *(const bf16x8*)(w2t + (size_t)(32 * wave + r) * 128 + k0);
        acc = MFMA32(af, bfr, acc);
    }
#pragma unroll
    for (int i = 0; i < 16; ++i) {
        const int R = rt * 32 + crow(i, hh), nrow = R & 127, bgi = R >> 7, d = 32 * wave + r;
        const float v = (nrow == 127) ? 0.f : acc[i];
        const bf16_t o = (bf16_t)(pk2(v, 0.f) & 0xffffu);
        if (src == 0) ((bf16_t*)(ws + WS_KCC))[(size_t)R * 128 + d] = o;
        else ((bf16_t*)(ws + WS_VCT))[((size_t)bgi * 128 + d) * 128 + nrow] = o;
    }
}
NOINL __device__ void ph_lru_gates(unsigned char* ws, const float* conv_w, const float* conv_b, const float* lbr, const float* lbi, const float* llam) {
    const int tid = otid(), lane = tid & 63, wave = __builtin_amdgcn_readfirstlane(tid >> 6), bx = blockIdx.x, G = gridDim.x;
    LAS unsigned char* lds = LDS_PTR();
    const int h = bx & 15, cuh = bx >> 4, nch = G >> 4;
    LAS unsigned char* WL = lds; LAS unsigned char* XS = lds + 69632 + wave * 8704; LAS float* CW = (LAS float*)(lds + 139264);
    const bf16_t* wri = (const bf16_t*)(ws + WS_WRI) + (size_t)h * 256 * 128;
#pragma unroll
    for (int e = 0; e < 8; ++e) { const int c = tid + 512 * e; *(LAS u32x4*)(WL + (c >> 4) * 272 + (c & 15) * 16) = *(const u32x4*)(wri + (c >> 4) * 128 + (c & 15) * 8); }
    if (tid < 128) { const int ch = h * 128 + tid;
        CW[tid] = conv_w[ch]; CW[128 + tid] = conv_w[DM + ch]; CW[256 + tid] = conv_w[2 * DM + ch]; CW[384 + tid] = conv_w[3 * DM + ch];
        CW[512 + tid] = conv_b[ch]; CW[640 + tid] = lbr[ch]; CW[768 + tid] = lbi[ch];
        const float lam = llam[ch], ex = __expf(-lam);
        CW[896 + tid] = (ex < 0.03f) ? ex * (1.f - ex * (0.5f - ex * (0.33333333f - ex * (0.25f - ex * 0.2f)))) : __logf(1.f + ex); }
    __syncthreads();
    const int r = lane & 31, hh = lane >> 5;
    const bf16_t* XA = (const bf16_t*)(ws + WS_XA); bf16_t* LA = (bf16_t*)(ws + WS_U); bf16_t* BBp = (bf16_t*)(ws + WS_BB);
#pragma unroll 1
    for (int rt = cuh * 8 + wave; rt < T / 32; rt += nch * 8) {
        const int t0 = rt * 32, tok = t0 + r, s = tok & 2047;
        bf16x8 af[8];
#pragma unroll
        for (int st = 0; st < 8; ++st) {
            const int ch0 = 16 * st + 8 * hh; float xc[8];
#pragma unroll
            for (int e = 0; e < 8; ++e) xc[e] = CW[512 + ch0 + e];
#pragma unroll
            for (int j = 0; j < 4; ++j) { if (s - 3 + j >= 0) { const u32x4 xv = *(const u32x4*)(XA + ((size_t)(((tok >> 11) * 16 + h) * 2048 + (s - 3 + j))) * 128 + ch0);
                xc[0] += CW[j * 128 + ch0 + 0] * bflo(xv.x); xc[1] += CW[j * 128 + ch0 + 1] * bfhi(xv.x); xc[2] += CW[j * 128 + ch0 + 2] * bflo(xv.y); xc[3] += CW[j * 128 + ch0 + 3] * bfhi(xv.y);
                xc[4] += CW[j * 128 + ch0 + 4] * bflo(xv.z); xc[5] += CW[j * 128 + ch0 + 5] * bfhi(xv.z); xc[6] += CW[j * 128 + ch0 + 6] * bflo(xv.w); xc[7] += CW[j * 128 + ch0 + 7] * bfhi(xv.w); } }
            u32x4 w; w.x = pk2(xc[0], xc[1]); w.y = pk2(xc[2], xc[3]); w.z = pk2(xc[4], xc[5]); w.w = pk2(xc[6], xc[7]);
            af[st] = __builtin_bit_cast(bf16x8, w);
            *(LAS u32x4*)(XS + r * 272 + ch0 * 2) = w;
            if (st & 1) asm volatile("" ::: "memory");
        }
        LDS_WAIT();
#pragma unroll 1
        for (int cb = 0; cb < 4; ++cb) {
            f32x16 aR, aI;
#pragma unroll
            for (int i = 0; i < 16; ++i) { aR[i] = 0.f; aI[i] = 0.f; }
#pragma unroll
            for (int st = 0; st < 8; ++st) {
                const bf16x8 bR = *(const LAS bf16x8*)(WL + (32 * cb + r) * 272 + st * 32 + hh * 16), bI = *(const LAS bf16x8*)(WL + (128 + 32 * cb + r) * 272 + st * 32 + hh * 16);
                aR = MFMA32(af[st], bR, aR); aI = MFMA32(af[st], bI, aI);
            }
            const int ch = 32 * cb + r; const float br_ = CW[640 + ch], bi_ = CW[768 + ch], sp_ = CW[896 + ch];
#pragma unroll
            for (int i = 0; i < 16; ++i) {
                const int tk = crow(i, hh);
                const float rr = sigm(aR[i] + br_), ig = sigm(aI[i] + bi_), la = -8.f * rr * sp_;
                const float xcv = bf2f(*(const LAS bf16_t*)(XS + tk * 272 + ch * 2));
                const float bm = sqrtf(fmaxf(1.f - __expf(2.f * la), 0.f)) * ig * xcv;
                const int tkn = t0 + tk;
                const size_t o = ((size_t)(((tkn >> 11) * 32 + h * 2 + (cb >> 1)) * 2048 + (tkn & 2047))) * 64 + (cb & 1) * 32 + r;
                LA[o] = (bf16_t)(pk2(la, 0.f) & 0xffffu); BBp[o] = (bf16_t)(pk2(bm, 0.f) & 0xffffu);
            }
        }
        LDS_WAIT();
    }
}
NOINL __device__ void ph_scan(unsigned char* ws) {
    const int tid = otid(), lane = tid & 63, wave = __builtin_amdgcn_readfirstlane(tid >> 6), bx = blockIdx.x, G = gridDim.x;
    LAS float* car = (LAS float*)LDS_PTR();
    const bf16_t* LA = (const bf16_t*)(ws + WS_U); const bf16_t* BBp = (const bf16_t*)(ws + WS_BB); const bf16_t* GY = (const bf16_t*)(ws + WS_GY); bf16_t* HG = (bf16_t*)(ws + WS_HG);
    for (int unit = bx; unit < 256; unit += G) {
        const int b = unit >> 5, ch = (unit & 31) * 64 + lane;
        const size_t bbase = (size_t)unit * 2048 * 64 + lane;
        float hcarry = 0.f;
#pragma unroll 1
        for (int rd = 0; rd < 8; ++rd) {
            const size_t base = ((size_t)b * SEQ + rd * 256 + wave * 32) * DM + ch;
            float la[32], bb[32], gy[32];
#pragma unroll
            for (int e = 0; e < 32; ++e) { const size_t o = bbase + (size_t)(rd * 256 + wave * 32 + e) * 64; la[e] = bf2f(LA[o]); bb[e] = bf2f(BBp[o]); gy[e] = bf2f(GY[o]); }
            float hst = 0.f;
#pragma unroll
            for (int e = 0; e < 32; ++e) { la[e] = __expf(la[e]); hst = la[e] * hst + bb[e]; }
            float aprod = 1.f;
#pragma unroll
            for (int e = 0; e < 32; ++e) aprod *= la[e];
            LAS float* cb = car + (rd & 1) * 1024;
            cb[(wave * 2) * 64 + lane] = aprod; cb[(wave * 2 + 1) * 64 + lane] = hst;
            __syncthreads();
            float hin = hcarry, myhin = 0.f;
#pragma unroll
            for (int w = 0; w < 8; ++w) { if (w == wave) myhin = hin; hin = cb[(w * 2) * 64 + lane] * hin + cb[(w * 2 + 1) * 64 + lane]; }
            hcarry = hin; hst = myhin;
#pragma unroll
            for (int e = 0; e < 32; ++e) { hst = la[e] * hst + bb[e]; HG[base + (size_t)e * DM] = (bf16_t)(pk2(hst * gy[e], 0.f) & 0xffffu); }
        }
        __syncthreads();
    }
}
NOINL __device__ void ph_lru_fused(unsigned char* ws, const float* conv_w, const float* conv_b, const float* lbr, const float* lbi, const float* llam) {
    const int tid = otid(), lane = tid & 63, wave = __builtin_amdgcn_readfirstlane(tid >> 6), bx = blockIdx.x, G = gridDim.x;
    LAS unsigned char* lds = LDS_PTR();
    LAS unsigned char* WL = lds; LAS float* CW = (LAS float*)(lds + 34816); LAS unsigned char* XS = lds + 38912 + wave * 8704; LAS float* car = (LAS float*)(lds + 108544);
    const int r = lane & 31, hh = lane >> 5;
    const bf16_t* XA = (const bf16_t*)(ws + WS_XA); const bf16_t* GY = (const bf16_t*)(ws + WS_GY); bf16_t* HG = (bf16_t*)(ws + WS_HG);
#pragma unroll 1
    for (int unit = bx; unit < 256; unit += G) {
        const int b = unit >> 5, cgp = unit & 31, h = cgp >> 1, hf = cgp & 1;
        __syncthreads();
        {
            const bf16_t* wri = (const bf16_t*)(ws + WS_WRI) + (size_t)h * 256 * 128;
#pragma unroll
            for (int e = 0; e < 4; ++e) { const int c = tid + 512 * e, row = c >> 4, srow = (row < 64) ? hf * 64 + row : 128 + hf * 64 + (row - 64);
                *(LAS u32x4*)(WL + row * 272 + (c & 15) * 16) = *(const u32x4*)(wri + srow * 128 + (c & 15) * 8); }
            if (tid < 128) { const int ch = h * 128 + tid; CW[tid] = conv_w[ch]; CW[128 + tid] = conv_w[DM + ch]; CW[256 + tid] = conv_w[2 * DM + ch]; CW[384 + tid] = conv_w[3 * DM + ch]; CW[512 + tid] = conv_b[ch]; }
            if (tid < 64) { const int ch = h * 128 + hf * 64 + tid; CW[640 + tid] = lbr[ch]; CW[704 + tid] = lbi[ch];
                const float lam = llam[ch], ex = __expf(-lam);
                CW[768 + tid] = (ex < 0.03f) ? ex * (1.f - ex * (0.5f - ex * (0.33333333f - ex * (0.25f - ex * 0.2f)))) : __logf(1.f + ex); }
        }
        __syncthreads();
        const bf16_t* XAb = XA + (size_t)(b * 16 + h) * 2048 * 128;
        const bf16_t* GYb = GY + (size_t)unit * 2048 * 64;
        float hcar0 = 0.f, hcar1 = 0.f;
#pragma unroll 1
        for (int rd = 0; rd < 8; ++rd) {
            const int t0 = rd * 256 + wave * 32, s = t0 + r;
            bf16_t gyr[2][16];
#pragma unroll
            for (int cb = 0; cb < 2; ++cb)
#pragma unroll
                for (int i = 0; i < 16; ++i) gyr[cb][i] = GYb[(size_t)(t0 + crow(i, hh)) * 64 + 32 * cb + r];
            bf16x8 af[8];
            {
                u32x4 xv[8][4];
#pragma unroll
                for (int st = 0; st < 8; ++st)
#pragma unroll
                    for (int j = 0; j < 4; ++j) { const int sp = s - 3 + j; xv[st][j] = *(const u32x4*)(XAb + (size_t)(sp < 0 ? 0 : sp) * 128 + 16 * st + 8 * hh); }
#pragma unroll
                for (int st = 0; st < 8; ++st) {
                    const int ch0 = 16 * st + 8 * hh; float xc[8];
#pragma unroll
                    for (int e = 0; e < 8; ++e) xc[e] = CW[512 + ch0 + e];
#pragma unroll
                    for (int j = 0; j < 4; ++j) { const float ok = (s - 3 + j >= 0) ? 1.f : 0.f; const u32x4 x4 = xv[st][j];
                        xc[0] += ok * CW[j * 128 + ch0 + 0] * bflo(x4.x); xc[1] += ok * CW[j * 128 + ch0 + 1] * bfhi(x4.x); xc[2] += ok * CW[j * 128 + ch0 + 2] * bflo(x4.y); xc[3] += ok * CW[j * 128 + ch0 + 3] * bfhi(x4.y);
                        xc[4] += ok * CW[j * 128 + ch0 + 4] * bflo(x4.z); xc[5] += ok * CW[j * 128 + ch0 + 5] * bfhi(x4.z); xc[6] += ok * CW[j * 128 + ch0 + 6] * bflo(x4.w); xc[7] += ok * CW[j * 128 + ch0 + 7] * bfhi(x4.w); }
                    u32x4 w; w.x = pk2(xc[0], xc[1]); w.y = pk2(xc[2], xc[3]); w.z = pk2(xc[4], xc[5]); w.w = pk2(xc[6], xc[7]);
                    af[st] = __builtin_bit_cast(bf16x8, w);
                    *(LAS u32x4*)(XS + r * 272 + ch0 * 2) = w;
                }
            }
            LDS_WAIT();
            float av[2][16], bv[2][16];
#pragma unroll
            for (int cb = 0; cb < 2; ++cb) {
                f32x16 aR, aI;
#pragma unroll
                for (int i = 0; i < 16; ++i) { aR[i] = 0.f; aI[i] = 0.f; }
#pragma unroll
                for (int st = 0; st < 8; ++st) {
                    const bf16x8 bR = *(const LAS bf16x8*)(WL + (32 * cb + r) * 272 + st * 32 + hh * 16), bI = *(const LAS bf16x8*)(WL + (64 + 32 * cb + r) * 272 + st * 32 + hh * 16);
                    aR = MFMA32(af[st], bR, aR); aI = MFMA32(af[st], bI, aI);
                }
                const int chl = 32 * cb + r; const float br_ = CW[640 + chl], bi_ = CW[704 + chl], sp_ = CW[768 + chl];
#pragma unroll
                for (int i = 0; i < 16; ++i) {
                    const float rr = sigm(aR[i] + br_), ig = sigm(aI[i] + bi_), a = __expf(-8.f * rr * sp_);
                    const float xcv = bf2f(*(const LAS bf16_t*)(XS + crow(i, hh) * 272 + (hf * 64 + chl) * 2));
                    av[cb][i] = a; bv[cb][i] = __builtin_amdgcn_sqrtf(fmaxf(1.f - a * a, 0.f)) * ig * xcv;
                }
            }
            float GA[2][4], GB[2][4], PA[2][4], PB[2][4];
#pragma unroll
            for (int cb = 0; cb < 2; ++cb)
#pragma unroll
                for (int g = 0; g < 4; ++g) {
                    float A = av[cb][4 * g], B = bv[cb][4 * g];
#pragma unroll
                    for (int e = 1; e < 4; ++e) { B = av[cb][4 * g + e] * B + bv[cb][4 * g + e]; A *= av[cb][4 * g + e]; }
                    GA[cb][g] = A; GB[cb][g] = B; PA[cb][g] = __shfl_xor(A, 32); PB[cb][g] = __shfl_xor(B, 32);
                }
            LAS float* cbuf = car + (rd & 1) * 1024;
#pragma unroll
            for (int cb = 0; cb < 2; ++cb) {
                float A = 1.f, B = 0.f;
#pragma unroll
                for (int g = 0; g < 4; ++g) {
                    const float A0 = hh ? PA[cb][g] : GA[cb][g], B0 = hh ? PB[cb][g] : GB[cb][g], A1 = hh ? GA[cb][g] : PA[cb][g], B1 = hh ? GB[cb][g] : PB[cb][g];
                    B = A0 * B + B0; A *= A0; B = A1 * B + B1; A *= A1;
                }
                if (hh == 0) { cbuf[(wave * 2) * 64 + 32 * cb + r] = A; cbuf[(wave * 2 + 1) * 64 + 32 * cb + r] = B; }
            }
            __syncthreads();
#pragma unroll
            for (int cb = 0; cb < 2; ++cb) {
                float hin = cb ? hcar1 : hcar0, myhin = 0.f;
#pragma unroll
                for (int w = 0; w < 8; ++w) { if (w == wave) myhin = hin; hin = cbuf[(w * 2) * 64 + 32 * cb + r] * hin + cbuf[(w * 2 + 1) * 64 + 32 * cb + r]; }
                if (cb) hcar1 = hin; else hcar0 = hin;
                float hrun = myhin;
#pragma unroll
                for (int g = 0; g < 4; ++g) {
                    if (hh) hrun = PA[cb][g] * hrun + PB[cb][g];
                    float hv = hrun;
#pragma unroll
                    for (int e = 0; e < 4; ++e) { const int i = 4 * g + e; hv = av[cb][i] * hv + bv[cb][i];
                        HG[((size_t)b * SEQ + t0 + crow(i, hh)) * DM + h * 128 + hf * 64 + 32 * cb + r] = (bf16_t)(pk2(hv * bf2f(gyr[cb][i]), 0.f) & 0xffffu); }
                    hrun = hv;
                    if (!hh) hrun = PA[cb][g] * hrun + PB[cb][g];
                }
            }
        }
    }
}
NOINL __device__ void ph_nsa(unsigned char* ws) {
    const int bx = blockIdx.x, G = gridDim.x;
    const int vcu = (G % 8 == 0) ? (bx % 8) * (G / 8) + bx / 8 : bx;
#pragma unroll 1
    for (int uu = vcu; uu < 1024; uu += G) {
        const int pr = uu & 255, it = uu >> 8, bg = pr >> 3, s = pr & 7;
        const int qblk = (it == 0) ? s : (it == 1) ? 15 - s : (it == 2) ? 16 + s : 31 - s;
        nsa_unit(bg, qblk, ws, LDS_PTR());
    }
}

constexpr size_t WS_BAR = 960 * 1024;
constexpr int LDS_BARST = LDS_BYTES - 16;
#define XB_TMO      128
#define XB_XCNT(j)  (256  + 64 * (j))
#define XB_XSUB(j)  (1280 + 64 * (j))
#define XB_XGEN(j)  (2304 + 64 * (j))
#define XB_TOP      3328
#define XB_TOPGEN   3392
#define XCD_BAR_WORDS 3456
#define XB_SPIN_CAP (1u << 18)
DI unsigned xb_ld(unsigned* p)              { return __hip_atomic_load(p, __ATOMIC_RELAXED, __HIP_MEMORY_SCOPE_AGENT); }
DI unsigned xb_add(unsigned* p, unsigned v) { return __hip_atomic_fetch_add(p, v, __ATOMIC_RELAXED, __HIP_MEMORY_SCOPE_AGENT); }
DI unsigned xb_xcc_id() { return (unsigned)__builtin_amdgcn_s_getreg((3 << 11) | 20) & 0xFu; }
#define XB_SPIN(cond, bar) do { unsigned _sp = 0; while (cond) { __builtin_amdgcn_s_sleep(1); \
    if ((++_sp & 255u) == 0u) { if (xb_ld(&(bar)[XB_TMO])) break; if (_sp > XB_SPIN_CAP) { atomicAdd(&(bar)[XB_TMO], 1u); break; } } } } while (0)
DI void xcd_barrier_complete(unsigned* bar, unsigned x, unsigned& nloc, unsigned& nx) {
    const unsigned G = gridDim.x * gridDim.y * gridDim.z;
    unsigned sum, cnt, mine, sp = 0u;
    for (;;) {
        sum = 0u; cnt = 0u; mine = 0u;
#pragma unroll
        for (unsigned j = 0; j < 16; ++j) { const unsigned c = xb_ld(&bar[XB_XCNT(j)]); sum += c; cnt += (c > 0u) ? 1u : 0u; mine = (j == x) ? c : mine; }
        if (sum == G) break;
        __builtin_amdgcn_s_sleep(1);
        if ((++sp & 255u) == 0u) { if (xb_ld(&bar[XB_TMO])) break; if (sp > XB_SPIN_CAP) { atomicAdd(&bar[XB_TMO], 1u); break; } }
    }
    nloc = mine > 0u ? mine : 1u; nx = cnt > 0u ? cnt : 1u;
}
DI void xcd_barrier(unsigned* bar) {
    asm volatile("s_waitcnt vmcnt(0)" ::: "memory");
    __syncthreads();
    if (threadIdx.x == 0) {
        volatile LAS unsigned* st = (volatile LAS unsigned*)(LDS_PTR() + LDS_BARST);
        const unsigned x = xb_xcc_id();
        __builtin_amdgcn_s_waitcnt(0);
        unsigned nloc = st[0], nx = st[1];
        if (nloc == 0u) { xcd_barrier_complete(bar, x, nloc, nx); st[0] = nloc; st[1] = nx; }
        const unsigned old = xb_add(&bar[XB_XSUB(x)], 1u);
        const unsigned gen = old / nloc;
        if (old + 1u == (gen + 1u) * nloc) {
            __builtin_amdgcn_fence(__ATOMIC_RELEASE, "agent");
            asm volatile("s_waitcnt vmcnt(0)" ::: "memory");
            const unsigned og = xb_add(&bar[XB_TOP], 1u);
            const unsigned tg = og / nx;
            if (og + 1u == (tg + 1u) * nx) xb_add(&bar[XB_TOPGEN], 1u);
            else XB_SPIN(xb_ld(&bar[XB_TOPGEN]) == tg, bar);
            __builtin_amdgcn_fence(__ATOMIC_ACQUIRE, "agent");
            xb_add(&bar[XB_XGEN(x)], 1u);
            asm volatile("s_waitcnt vmcnt(0)" ::: "memory");
        } else {
            XB_SPIN(xb_ld(&bar[XB_XGEN(x)]) == gen, bar);
            __builtin_amdgcn_fence(__ATOMIC_ACQUIRE, "agent");
            asm volatile("s_waitcnt vmcnt(0)" ::: "memory");
        }
    }
    __syncthreads();
}

DI KArgs oargs() { auto p = __builtin_amdgcn_kernarg_segment_ptr(); asm volatile("" : "+s"(p)); return (KArgs)p; }

DI void ph_prologue() {
    KArgs ka = oargs();
    LAS unsigned char* lds = LDS_PTR(); unsigned char* ws = ka->ws; float* mod = (float*)(ws + WS_MOD);
    const int tid = otid(), lane = tid & 63, wave = __builtin_amdgcn_readfirstlane(tid >> 6), G = gridDim.x, bx = blockIdx.x, gw = bx * NWV + wave, ngw = G * NWV;
#ifdef PROBE_ADA
    const unsigned long long tp0 = __builtin_amdgcn_s_memrealtime();
#endif
    if (bx < 72) {
        LAS float* cact = (LAS float*)lds;
        LAS float* red = (LAS float*)(lds + 65536);
        const float* c = ka->in[1]; const float* wada = ka->in[2]; const float* bada = ka->in[3];
        for (int i = tid; i < NB * DM; i += NTHR) { const float v = c[i]; cact[i] = v * sigm(v); }
        __syncthreads();
        const int col = bx * 256 + 4 * lane;
        f32x4 acc[8];
#pragma unroll
        for (int b = 0; b < 8; ++b) acc[b] = (f32x4){0.f, 0.f, 0.f, 0.f};
        const float* wp = wada + (size_t)(wave * 256) * (NADA * DM) + col;
        f32x4 wn[8];
#pragma unroll
        for (int e = 0; e < 8; ++e) wn[e] = *(const f32x4*)(wp + (size_t)e * (NADA * DM));
#pragma unroll 1
        for (int k = 0; k < 256; k += 8) {
            f32x4 w[8];
#pragma unroll
            for (int e = 0; e < 8; ++e) w[e] = wn[e];
            if (k + 8 < 256) {
#pragma unroll
                for (int e = 0; e < 8; ++e) wn[e] = *(const f32x4*)(wp + (size_t)(k + 8 + e) * (NADA * DM)); }
#pragma unroll
            for (int e = 0; e < 8; ++e)
#pragma unroll
                for (int b = 0; b < 8; ++b) acc[b] += w[e] * cact[b * DM + wave * 256 + k + e];
        }
#pragma unroll
        for (int b = 0; b < 8; ++b) *(LAS f32x4*)(red + (wave * 8 + b) * 256 + 4 * lane) = acc[b];
        __syncthreads();
#pragma unroll
        for (int e = 0; e < 4; ++e) { const int idx = tid + 512 * e, b = idx >> 8, cc = idx & 255; float sum = bada[bx * 256 + cc];
#pragma unroll
            for (int w = 0; w < 8; ++w) sum += red[(w * 8 + b) * 256 + cc];
            mod[b * (NADA * DM) + bx * 256 + cc] = sum; }
        __syncthreads();
    }
#ifdef PROBE_ADA
    { const unsigned long long tp1 = __builtin_amdgcn_s_memrealtime(); while (__builtin_amdgcn_s_memrealtime() - tp1 < tp1 - tp0) __builtin_amdgcn_s_sleep(8); }
#endif
    {
        const int nada = (G > 72) ? 72 : 0, nslots = (G - nada) * NWV * 2 + nada * NWV;
        const int slot0 = (bx >= nada) ? ((bx - nada) * NWV + wave) * 2 : (G - nada) * NWV * 2 + bx * NWV + wave, nslot = (bx >= nada) ? 2 : 1;
        conv_jobs_w(0, 9, ka, lds, slot0, nslot, nslots, wave, lane);
        conv_jobs_w(11, 12, ka, lds, slot0, nslot, nslots, wave, lane);
    }
    {
        const int idx = bx * NTHR + tid;
        if (idx < SEQ * 16) { const int pos = idx >> 4, i = idx & 15;
            const float invf = __builtin_amdgcn_exp2f(-(float)i * 1.1832230356f); const float ang = (float)pos * invf;
            const float rev = ang * 0.15915494309189535f, fr = rev - floorf(rev);
            float* rp = (float*)(ws + WS_ROPE) + pos * 32; rp[i] = __builtin_amdgcn_cosf(fr); rp[16 + i] = __builtin_amdgcn_sinf(fr); }
    }
    __syncthreads();
}
template <bool RES>
DI void rows_fetch(u32x4 (&fN)[4], f32x4 (&xN)[8], const bf16_t* F, const float* X, int row, int lane) {
    if (row < T) {
        if (RES) {
#pragma unroll
            for (int j = 0; j < 4; ++j) fN[j] = *(const u32x4*)(F + (size_t)row * DM + 512 * j + 8 * lane); }
        row_load(xN, X + (size_t)row * DM, lane);
    }
}
template <bool RES, bool MODU>
DI void rows_proc(const u32x4 (&fN)[4], const f32x4 (&xN)[8], int row, float* XO, const float* gatebase, const float* pg, float wgt, const float* g, const float* shbase, const float* scbase, bf16_t* U, int lane) {
    f32x4 v[8], fv[8];
#pragma unroll
    for (int q = 0; q < 8; ++q) v[q] = xN[q];
    if (RES) {
#pragma unroll
        for (int j = 0; j < 4; ++j) { const u32x4 w = fN[j]; fv[2 * j] = (f32x4){bflo(w.x), bfhi(w.x), bflo(w.y), bfhi(w.y)}; fv[2 * j + 1] = (f32x4){bflo(w.z), bfhi(w.z), bflo(w.w), bfhi(w.w)}; } }
    const int b = row >> 11; const size_t mo = (size_t)b * (NADA * DM);
    if (RES) {
        const float rs = row_rstd(fv);
#pragma unroll
        for (int j = 0; j < 8; ++j) { const int c = rcol(j, lane); const f32x4 gt = *(const f32x4*)(gatebase + mo + c), pp = *(const f32x4*)(pg + c);
            v[j] = v[j] + (gt * wgt) * (fv[j] * rs * pp); *(f32x4*)(XO + (size_t)row * DM + c) = v[j]; }
    }
    if (MODU) { const float rs2 = row_rstd(v); row_modulate_store(v, rs2, g, shbase + mo, scbase + mo, U + (size_t)row * DM, lane); }
}
template <bool RES, bool MODU>
DI void rows_run(const bf16_t* F, const float* X, float* XO, const float* gatebase, const float* pg, float wgt, const float* g, const float* shbase, const float* scbase, bf16_t* U, int lane, int gw, int ngw) {
    u32x4 fA[4], fB[4]; f32x4 xA[8], xB[8];
    rows_fetch<RES>(fA, xA, F, X, gw, lane); rows_fetch<RES>(fB, xB, F, X, gw + ngw, lane);
#pragma unroll 1
    for (int row = gw; row < T; row += 2 * ngw) {
        u32x4 fc[4]; f32x4 xc[8];
#pragma unroll
        for (int j = 0; j < 4; ++j) fc[j] = fA[j];
#pragma unroll
        for (int q = 0; q < 8; ++q) xc[q] = xA[q];
        rows_fetch<RES>(fA, xA, F, X, row + 2 * ngw, lane);
        rows_proc<RES, MODU>(fc, xc, row, XO, gatebase, pg, wgt, g, shbase, scbase, U, lane);
        if (row + ngw < T) {
#pragma unroll
            for (int j = 0; j < 4; ++j) fc[j] = fB[j];
#pragma unroll
            for (int q = 0; q < 8; ++q) xc[q] = xB[q];
            rows_fetch<RES>(fB, xB, F, X, row + 3 * ngw, lane);
            rows_proc<RES, MODU>(fc, xc, row + ngw, XO, gatebase, pg, wgt, g, shbase, scbase, U, lane);
        }
    }
}
DI void ph_rows(int which) {
    KArgs ka = oargs(); unsigned char* ws = ka->ws; float* out = ka->out; const float* mod = (const float*)(ws + WS_MOD);
    const int tid = otid(), lane = tid & 63, wave = __builtin_amdgcn_readfirstlane(tid >> 6), G = gridDim.x, bx = blockIdx.x, gw = bx * NWV + wave, ngw = G * NWV;
    bf16_t* U = (bf16_t*)(ws + WS_U);
    if (which == 0) rows_run<false, true>(nullptr, ka->in[0], nullptr, nullptr, nullptr, 0.f, ka->in[4], mod + 0 * DM, mod + 1 * DM, U, lane, gw, ngw);
    else if (which == 1) rows_run<true, true>((const bf16_t*)(ws + WS_F), ka->in[0], out, mod + 2 * DM, ka->in[5], 0.5f, ka->in[9], mod + 3 * DM, mod + 4 * DM, U, lane, gw, ngw);
    else if (which == 2) rows_run<true, true>((const bf16_t*)(ws + WS_FMIX), out, out, mod + 5 * DM, ka->in[10], 1.0f, ka->in[28], mod + 6 * DM, mod + 7 * DM, U, lane, gw, ngw);
    else rows_run<true, false>((const bf16_t*)(ws + WS_F), out, out, mod + 8 * DM, ka->in[29], 0.5f, nullptr, nullptr, nullptr, nullptr, lane, gw, ngw);
}

DI void ph_pebias() {
    const int G = gridDim.x, bx = blockIdx.x;
    if (bx < G - 2) return;
    KArgs ka = oargs(); unsigned char* ws = ka->ws;
    const int tid = otid(), src = bx - (G - 2); const float* pe = ka->in[src ? 22 : 19]; const float* w1 = ka->in[src ? 23 : 20];
    LAS f32x4* red = (LAS f32x4*)LDS_PTR();
    const int d4 = tid & 31, kq = tid >> 5;
    f32x4 acc = {0.f, 0.f, 0.f, 0.f};
#pragma unroll 1
    for (int k = kq * 256; k < kq * 256 + 256; k += 16) {
        f32x4 w[16]; float pv[16];
#pragma unroll
        for (int e = 0; e < 16; ++e) { w[e] = *(const f32x4*)(w1 + (size_t)(k + e) * 128 + 4 * d4); pv[e] = pe[k + e]; }
#pragma unroll
        for (int e = 0; e < 16; ++e) acc += w[e] * pv[e];
    }
    __syncthreads();
    red[tid] = acc; __syncthreads();
    if (tid < 32) { f32x4 sum = red[tid];
#pragma unroll
        for (int q = 1; q < 16; ++q) sum += red[q * 32 + tid];
        *(f32x4*)((float*)(ws + WS_PEB) + src * 128 + 4 * tid) = sum; }
    __syncthreads();
}

DI void ph_conv_ffn2() {
    const int G = gridDim.x, bx = blockIdx.x, nlong = (3136 % G);
    if (G <= nlong || bx < nlong) return;
    KArgs ka = oargs();
    const int tid = otid(), lane = tid & 63, wave = __builtin_amdgcn_readfirstlane(tid >> 6);
    __syncthreads();
    conv_jobs_w(9, 11, ka, LDS_PTR(), (bx - nlong) * NWV + wave, 1, (G - nlong) * NWV, wave, lane);
    __syncthreads();
}

__global__ void __launch_bounds__(NTHR) fwd_kernel(Args args_unused) {
    cg::grid_group grid = cg::this_grid();
    {
        volatile LAS unsigned* st = (volatile LAS unsigned*)(LDS_PTR() + LDS_BARST);
        if (threadIdx.x < 2) st[threadIdx.x] = 0u;
        __syncthreads();
        if (threadIdx.x == 0) (void)xb_add((unsigned*)(oargs()->ws + WS_BAR) + XB_XCNT(xb_xcc_id()), 1u);
    }
#ifndef PH_MASK
#define PH_MASK 0xffff
#endif
#define WSP() (oargs()->ws)
#ifndef PROBE_DUP
#define PROBE_DUP 0
#endif
#ifndef PROBE_SPIN
#define PROBE_SPIN 0
#endif
#define RUN(k, bit, body) if (oargs()->ph_lo <= (k) && (k) < oargs()->ph_hi) { unsigned long long _t0 = 0; if (((PROBE_SPIN) >> (k)) & 1) _t0 = __builtin_amdgcn_s_memrealtime(); \
    for (int _rep = 0; _rep < 1 + (((PROBE_DUP) >> (bit)) & 1); ++_rep) if (((PH_MASK) >> (bit)) & 1) { body; } \
    if (((PROBE_SPIN) >> (k)) & 1) { __syncthreads(); const unsigned long long _t1 = __builtin_amdgcn_s_memrealtime(); while (__builtin_amdgcn_s_memrealtime() - _t1 < _t1 - _t0) __builtin_amdgcn_s_sleep(8); } }
#define SEAMX(k) if (oargs()->ph_lo <= (k) && (k) + 1 < oargs()->ph_hi) { if (oargs()->ph_hi > 1000) grid.sync(); else xcd_barrier((unsigned*)(oargs()->ws + WS_BAR)); }
    RUN(0, 0, ph_prologue()) SEAMX(0)
    RUN(1, 1, ph_rows(0)) SEAMX(1)
    RUN(2, 2, ph_ffn_up(WSP())) SEAMX(2)
    RUN(3, 3, ph_ffn_down(WSP())) SEAMX(3)
    RUN(4, 4, ph_rows(1)) SEAMX(4)
    RUN(5, 5, ph_inproj(WSP()); ph_vt(WSP()); ph_pebias(); ph_conv_ffn2()) SEAMX(5)
    RUN(6, 6, ph_cmp1(WSP())) SEAMX(6)
    RUN(7, 7, ph_cmp2(WSP()); __syncthreads(); ph_lru_fused(oargs()->ws, oargs()->in[12], oargs()->in[13], oargs()->in[15], oargs()->in[17], oargs()->in[18]))
    SEAMX(7)
    RUN(8, 8, ph_nsa(WSP())) SEAMX(8)
    RUN(9, 9, ph_ya(WSP()))
    RUN(10, 10, ph_yb(WSP())) SEAMX(10)
    RUN(11, 11, ph_out(WSP())) SEAMX(11)
    RUN(12, 12, ph_rows(2)) SEAMX(12)
    RUN(13, 2, ph_ffn_up(WSP())) SEAMX(13)
    RUN(14, 3, ph_ffn_down(WSP())) SEAMX(14)
    RUN(15, 15, ph_rows(3))
}

extern "C" void kernel_launch(void* const* d_in, const int* in_sizes, int n_in, void* d_out, int out_size, void* d_ws, size_t ws_size, hipStream_t stream) {
    static int grid = 0;
    if (grid == 0) {
        if (n_in != 33 || out_size != T * DM || ws_size < WS_END) { fprintf(stderr, "kernel_launch: unexpected problem (n_in %d out %d ws %zu)\n", n_in, out_size, ws_size); grid = -1; return; }
        int dev = 0, cus = 0, per_cu = 0;
        hipGetDevice(&dev); hipDeviceGetAttribute(&cus, hipDeviceAttributeMultiprocessorCount, dev);
        if (hipFuncSetAttribute((const void*)fwd_kernel, hipFuncAttributeMaxDynamicSharedMemorySize, LDS_BYTES) != hipSuccess) { fprintf(stderr, "kernel_launch: hipFuncSetAttribute failed\n"); grid = -1; return; }
        if (hipOccupancyMaxActiveBlocksPerMultiprocessor(&per_cu, (const void*)fwd_kernel, NTHR, LDS_BYTES) != hipSuccess || per_cu < 1) { fprintf(stderr, "kernel_launch: occupancy query gives %d\n", per_cu); per_cu = 1; }
        (void)hipGetLastError();
        grid = cus;
    }
    if (grid < 0) return;
    if (hipMemsetAsync((char*)d_ws + WS_BAR, 0, 16384, stream) != hipSuccess) { fprintf(stderr, "kernel_launch: memset of the barrier words failed\n"); return; }
    Args a{};
    for (int i = 0; i < 33; ++i) a.in[i] = (const float*)d_in[i];
    a.out = (float*)d_out; a.ws = (unsigned char*)d_ws;
#if ONE_LAUNCH
    a.ph_lo = 0; a.ph_hi = 16;
    void* params[] = {&a};
    hipError_t e = hipLaunchCooperativeKernel((const void*)fwd_kernel, dim3(grid), dim3(NTHR), params, LDS_BYTES, stream);
    if (e != hipSuccess) fprintf(stderr, "cooperative launch failed: %s (grid %d)\n", hipGetErrorString(e), grid);
#else
    for (int p = 0; p < 16; ++p) { a.ph_lo = p; a.ph_hi = p + 1; hipLaunchKernelGGL(fwd_kernel, dim3(grid), dim3(NTHR), LDS_BYTES, stream, a); }
#endif
}
```
